# Optimizing an MI355X kernel written in HIP

```python
import jax, jax.numpy as jnp
from jax import lax
import numpy as np

D_MODEL = 2048
BATCH = 4
SEQ = 2048
DEPTH = 4
DEC_BATCH = 16
DEC_SEQ = 2048
PAST_LEN = 128

GRID_W = 64
HEAD_DIM = 128
N_HEADS = D_MODEL // HEAD_DIM
N_KV_HEADS = N_HEADS // 4
Q_BLOCK = 128
ROPE_BASE = 10000.0
SG_WIDTH = D_MODEL
SG_GROUPS = 8
SG_CHUNK = 128
N_MEM = 256
X_HEADS = 4
X_HEAD_DIM = D_MODEL // X_HEADS
D_FF = 5632
CONV_W = 3
EPS = 1e-6

Q_COLS = N_HEADS * HEAD_DIM
KV_COLS = N_KV_HEADS * HEAD_DIM
N_IN = Q_COLS + 2 * KV_COLS + 2 * SG_WIDTH + 2 * D_MODEL

kernel_name = "hybrid_gqa_sgu_convffn_encoder"


def rms_norm(x, g):
    xf = x.astype(jnp.float32)
    y = xf * lax.rsqrt(jnp.mean(xf * xf, axis=-1, keepdims=True) + EPS)
    return (y * g.astype(jnp.float32)).astype(x.dtype)


def layer_norm(x, g, b):
    xf = x.astype(jnp.float32)
    mu = jnp.mean(xf, axis=-1, keepdims=True)
    xc = xf - mu
    y = xc * lax.rsqrt(jnp.mean(xc * xc, axis=-1, keepdims=True) + EPS)
    return (y * g.astype(jnp.float32) + b.astype(jnp.float32)).astype(x.dtype)


def axial_rope_tables(seq_len, dtype):
    rows = seq_len // GRID_W
    t = jnp.arange(rows * GRID_W)
    row = (t // GRID_W).astype(jnp.float32)
    col = (t % GRID_W).astype(jnp.float32)
    quarter = HEAD_DIM // 4
    inv = ROPE_BASE ** (-jnp.arange(quarter, dtype=jnp.float32) / quarter)
    ang_r = row[:, None] * inv[None, :]
    ang_c = col[:, None] * inv[None, :]
    ang = jnp.concatenate([ang_r, ang_r, ang_c, ang_c], axis=-1)
    return jnp.cos(ang).astype(dtype), jnp.sin(ang).astype(dtype)


def apply_rope(x, cos, sin):
    quarter = HEAD_DIM // 4
    x4 = x.reshape(x.shape[:-1] + (2, 2, quarter))
    rot = jnp.stack([-x4[..., 1, :], x4[..., 0, :]], axis=-2).reshape(x.shape)
    return x * cos[None, :, None, :] + rot * sin[None, :, None, :]


def grid_attention(q, k, v):
    B, S = q.shape[0], q.shape[1]
    nb = S // Q_BLOCK
    grp = N_HEADS // N_KV_HEADS
    qb = q.reshape(B, nb, Q_BLOCK, N_KV_HEADS, grp, HEAD_DIM).transpose(1, 0, 2, 3, 4, 5)
    scale = HEAD_DIM ** -0.5

    def block(qi):
        s = jnp.einsum('bqkgd,bskd->bkgqs', qi, k).astype(jnp.float32) * scale
        p = jax.nn.softmax(s, axis=-1).astype(v.dtype)
        return jnp.einsum('bkgqs,bskd->bqkgd', p, v)

    o = lax.map(block, qb)
    return o.transpose(1, 0, 2, 3, 4, 5).reshape(B, S, N_HEADS * HEAD_DIM)


def spatial_gating(z, ln_g, ln_b, w_s, b_s):
    B, S = z.shape[0], z.shape[1]
    u, v = jnp.split(z, 2, axis=-1)
    v = layer_norm(v, ln_g, ln_b)
    nc = S // SG_CHUNK
    cg = SG_WIDTH // SG_GROUPS
    vc = v.reshape(B, nc, SG_CHUNK, SG_GROUPS, cg)
    mixed = jnp.einsum('gpq,bnqgc->bnpgc', w_s, vc) + b_s.T[:, :, None]
    return u * mixed.reshape(B, S, SG_WIDTH)


def memory_attention(h, mem, w_xq, w_xkv, w_xo):
    B, S = h.shape[0], h.shape[1]
    n_mem = mem.shape[1]
    q = (h @ w_xq).reshape(B, S, X_HEADS, X_HEAD_DIM)
    k, v = jnp.split(mem @ w_xkv, 2, axis=-1)
    k = k.reshape(B, n_mem, X_HEADS, X_HEAD_DIM)
    v = v.reshape(B, n_mem, X_HEADS, X_HEAD_DIM)
    s = jnp.einsum('bshd,bnhd->bhsn', q, k).astype(jnp.float32) * (X_HEAD_DIM ** -0.5)
    p = jax.nn.softmax(s, axis=-1).astype(v.dtype)
    o = jnp.einsum('bhsn,bnhd->bshd', p, v).reshape(B, S, D_MODEL)
    return o @ w_xo


def depthwise_conv(a, w, b):
    S = a.shape[1]
    pad = CONV_W // 2
    ap = jnp.pad(a, ((0, 0), (pad, CONV_W - 1 - pad), (0, 0)))
    out = b
    for j in range(CONV_W):
        out = out + ap[:, j:j + S] * w[j]
    return out


def trunk(x, mem, params):
    (norm_mix_g, w_in, q_norm_g, k_norm_g, w_attn_o, sg_norm_g, sg_norm_b,
     w_spatial, b_spatial, w_sg_o, w_out, norm_x_g, norm_mem_g, w_xq, w_xkv,
     w_xo, norm_ffn_g, w_ffn_up, conv_w, conv_b, w_ffn_down, final_norm_g) = params
    B, S = x.shape[0], x.shape[1]
    cos, sin = axial_rope_tables(S, x.dtype)
    splits = [Q_COLS, Q_COLS + KV_COLS, Q_COLS + 2 * KV_COLS, Q_COLS + 2 * KV_COLS + 2 * SG_WIDTH]
    for l in range(DEPTH):
        h = rms_norm(x, norm_mix_g[l])
        q, k, v, z, gates = jnp.split(h @ w_in[l], splits, axis=-1)
        q = apply_rope(rms_norm(q.reshape(B, S, N_HEADS, HEAD_DIM), q_norm_g[l]), cos, sin)
        k = apply_rope(rms_norm(k.reshape(B, S, N_KV_HEADS, HEAD_DIM), k_norm_g[l]), cos, sin)
        v = v.reshape(B, S, N_KV_HEADS, HEAD_DIM)
        branch_a = grid_attention(q, k, v) @ w_attn_o[l]
        branch_s = spatial_gating(jax.nn.gelu(z), sg_norm_g[l], sg_norm_b[l],
                                  w_spatial[l], b_spatial[l]) @ w_sg_o[l]
        g_a, g_s = jnp.split(jax.nn.sigmoid(gates), 2, axis=-1)
        x = x + (g_a * branch_a + g_s * branch_s) @ w_out[l]
        x = x + memory_attention(rms_norm(x, norm_x_g[l]), rms_norm(mem, norm_mem_g[l]),
                                 w_xq[l], w_xkv[l], w_xo[l])
        h = rms_norm(x, norm_ffn_g[l])
        a, b = jnp.split(h @ w_ffn_up[l], 2, axis=-1)
        a = depthwise_conv(a, conv_w[l], conv_b[l])
        x = x + (jax.nn.gelu(a) * b) @ w_ffn_down[l]
    return rms_norm(x, final_norm_g)


def setup_inputs(seed: int = 0) -> dict:
    key = jax.random.key(seed)
    ks = jax.random.split(key, 32)

    def nrm(k, shape, scale):
        return jax.random.normal(k, shape, dtype=jnp.float32) * scale

    def gain(k, shape):
        return 1.0 + nrm(k, shape, 0.02)

    return {
        "x_prompt": nrm(ks[0], (BATCH, SEQ, D_MODEL), 1.0),
        "x_sample": nrm(ks[1], (DEC_BATCH, DEC_SEQ, D_MODEL), 1.0),
        "mem_prompt": nrm(ks[2], (BATCH, N_MEM, D_MODEL), 1.0),
        "mem_sample": nrm(ks[3], (DEC_BATCH, N_MEM, D_MODEL), 1.0),
        "norm_mix_g": gain(ks[4], (DEPTH, D_MODEL)),
        "w_in": nrm(ks[5], (DEPTH, D_MODEL, N_IN), D_MODEL ** -0.5),
        "q_norm_g": gain(ks[6], (DEPTH, HEAD_DIM)),
        "k_norm_g": gain(ks[7], (DEPTH, HEAD_DIM)),
        "w_attn_o": nrm(ks[8], (DEPTH, Q_COLS, D_MODEL), Q_COLS ** -0.5),
        "sg_norm_g": gain(ks[9], (DEPTH, SG_WIDTH)),
        "sg_norm_b": nrm(ks[10], (DEPTH, SG_WIDTH), 0.02),
        "w_spatial": nrm(ks[11], (DEPTH, SG_GROUPS, SG_CHUNK, SG_CHUNK), 0.5 * SG_CHUNK ** -0.5),
        "b_spatial": 1.0 + nrm(ks[12], (DEPTH, SG_GROUPS, SG_CHUNK), 0.02),
        "w_sg_o": nrm(ks[13], (DEPTH, SG_WIDTH, D_MODEL), SG_WIDTH ** -0.5),
        "w_out": nrm(ks[14], (DEPTH, D_MODEL, D_MODEL), D_MODEL ** -0.5),
        "norm_x_g": gain(ks[15], (DEPTH, D_MODEL)),
        "norm_mem_g": gain(ks[16], (DEPTH, D_MODEL)),
        "w_xq": nrm(ks[17], (DEPTH, D_MODEL, D_MODEL), D_MODEL ** -0.5),
        "w_xkv": nrm(ks[18], (DEPTH, D_MODEL, 2 * D_MODEL), D_MODEL ** -0.5),
        "w_xo": nrm(ks[19], (DEPTH, D_MODEL, D_MODEL), D_MODEL ** -0.5),
        "norm_ffn_g": gain(ks[20], (DEPTH, D_MODEL)),
        "w_ffn_up": nrm(ks[21], (DEPTH, D_MODEL, 2 * D_FF), D_MODEL ** -0.5),
        "conv_w": nrm(ks[22], (DEPTH, CONV_W, D_FF), CONV_W ** -0.5),
        "conv_b": nrm(ks[23], (DEPTH, D_FF), 0.02),
        "w_ffn_down": nrm(ks[24], (DEPTH, D_FF, D_MODEL), D_FF ** -0.5),
        "final_norm_g": gain(ks[25], (D_MODEL,)),
    }


def reference(x_prompt, x_sample, mem_prompt, mem_sample, norm_mix_g, w_in, q_norm_g,
              k_norm_g, w_attn_o, sg_norm_g, sg_norm_b, w_spatial, b_spatial, w_sg_o,
              w_out, norm_x_g, norm_mem_g, w_xq, w_xkv, w_xo, norm_ffn_g, w_ffn_up,
              conv_w, conv_b, w_ffn_down, final_norm_g):
    params = (norm_mix_g, w_in, q_norm_g, k_norm_g, w_attn_o, sg_norm_g, sg_norm_b,
              w_spatial, b_spatial, w_sg_o, w_out, norm_x_g, norm_mem_g, w_xq, w_xkv,
              w_xo, norm_ffn_g, w_ffn_up, conv_w, conv_b, w_ffn_down, final_norm_g)
    y_prompt = trunk(x_prompt, mem_prompt, params)
    y_sample = trunk(x_sample, mem_sample, params)
    return (y_prompt, y_sample)
```

```cpp
#include <hip/hip_runtime.h>
#include <hip/hip_bf16.h>
#include <cstdio>
#include <cstdint>

#ifndef ONLY
#define ONLY -1
#endif
#define PH(n) (ONLY < 0 || ONLY == (n))
constexpr int DM = 2048, NB = 20, SEQ = 2048, T = NB * SEQ, DEPTH = 4;
constexpr int NIN = 11264, DFF = 5632, HFF = DFF / 2  , NMEM = 256, MEMROWS = NB * NMEM;
constexpr int C_Q = 0, C_K = 2048, C_V = 2560, C_U = 3072, C_VS = 5120, C_GA = 7168, C_GS = 9216;
constexpr float EPS = 1e-6f;

namespace pg8 {
#define PG8_LAS __attribute__((address_space(3)))
typedef unsigned short bf16_t;
typedef short bf16x8 __attribute__((ext_vector_type(8)));
typedef float f32x4 __attribute__((ext_vector_type(4)));
typedef float f32x2 __attribute__((ext_vector_type(2)));
typedef unsigned u32x4 __attribute__((ext_vector_type(4)));
constexpr int BM = 256, BK = 64, HALF = 128, HTB = HALF * BK * 2, STAGE_BYTES = 8 * HTB, NXCD = 8, WGM = 4;

__host__ __device__ __forceinline__ int lds_byte(int r, int c) { const int st = (r >> 4) * 2 + (c >> 5), rr = r & 15, cc = c & 31, ob = rr * 64 + cc * 2; return st * 1024 + (ob ^ (((ob >> 9) & 1) << 5)); }
__host__ __device__ __forceinline__ void stage_rc(int b, int& R, int& C) { const int st = b / 1024, sb = b % 1024, swz = sb ^ (((sb >> 9) & 1) << 5); R = (st >> 1) * 16 + swz / 64; C = (st & 1) * 32 + (swz % 64) / 2; }
__host__ __device__ __forceinline__ int perm32(int rho) { const int n = rho >> 4, i = rho & 15; return 8 * (i >> 2) + 4 * n + (i & 3); }

struct Unit { int z1, z2, pm, pn; };
struct Gemm { const bf16_t* A; const bf16_t* Bt; int lda, ldb, K; long aS1, aS2, bS1, bS2; long jA = 0, jB = 0; int tj = 0; };
struct Sched {
    int Z2, nM, nN, nwg, G, c, rev;
    __device__ __forceinline__ void init(int Z, int Z2_, int nM_, int nN_, int G_, int c_, int rev_ = 0) { Z2 = Z2_; nM = nM_; nN = nN_; nwg = Z * nM_ * nN_; G = G_; c = c_; rev = rev_; }
    __device__ __forceinline__ bool next(int i, Unit& u) const {
        int nM = this->nM, nN = this->nN, Z2 = this->Z2; asm volatile("" : "+s"(nM), "+s"(nN), "+s"(Z2));
        const long L = (long)i * G + c; if (L >= nwg) return false;
        int wgid = (int)L; { const int q = nwg / NXCD, r = nwg % NXCD, xcd = wgid % NXCD, off = wgid / NXCD; wgid = (xcd < r ? xcd * (q + 1) : r * (q + 1) + (xcd - r) * q) + off; }
        if (rev) wgid = nwg - 1 - wgid;
        const int per = nM * nN, z = wgid / per, rem = wgid - z * per;
        const int nig = WGM * nN, gid = rem / nig, fm = gid * WGM, gsz = (nM - fm) < WGM ? (nM - fm) : WGM, ri = rem - gid * nig;
        u.pm = fm + (ri % gsz); u.pn = ri / gsz; u.z1 = z / Z2; u.z2 = z - u.z1 * Z2; return true;
    }
};
__device__ __forceinline__ const char* a_tile(const Gemm& g, const Unit& u) { return (const char*)(g.A + ((long)u.z1 * g.aS1 + (long)u.z2 * g.aS2 + (long)u.pm * BM * g.lda)); }
__device__ __forceinline__ const char* b_tile(const Gemm& g, const Unit& u) { return (const char*)(g.Bt + ((long)u.z1 * g.bS1 + (long)u.z2 * g.bS2 + (long)u.pn * BM * g.ldb)); }

__device__ __forceinline__ unsigned cvt_pk_bf16(float lo, float hi) { unsigned r; asm volatile("v_cvt_pk_bf16_f32 %0, %1, %2" : "=v"(r) : "v"(lo), "v"(hi)); return r; }
__device__ __forceinline__ float bf_lo(unsigned w) { return __uint_as_float(w << 16); }
__device__ __forceinline__ float bf_hi(unsigned w) { return __uint_as_float(w & 0xffff0000u); }
__device__ __forceinline__ float gelu_t(float x) { const float e = __builtin_amdgcn_exp2f(x * (-2.302208198f - 0.1029432397f * x * x)); return x * __builtin_amdgcn_rcpf(1.0f + e); }
__device__ __forceinline__ float sigm(float x) { return __builtin_amdgcn_rcpf(1.0f + __builtin_amdgcn_exp2f(-1.4426950409f * x)); }
__device__ __forceinline__ f32x2 gelu_t2(f32x2 x) { const f32x2 t = x * x, u = t * (-0.1029432397f) + (-2.302208198f), a = x * u;
    f32x2 e; e.x = __builtin_amdgcn_exp2f(a.x); e.y = __builtin_amdgcn_exp2f(a.y); const f32x2 d = e + 1.0f;
    f32x2 r; r.x = __builtin_amdgcn_rcpf(d.x); r.y = __builtin_amdgcn_rcpf(d.y); return x * r; }
__device__ __forceinline__ f32x2 sigm2(f32x2 x) { const f32x2 a = x * (-1.4426950409f);
    f32x2 e; e.x = __builtin_amdgcn_exp2f(a.x); e.y = __builtin_amdgcn_exp2f(a.y); const f32x2 d = e + 1.0f;
    f32x2 r; r.x = __builtin_amdgcn_rcpf(d.x); r.y = __builtin_amdgcn_rcpf(d.y); return r; }
#define ACT4(v, F) do { const f32x2 _lo = F((f32x2){v[0], v[1]}), _hi = F((f32x2){v[2], v[3]}); v = (f32x4){_lo.x, _lo.y, _hi.x, _hi.y}; } while (0)

__device__ __forceinline__ int lane_id_opq() { int l; asm volatile("v_mbcnt_lo_u32_b32 %0, -1, 0\n\tv_mbcnt_hi_u32_b32 %0, -1, %0" : "=v"(l)); return l; }
__device__ __forceinline__ float shx(float v, int mask, int lane) { return __int_as_float(__builtin_amdgcn_ds_bpermute((lane ^ mask) << 2, __float_as_int(v))); }
typedef f32x4 Acc[2][2][4][2];
#define EPI_ARGS Acc& acc, const Unit& u, int wr, int wc, int fr, int fq, PG8_LAS unsigned char* xl, const float (&pre)[8]

#define PACK8(w, v0, v1) do { w.x = cvt_pk_bf16(v0[0], v0[1]); w.y = cvt_pk_bf16(v0[2], v0[3]); w.z = cvt_pk_bf16(v1[0], v1[1]); w.w = cvt_pk_bf16(v1[2], v1[3]); } while (0)
#define MUL8(v0, v1, g) do { v0[0] *= bf_lo(g.x); v0[1] *= bf_hi(g.x); v0[2] *= bf_lo(g.y); v0[3] *= bf_hi(g.y); v1[0] *= bf_lo(g.z); v1[1] *= bf_hi(g.z); v1[2] *= bf_lo(g.w); v1[3] *= bf_hi(g.w); } while (0)
#define ADD8(v0, v1, g) do { v0[0] += bf_lo(g.x); v0[1] += bf_hi(g.x); v0[2] += bf_lo(g.y); v0[3] += bf_hi(g.y); v1[0] += bf_lo(g.z); v1[1] += bf_hi(g.z); v1[2] += bf_lo(g.w); v1[3] += bf_hi(g.w); } while (0)
#define ROW_RS8(rs, stats, row0) do { f32x4 _a[2][4], _b[2][4]; \
    _Pragma("unroll") for (int ai = 0; ai < 2; ++ai) _Pragma("unroll") for (int m = 0; m < 4; ++m) { const float* _p = (stats) + (size_t)((row0) + ai * HALF + m * 16) * 8; _a[ai][m] = *(const f32x4*)_p; _b[ai][m] = *(const f32x4*)(_p + 4); } \
    _Pragma("unroll") for (int ai = 0; ai < 2; ++ai) _Pragma("unroll") for (int m = 0; m < 4; ++m) \
        rs[ai][m] = 1.0f / sqrtf(((_a[ai][m][0] + _a[ai][m][1]) + (_a[ai][m][2] + _a[ai][m][3]) + (_b[ai][m][0] + _b[ai][m][1]) + (_b[ai][m][2] + _b[ai][m][3])) * (1.0f / 2048.0f) + 1e-6f); } while (0)
__device__ __forceinline__ void gate2(f32x2& a, f32x2& s, float k) { const f32x2 ta = a * k, ts = s * k;
    f32x2 ea, es; ea.x = __builtin_amdgcn_exp2f(ta.x); ea.y = __builtin_amdgcn_exp2f(ta.y); es.x = __builtin_amdgcn_exp2f(ts.x); es.y = __builtin_amdgcn_exp2f(ts.y);
    const f32x2 da = ea + 1.0f, ds = es + 1.0f;
    f32x2 ra, rs; ra.x = __builtin_amdgcn_rcpf(da.x); ra.y = __builtin_amdgcn_rcpf(da.y); rs.x = __builtin_amdgcn_rcpf(ds.x); rs.y = __builtin_amdgcn_rcpf(ds.y);
    a = ds * ra; s = rs; }
#define GATE4(a, s, k) do { f32x2 _al = {a[0], a[1]}, _ah = {a[2], a[3]}, _sl = {s[0], s[1]}, _sh = {s[2], s[3]}; gate2(_al, _sl, k); gate2(_ah, _sh, k); \
    a = (f32x4){_al.x, _al.y, _ah.x, _ah.y}; s = (f32x4){_sl.x, _sl.y, _sh.x, _sh.y}; } while (0)
template <int MODE, bool PRE_ = false> struct EpiBf16 {
    static constexpr bool MID = false, PERM = true, PRE = PRE_;
    bf16_t* C; int ldc; long cS1, cS2; const float* stats;
    float* lnst; int pn0 = 0;
    __device__ __forceinline__ const float* pre_base(const Unit& u) const { return stats + (size_t)u.pm * BM; }
    __device__ __forceinline__ void operator()(EPI_ARGS) const {
        const int pn = u.pn + pn0;
        int act = 0; if (MODE == 1) act = pn < 20 ? 0 : (pn < 28 ? 1 : 2);
        const bool lnrows = (MODE == 1) && pn >= 20 && pn < 28;
        char* ub = (char*)(C + (long)u.z1 * cS1 + (long)u.z2 * cS2 + (long)u.pm * BM * ldc + pn * BM);
        const unsigned lo = (unsigned)((wr * 64 + fr) * ldc + wc * 32 + 8 * fq) * 2u;
        float rs[2][4];
        if (PRE) {
#pragma unroll
            for (int ai = 0; ai < 2; ++ai)
#pragma unroll
                for (int m = 0; m < 4; ++m) rs[ai][m] = pre[ai * 4 + m]; }
        else if (stats) ROW_RS8(rs, stats, u.pm * BM + wr * 64 + fr);
        else {
#pragma unroll
            for (int ai = 0; ai < 2; ++ai)
#pragma unroll
                for (int m = 0; m < 4; ++m) rs[ai][m] = 1.0f; }
        if (MODE == 1 && act == 2) {
            char* g0 = (char*)(C + (long)u.pm * BM * ldc + C_GA + 128 * (pn - 28));
#pragma unroll
            for (int ai = 0; ai < 2; ++ai)
#pragma unroll
                for (int m = 0; m < 4; ++m) { char* rb = g0 + (size_t)(ai * HALF + m * 16) * ldc * 2;
                    f32x4 a0 = acc[ai][0][m][0], a1 = acc[ai][0][m][1], s0 = acc[ai][1][m][0], s1 = acc[ai][1][m][1]; const float kk = rs[ai][m] * (-1.4426950409f);
                    GATE4(a0, s0, kk); GATE4(a1, s1, kk);
                    { u32x4 w; PACK8(w, a0, a1); *(u32x4*)(rb + lo) = w; }
                    { u32x4 w; PACK8(w, s0, s1); *(u32x4*)(rb + lo + (C_GS - C_GA) * 2) = w; } }
            return; }
#pragma unroll
        for (int ai = 0; ai < 2; ++ai)
#pragma unroll
            for (int m = 0; m < 4; ++m) { char* rb = ub + (size_t)(ai * HALF + m * 16) * ldc * 2;
                float s1 = 0.f, s2 = 0.f;
#pragma unroll
                for (int bj = 0; bj < 2; ++bj) { f32x4 v0 = acc[ai][bj][m][0] * rs[ai][m], v1 = acc[ai][bj][m][1] * rs[ai][m];
                    if (act == 1) { ACT4(v0, gelu_t2); ACT4(v1, gelu_t2); }
                    else if (act == 2) { ACT4(v0, sigm2); ACT4(v1, sigm2); }
                    u32x4 w; PACK8(w, v0, v1);
                    *(u32x4*)(rb + lo + bj * 256) = w;
                    if (MODE == 1 && lnrows) { const f32x4 t = v0 + v1, q = v0 * v0 + v1 * v1; s1 += (t[0] + t[1]) + (t[2] + t[3]); s2 += (q[0] + q[1]) + (q[2] + q[3]); } }
                if (MODE == 1 && lnrows) { const int ln = fq * 16 + fr; s1 += shx(s1, 16, ln); s1 += shx(s1, 32, ln); s2 += shx(s2, 16, ln); s2 += shx(s2, 32, ln);
                    if (fq == 0) ((PG8_LAS f32x2*)xl)[(ai * HALF + wr * 64 + m * 16 + fr) * 4 + wc] = (f32x2){s1, s2}; } }
        if (MODE == 1 && lnrows) {
            asm volatile("s_waitcnt lgkmcnt(0)" ::: "memory"); __builtin_amdgcn_s_barrier(); asm volatile("" ::: "memory");
            if (fq == 0) {
#pragma unroll
                for (int ai = 0; ai < 2; ++ai) { const int r = ai * HALF + wr * 64 + wc * 16 + fr; const PG8_LAS f32x2* q = (const PG8_LAS f32x2*)xl + r * 4;
                    const f32x2 a = q[0], b = q[1], c = q[2], d = q[3];
                    *(f32x2*)(lnst + ((size_t)(u.pm * BM + r) * 8 + (pn - 20)) * 2) = (f32x2){(a.x + b.x) + (c.x + d.x), (a.y + b.y) + (c.y + d.y)}; } }
        }
    }
};
struct EpiRes {
    static constexpr bool MID = false, PERM = true, PRE = false;
    bf16_t* XB; int ldc; long cS1; float* stats; int rows_per_z;
    __device__ __forceinline__ void operator()(EPI_ARGS) const {
        char* ub = (char*)(XB + (long)u.z1 * cS1 + (long)u.pm * BM * ldc + u.pn * BM);
        const unsigned lo = (unsigned)((wr * 64 + fr) * ldc + wc * 32 + 8 * fq) * 2u;
        PG8_LAS float* XS = (PG8_LAS float*)xl;
        const int ln = fq * 16 + fr;
        u32x4 xq[2][4][2];
#pragma unroll
        for (int ai = 0; ai < 2; ++ai)
#pragma unroll
            for (int m = 0; m < 4; ++m)
#pragma unroll
                for (int bj = 0; bj < 2; ++bj) xq[ai][m][bj] = *(const u32x4*)(ub + (size_t)(ai * HALF + m * 16) * ldc * 2 + lo + bj * 256);
        asm volatile("" ::: "memory");
#pragma unroll
        for (int ai = 0; ai < 2; ++ai)
#pragma unroll
            for (int m = 0; m < 4; ++m) { float ss = 0.f;
#pragma unroll
                for (int bj = 0; bj < 2; ++bj) { f32x4 v0 = acc[ai][bj][m][0], v1 = acc[ai][bj][m][1];
                    ADD8(v0, v1, xq[ai][m][bj]);
                    u32x4 w; PACK8(w, v0, v1); *(u32x4*)(ub + (size_t)(ai * HALF + m * 16) * ldc * 2 + lo + bj * 256) = w;
                    ss += (v0[0] * v0[0] + v0[1] * v0[1]) + (v0[2] * v0[2] + v0[3] * v0[3]) + (v1[0] * v1[0] + v1[1] * v1[1]) + (v1[2] * v1[2] + v1[3] * v1[3]); }
                ss += shx(ss, 16, ln); ss += shx(ss, 32, ln); if (fq == 0) XS[(ai * HALF + wr * 64 + m * 16 + fr) * 4 + wc] = ss; }
        asm volatile("s_waitcnt lgkmcnt(0)" ::: "memory"); __builtin_amdgcn_s_barrier(); asm volatile("" ::: "memory");
        if (fq == 0) {
#pragma unroll
            for (int ai = 0; ai < 2; ++ai) { const int r = ai * HALF + wr * 64 + wc * 16 + fr; const f32x4 q = *(const PG8_LAS f32x4*)(XS + r * 4);
                stats[((size_t)u.z1 * rows_per_z + u.pm * BM + r) * 8 + u.pn] = (q[0] + q[1]) + (q[2] + q[3]); } }
    }
};
template <bool FIRST> struct EpiMix {
    static constexpr bool MID = false, PERM = true, PRE = false;
    const bf16_t* G; bf16_t* O; int ld;
    __device__ __forceinline__ void operator()(EPI_ARGS) const {
        const long uo = (long)u.pm * BM * ld + u.pn * BM;
        const char* gb = (const char*)(G + uo); char* ob = (char*)(O + uo);
        const unsigned lo = (unsigned)((wr * 64 + fr) * ld + wc * 32 + 8 * fq) * 2u;
#pragma unroll
        for (int ai = 0; ai < 2; ++ai) {
            u32x4 gq[4][2], oq[4][2];
#pragma unroll
            for (int m = 0; m < 4; ++m)
#pragma unroll
                for (int bj = 0; bj < 2; ++bj) { const size_t ro = (size_t)(ai * HALF + m * 16) * ld * 2; gq[m][bj] = *(const u32x4*)(gb + ro + lo + bj * 256); if (!FIRST) oq[m][bj] = *(const u32x4*)(ob + ro + lo + bj * 256); }
            asm volatile("" ::: "memory");
#pragma unroll
            for (int m = 0; m < 4; ++m)
#pragma unroll
                for (int bj = 0; bj < 2; ++bj) { const size_t ro = (size_t)(ai * HALF + m * 16) * ld * 2;
                    f32x4 v0 = acc[ai][bj][m][0], v1 = acc[ai][bj][m][1];
                    MUL8(v0, v1, gq[m][bj]);
                    if (!FIRST) ADD8(v0, v1, oq[m][bj]);
                    u32x4 w; PACK8(w, v0, v1);
                    *(u32x4*)(ob + ro + lo + bj * 256) = w; }
            asm volatile("" ::: "memory"); }
    }
};
struct EpiMixF {
    static constexpr bool MID = true, PERM = true, PRE = false;
    const bf16_t* GA; const bf16_t* GS; bf16_t* O; int ld;
    __device__ __forceinline__ void mid(Acc& acc, const Unit& u, int wr, int wc, int fr, int fq) const {
        const char* ab = (const char*)(GA + ((long)u.pm * BM * ld + u.pn * BM));
        const unsigned lo = (unsigned)((wr * 64 + fr) * ld + wc * 32 + 8 * fq) * 2u;
#pragma unroll
        for (int ai = 0; ai < 2; ++ai) {
            u32x4 aq[4][2];
#pragma unroll
            for (int m = 0; m < 4; ++m)
#pragma unroll
                for (int bj = 0; bj < 2; ++bj) aq[m][bj] = *(const u32x4*)(ab + (size_t)(ai * HALF + m * 16) * ld * 2 + lo + bj * 256);
            asm volatile("" ::: "memory");
#pragma unroll
            for (int m = 0; m < 4; ++m)
#pragma unroll
                for (int bj = 0; bj < 2; ++bj) MUL8(acc[ai][bj][m][0], acc[ai][bj][m][1], aq[m][bj]);
            asm volatile("" ::: "memory"); }
    }
    __device__ __forceinline__ void operator()(EPI_ARGS) const {
        const long uo = (long)u.pm * BM * ld + u.pn * BM;
        const char* gb = (const char*)(GS + uo); char* ob = (char*)(O + uo);
        const unsigned lo = (unsigned)((wr * 64 + fr) * ld + wc * 32 + 8 * fq) * 2u;
#pragma unroll
        for (int ai = 0; ai < 2; ++ai) {
            u32x4 gq[4][2];
#pragma unroll
            for (int m = 0; m < 4; ++m)
#pragma unroll
                for (int bj = 0; bj < 2; ++bj) { const size_t ro = (size_t)(ai * HALF + m * 16) * ld * 2; gq[m][bj] = *(const u32x4*)(gb + ro + lo + bj * 256); }
            asm volatile("" ::: "memory");
#pragma unroll
            for (int m = 0; m < 4; ++m)
#pragma unroll
                for (int bj = 0; bj < 2; ++bj) { const size_t ro = (size_t)(ai * HALF + m * 16) * ld * 2;
                    f32x4 v0 = acc[ai][bj][m][0], v1 = acc[ai][bj][m][1];
                    MUL8(v0, v1, gq[m][bj]);
                    u32x4 w; PACK8(w, v0, v1);
                    *(u32x4*)(ob + ro + lo + bj * 256) = w; }
            asm volatile("" ::: "memory"); }
    }
};
struct EpiSpatial {
    static constexpr bool MID = false, PERM = true, PRE = false;
    bf16_t* U; int ld; const float* bs;
    __device__ __forceinline__ void operator()(EPI_ARGS) const {
        char* ub = (char*)(U + (long)u.z1 * BM * ld + u.z2 * BM);
        const unsigned lo = (unsigned)((wr * 64 + fr) * ld + wc * 32 + 8 * fq) * 2u;
        const float* bp = bs + u.z2 * 128 + wr * 64;
        u32x4 uq[2][4][2]; float bq[4];
#pragma unroll
        for (int m = 0; m < 4; ++m) bq[m] = bp[m * 16 + fr];
#pragma unroll
        for (int ai = 0; ai < 2; ++ai)
#pragma unroll
            for (int m = 0; m < 4; ++m)
#pragma unroll
                for (int bj = 0; bj < 2; ++bj) uq[ai][m][bj] = *(const u32x4*)(ub + (size_t)(ai * HALF + m * 16) * ld * 2 + lo + bj * 256);
        asm volatile("" ::: "memory");
#pragma unroll
        for (int ai = 0; ai < 2; ++ai)
#pragma unroll
            for (int m = 0; m < 4; ++m)
#pragma unroll
                for (int bj = 0; bj < 2; ++bj) {
                    const u32x4 q = uq[ai][m][bj];
                    f32x4 u0 = (f32x4){bf_lo(q.x), bf_hi(q.x), bf_lo(q.y), bf_hi(q.y)}, u1 = (f32x4){bf_lo(q.z), bf_hi(q.z), bf_lo(q.w), bf_hi(q.w)};
                    ACT4(u0, gelu_t2); ACT4(u1, gelu_t2);
                    const f32x4 v0 = (acc[ai][bj][m][0] + bq[m]) * u0, v1 = (acc[ai][bj][m][1] + bq[m]) * u1;
                    u32x4 w; PACK8(w, v0, v1);
                    *(u32x4*)(ub + (size_t)(ai * HALF + m * 16) * ld * 2 + lo + bj * 256) = w; }
    }
};
#define DPP_SHR1 0x111
#define DPP_SHL1 0x101
#define DPP_ROR1 0x121
#define DPP_ROR15 0x12F
#define DPPI(old, src, ctrl) ((unsigned)__builtin_amdgcn_update_dpp((int)(old), (int)(src), ctrl, 0xF, 0xF, false))
struct EpiConv {
    static constexpr bool MID = false, PERM = true, PRE = true;
    __device__ __forceinline__ const float* pre_base(const Unit& u) const { return stats + (size_t)u.pm * BM; }
    const bf16_t* A; bf16_t* O; int ld; const float* stats; const float* cw; const float* cb;
    __device__ __forceinline__ void operator()(EPI_ARGS) const {
        {
#pragma unroll
          for (int ai = 0; ai < 2; ++ai)
#pragma unroll
            for (int m = 0; m < 4; ++m)
#pragma unroll
                for (int bj = 0; bj < 2; ++bj) { acc[ai][bj][m][0] *= pre[ai * 4 + m]; acc[ai][bj][m][1] *= pre[ai * 4 + m]; } }
        const long uo = (long)u.pm * BM * ld + u.pn * BM;
        const char* ab = (const char*)(A + uo); char* ob = (char*)(O + uo);
        const int ld2 = ld * 2;
        const unsigned lo = (unsigned)((wr * 64 + fr) * ld + wc * 32 + 8 * fq) * 2u;
        const unsigned loe = (unsigned)((wr * 64) * ld + wc * 32 + 8 * fq) * 2u;
        const int pm8 = u.pm & 7;
#pragma unroll
        for (int bj = 0; bj < 2; ++bj) {
            const float* pp = cw + u.pn * BM + bj * HALF + wc * 32 + 8 * fq; const float* pb = cb + u.pn * BM + bj * HALF + wc * 32 + 8 * fq;
            const f32x4 w0a = *(const f32x4*)pp, w0b = *(const f32x4*)(pp + 4), w1a = *(const f32x4*)(pp + ld), w1b = *(const f32x4*)(pp + ld + 4),
                        w2a = *(const f32x4*)(pp + 2 * ld), w2b = *(const f32x4*)(pp + 2 * ld + 4), cba = *(const f32x4*)pb, cbb = *(const f32x4*)(pb + 4);
#pragma unroll
            for (int ai = 0; ai < 2; ++ai) {
                const bool tz = (pm8 == 0) && (ai == 0) && (wr == 0), bz = (pm8 == 7) && (ai == 1) && (wr == 1);
                u32x4 qc[4], et, eb;
#pragma unroll
                for (int m = 0; m < 4; ++m) qc[m] = *(const u32x4*)(ab + (size_t)(ai * HALF + m * 16) * ld2 + lo + bj * 256);
                et = *(const u32x4*)(ab + (long)(ai * HALF + (tz ? 0 : -1)) * ld2 + loe + bj * 256);
                eb = *(const u32x4*)(ab + (long)(ai * HALF + (bz ? 63 : 64)) * ld2 + loe + bj * 256);
                asm volatile("" ::: "memory");
                if (tz) et = (u32x4){0u, 0u, 0u, 0u};
                if (bz) eb = (u32x4){0u, 0u, 0u, 0u};
#pragma unroll
                for (int m = 0; m < 4; ++m) {
                    u32x4 zp, zn; const u32x4 zc = qc[m];
#pragma unroll
                    for (int d = 0; d < 4; ++d) {
                        const unsigned X = (m == 0) ? et[d] : DPPI(0, qc[m > 0 ? m - 1 : 0][d], DPP_ROR1);
                        zp[d] = DPPI(X, zc[d], DPP_SHR1);
                        const unsigned Y = (m == 3) ? eb[d] : DPPI(0, qc[m < 3 ? m + 1 : 3][d], DPP_ROR15);
                        zn[d] = DPPI(Y, zc[d], DPP_SHL1); }
#define UNP4(lo4, hi4, QQ) const f32x4 lo4 = (f32x4){bf_lo(QQ.x), bf_hi(QQ.x), bf_lo(QQ.y), bf_hi(QQ.y)}, hi4 = (f32x4){bf_lo(QQ.z), bf_hi(QQ.z), bf_lo(QQ.w), bf_hi(QQ.w)}
                    UNP4(pl, ph, zp); UNP4(cl, ch, zc); UNP4(nl, nh, zn);
#undef UNP4
                    f32x4 c0 = cba + w0a * pl + w1a * cl + w2a * nl, c1 = cbb + w0b * ph + w1b * ch + w2b * nh;
                    ACT4(c0, gelu_t2); ACT4(c1, gelu_t2);
                    const f32x4 v0 = acc[ai][bj][m][0] * c0, v1 = acc[ai][bj][m][1] * c1;
                    u32x4 w; PACK8(w, v0, v1);
                    *(u32x4*)(ob + (size_t)(ai * HALF + m * 16) * ld2 + lo + bj * 256) = w; }
                asm volatile("" ::: "memory"); }
        }
    }
};
struct EpiUp {
    static constexpr bool MID = false, PERM = true, PRE = true;
    bf16_t* O; int ldo; const float* stats; const float* cw; const float* cb; float* EA; float* EB;
    __device__ __forceinline__ const float* pre_base(const Unit& u) const { return stats + (size_t)u.pm * BM; }
    __device__ __forceinline__ void operator()(EPI_ARGS) const {
#pragma unroll
        for (int ai = 0; ai < 2; ++ai)
#pragma unroll
            for (int m = 0; m < 4; ++m)
#pragma unroll
                for (int bj = 0; bj < 2; ++bj) { acc[ai][bj][m][0] *= pre[ai * 4 + m]; acc[ai][bj][m][1] *= pre[ai * 4 + m]; }
        const int ch0 = u.pn * HALF + wc * 32 + 8 * fq;
        const float* pp = cw + ch0; const float* pb = cb + ch0;
        const f32x4 w0a = *(const f32x4*)pp, w0b = *(const f32x4*)(pp + 4), w1a = *(const f32x4*)(pp + ldo), w1b = *(const f32x4*)(pp + ldo + 4),
                    w2a = *(const f32x4*)(pp + 2 * ldo), w2b = *(const f32x4*)(pp + 2 * ldo + 4), cba = *(const f32x4*)pb, cbb = *(const f32x4*)(pb + 4);
        PG8_LAS float* E = (PG8_LAS float*)xl;
        const int cl = wc * 32 + 8 * fq;
#pragma unroll
        for (int ai = 0; ai < 2; ++ai) { const int blk = ai * 2 + wr;
            if (fr == 0)  { *(PG8_LAS f32x4*)(E + (blk * 2 + 0) * HALF + cl) = acc[ai][0][0][0]; *(PG8_LAS f32x4*)(E + (blk * 2 + 0) * HALF + cl + 4) = acc[ai][0][0][1]; }
            if (fr == 15) { *(PG8_LAS f32x4*)(E + (blk * 2 + 1) * HALF + cl) = acc[ai][0][3][0]; *(PG8_LAS f32x4*)(E + (blk * 2 + 1) * HALF + cl + 4) = acc[ai][0][3][1]; } }
        asm volatile("s_waitcnt lgkmcnt(0)" ::: "memory"); __builtin_amdgcn_s_barrier(); asm volatile("" ::: "memory");
        char* ob = (char*)(O + (long)u.pm * BM * ldo + ch0);
        const unsigned lo = (unsigned)((wr * 64 + fr) * ldo) * 2u;
#define DPPF(old, src, ctrl) __uint_as_float((unsigned)__builtin_amdgcn_update_dpp((int)__float_as_uint(old), (int)__float_as_uint(src), ctrl, 0xF, 0xF, false))
#pragma unroll
        for (int ai = 0; ai < 2; ++ai) { const int blk = ai * 2 + wr;
            f32x4 et0 = (f32x4){0.f, 0.f, 0.f, 0.f}, et1 = et0, eb0 = et0, eb1 = et0;
            if (blk > 0) { et0 = *(const PG8_LAS f32x4*)(E + ((blk - 1) * 2 + 1) * HALF + cl); et1 = *(const PG8_LAS f32x4*)(E + ((blk - 1) * 2 + 1) * HALF + cl + 4); }
            if (blk < 3) { eb0 = *(const PG8_LAS f32x4*)(E + ((blk + 1) * 2 + 0) * HALF + cl); eb1 = *(const PG8_LAS f32x4*)(E + ((blk + 1) * 2 + 0) * HALF + cl + 4); }
#pragma unroll
            for (int m = 0; m < 4; ++m) {
                const f32x4 c0 = acc[ai][0][m][0], c1 = acc[ai][0][m][1]; f32x4 p0, p1, n0, n1;
#pragma unroll
                for (int e = 0; e < 4; ++e) {
                    const float X0 = (m == 0) ? et0[e] : DPPF(0.f, acc[ai][0][m > 0 ? m - 1 : 0][0][e], DPP_ROR1), X1 = (m == 0) ? et1[e] : DPPF(0.f, acc[ai][0][m > 0 ? m - 1 : 0][1][e], DPP_ROR1);
                    p0[e] = DPPF(X0, c0[e], DPP_SHR1); p1[e] = DPPF(X1, c1[e], DPP_SHR1);
                    const float Y0 = (m == 3) ? eb0[e] : DPPF(0.f, acc[ai][0][m < 3 ? m + 1 : 3][0][e], DPP_ROR15), Y1 = (m == 3) ? eb1[e] : DPPF(0.f, acc[ai][0][m < 3 ? m + 1 : 3][1][e], DPP_ROR15);
                    n0[e] = DPPF(Y0, c0[e], DPP_SHL1); n1[e] = DPPF(Y1, c1[e], DPP_SHL1); }
                f32x4 g0 = cba + w0a * p0 + w1a * c0 + w2a * n0, g1 = cbb + w0b * p1 + w1b * c1 + w2b * n1;
                ACT4(g0, gelu_t2); ACT4(g1, gelu_t2);
                const f32x4 v0 = acc[ai][1][m][0] * g0, v1 = acc[ai][1][m][1] * g1;
                u32x4 w; PACK8(w, v0, v1);
                *(u32x4*)(ob + (size_t)(ai * HALF + m * 16) * ldo * 2 + lo) = w; } }
#undef DPPF
        if (wr == 0 && fr < 2) { float* ea = EA + ((size_t)u.pm * 4 + fr) * ldo + ch0; *(f32x4*)ea = acc[0][0][0][0]; *(f32x4*)(ea + 4) = acc[0][0][0][1];
            if (fr == 0) { float* eb = EB + ((size_t)u.pm * 2 + 0) * ldo + ch0; *(f32x4*)eb = acc[0][1][0][0]; *(f32x4*)(eb + 4) = acc[0][1][0][1]; } }
        if (wr == 1 && fr >= 14) { float* ea = EA + ((size_t)u.pm * 4 + 2 + (fr - 14)) * ldo + ch0; *(f32x4*)ea = acc[1][0][3][0]; *(f32x4*)(ea + 4) = acc[1][0][3][1];
            if (fr == 15) { float* eb = EB + ((size_t)u.pm * 2 + 1) * ldo + ch0; *(f32x4*)eb = acc[1][1][3][0]; *(f32x4*)(eb + 4) = acc[1][1][3][1]; } }
    }
};
struct EpiSoftmax {
    static constexpr bool MID = false, PERM = true, PRE = false;
    bf16_t* P; int ldc; long cS1; float sc2; const float* stats; int rows_per_z;
    __device__ __forceinline__ void operator()(EPI_ARGS) const {
        PG8_LAS f32x2* X = (PG8_LAS f32x2*)xl;
        float mw[2][4], rsr[2][4]; const int ln = fq * 16 + fr;
        ROW_RS8(rsr, stats, u.z1 * rows_per_z + u.pm * BM + wr * 64 + fr);
#pragma unroll
        for (int ai = 0; ai < 2; ++ai)
#pragma unroll
            for (int m = 0; m < 4; ++m) {
                float mx = -3.0e38f; const float rsc = sc2 * rsr[ai][m];
#pragma unroll
                for (int bj = 0; bj < 2; ++bj)
#pragma unroll
                    for (int n = 0; n < 2; ++n)
#pragma unroll
                        for (int e = 0; e < 4; ++e) { const float v = acc[ai][bj][m][n][e] * rsc; acc[ai][bj][m][n][e] = v; mx = fmaxf(mx, v); }
                mx = fmaxf(mx, shx(mx, 16, ln)); mx = fmaxf(mx, shx(mx, 32, ln));
                float s = 0.f;
#pragma unroll
                for (int bj = 0; bj < 2; ++bj)
#pragma unroll
                    for (int n = 0; n < 2; ++n)
#pragma unroll
                        for (int e = 0; e < 4; ++e) { const float p = __builtin_amdgcn_exp2f(acc[ai][bj][m][n][e] - mx); acc[ai][bj][m][n][e] = p; s += p; }
                s += shx(s, 16, ln); s += shx(s, 32, ln);
                mw[ai][m] = mx;
                if (fq == 0) X[(ai * HALF + wr * 64 + m * 16 + fr) * 4 + wc] = (f32x2){mx, s};
            }
        asm volatile("s_waitcnt lgkmcnt(0)" ::: "memory"); __builtin_amdgcn_s_barrier(); asm volatile("" ::: "memory");
        char* ub = (char*)(P + (long)u.z1 * cS1 + (long)u.pm * BM * ldc + u.pn * BM);
        const unsigned lo = (unsigned)((wr * 64 + fr) * ldc + wc * 32 + 8 * fq) * 2u;
#pragma unroll
        for (int ai = 0; ai < 2; ++ai)
#pragma unroll
            for (int m = 0; m < 4; ++m) { const int r = ai * HALF + wr * 64 + m * 16 + fr;
                const f32x2 a = X[r * 4 + 0], b = X[r * 4 + 1], c = X[r * 4 + 2], d = X[r * 4 + 3];
                const float mt = fmaxf(fmaxf(a.x, b.x), fmaxf(c.x, d.x));
                const float l = a.y * __builtin_amdgcn_exp2f(a.x - mt) + b.y * __builtin_amdgcn_exp2f(b.x - mt) + c.y * __builtin_amdgcn_exp2f(c.x - mt) + d.y * __builtin_amdgcn_exp2f(d.x - mt);
                const float f = __builtin_amdgcn_exp2f(mw[ai][m] - mt) / l;
                char* rb = ub + (size_t)(ai * HALF + m * 16) * ldc * 2;
#pragma unroll
                for (int bj = 0; bj < 2; ++bj) { const f32x4 v0 = acc[ai][bj][m][0] * f, v1 = acc[ai][bj][m][1] * f; u32x4 w; PACK8(w, v0, v1);
                    *(u32x4*)(rb + lo + bj * 256) = w; } }
    }
};

template <class Epi>
__device__ __forceinline__ void gemm_phase(PG8_LAS unsigned char* lds, PG8_LAS unsigned char* xl, const Gemm g, const Sched& S, const Epi& E, const int wid) {
    const int lane = lane_id_opq(), tid = wid * 64 + lane;
    const int wr = wid >> 2, wc = wid & 3, fr = lane & 15, fq = lane >> 4;
    const int K = g.K, nt = K / BK;
    unsigned voffA[2], voffB[2];
#pragma unroll
    for (int i = 0; i < 2; ++i) { int R, C; stage_rc(tid * 16 + i * 8192, R, C); const int Rb = Epi::PERM ? ((R & ~31) + perm32(R & 31)) : R;
        voffA[i] = (unsigned)(R * g.lda + C) * 2u; voffB[i] = (unsigned)(Rb * g.ldb + C) * 2u; }
    const size_t kstep = (size_t)(BK * 2);
    const size_t hstepA = (size_t)HALF * g.lda * 2, hstepB = (size_t)HALF * g.ldb * 2;
    const unsigned ldsw = (unsigned)wid * 1024u;
    const int aoff = lds_byte(wr * 64 + fr, fq * 8), boff = lds_byte(wc * 32 + fr, fq * 8);
#define PG8_SA(b, h) (((b) * 2 + (h)) * HTB)
#define PG8_SB(b, h) ((4 + (b) * 2 + (h)) * HTB)
#define PG8_STAGE(bufoff, gbase, voff) do { _Pragma("unroll") for (int _i = 0; _i < 2; ++_i) \
        __builtin_amdgcn_global_load_lds((const unsigned*)((const char*)(gbase) + (voff)[_i]), (PG8_LAS unsigned*)(lds + (bufoff) + ldsw + _i * 8192), 16, 0, 0); } while (0)
#define PG8_LDA(dst, b, h) do { _Pragma("unroll") for (int m = 0; m < 4; ++m) _Pragma("unroll") for (int k = 0; k < 2; ++k) dst[m][k] = *(const PG8_LAS bf16x8*)(lds + PG8_SA(b, h) + aoff + m * 2048 + k * 1024); } while (0)
#define PG8_LDB(dst, b, h) do { _Pragma("unroll") for (int n = 0; n < 2; ++n) _Pragma("unroll") for (int k = 0; k < 2; ++k) dst[n][k] = *(const PG8_LAS bf16x8*)(lds + PG8_SB(b, h) + boff + n * 2048 + k * 1024); } while (0)
#define PG8_MMA(ai, bj, At, Bt) do { __builtin_amdgcn_s_setprio(1); _Pragma("unroll") for (int m = 0; m < 4; ++m) _Pragma("unroll") for (int n = 0; n < 2; ++n) _Pragma("unroll") for (int k = 0; k < 2; ++k) \
        acc[ai][bj][m][n] = __builtin_amdgcn_mfma_f32_16x16x32_bf16(Bt[n][k], At[m][k], acc[ai][bj][m][n], 0, 0, 0); __builtin_amdgcn_s_setprio(0); } while (0)
#define PG8_WAIT_V(n) asm volatile("s_waitcnt vmcnt(" #n ")" ::: "memory")
#define PG8_WAIT_L(n) asm volatile("s_waitcnt lgkmcnt(" #n ")" ::: "memory")
#define PG8_BAR __builtin_amdgcn_s_barrier()
#define PG8_SCHED __builtin_amdgcn_sched_barrier(0)
    Unit cur, nxt; int ui = 0;
    if (!S.next(0, cur)) return;
    Acc acc;
#pragma unroll
    for (int a = 0; a < 2; ++a)
#pragma unroll
        for (int b = 0; b < 2; ++b)
#pragma unroll
            for (int m = 0; m < 4; ++m)
#pragma unroll
                for (int n = 0; n < 2; ++n) acc[a][b][m][n] = (f32x4){0.f, 0.f, 0.f, 0.f};
    bf16x8 At[4][2], B0[2][2], B1[2][2];
    float prc[8];
#pragma unroll
    for (int k = 0; k < 8; ++k) prc[k] = 1.0f;
    if constexpr (Epi::PRE) { const float* pb = E.pre_base(cur) + wr * 64 + fr;
#pragma unroll
        for (int k = 0; k < 8; ++k) prc[k] = pb[(k >> 2) * HALF + (k & 3) * 16]; }
    const char* cA = a_tile(g, cur); const char* cB = b_tile(g, cur);
    PG8_STAGE(PG8_SB(0, 0), cB, voffB); PG8_STAGE(PG8_SB(0, 1), cB + hstepB, voffB); PG8_STAGE(PG8_SA(0, 0), cA, voffA); PG8_STAGE(PG8_SA(0, 1), cA + hstepA, voffA);
    if (wr == 1) PG8_BAR;
    PG8_WAIT_V(2); PG8_BAR;
    PG8_STAGE(PG8_SB(1, 0), cB + kstep, voffB); PG8_STAGE(PG8_SA(1, 0), cA + kstep, voffA); PG8_STAGE(PG8_SB(1, 1), cB + hstepB + kstep, voffB);
    PG8_WAIT_V(6); PG8_BAR;
    for (;;) {
        const bool has_next = S.next(ui + 1, nxt);
        const char* nA = has_next ? a_tile(g, nxt) : cA; const char* nB = has_next ? b_tile(g, nxt) : cB;
        for (int t = 0; t < nt; t += 2) {
            const bool last = (t == nt - 2);
            long j1 = 0, ja2 = 0, jb2 = 0;
            if constexpr (Epi::MID) {
                if (t == g.tj) { const int lnM = lane_id_opq(); E.mid(acc, cur, wr, wc, lnM & 15, lnM >> 4); }
                if (t >= g.tj) j1 = g.jA;
                if (t + 2 >= g.tj) { ja2 = g.jA; jb2 = g.jB; } }
            const char* a1 = cA + (size_t)(t + 1) * kstep + j1;
            const char* a2 = last ? nA : cA + (size_t)(t + 2) * kstep + ja2; const char* b2 = last ? nB : cB + (size_t)(t + 2) * kstep + jb2;
            const char* a3 = a2 + kstep; const char* b3 = b2 + kstep;
            PG8_LDB(B0, 0, 0); PG8_LDB(B1, 0, 1); PG8_SCHED; PG8_LDA(At, 0, 0); PG8_STAGE(PG8_SA(1, 1), a1 + hstepA, voffA);
            PG8_WAIT_V(8); PG8_WAIT_L(0); PG8_BAR; PG8_MMA(0, 0, At, B0); PG8_MMA(0, 1, At, B1); PG8_BAR; PG8_SCHED;
            PG8_LDA(At, 0, 1); PG8_STAGE(PG8_SB(0, 0), b2, voffB); PG8_STAGE(PG8_SB(0, 1), b2 + hstepB, voffB); PG8_STAGE(PG8_SA(0, 0), a2, voffA);
            PG8_WAIT_V(8); PG8_WAIT_L(0); PG8_BAR; PG8_MMA(1, 0, At, B0); PG8_MMA(1, 1, At, B1); PG8_BAR; PG8_SCHED;
            PG8_LDB(B0, 1, 0); PG8_LDB(B1, 1, 1); PG8_SCHED; PG8_LDA(At, 1, 0); PG8_STAGE(PG8_SA(0, 1), a2 + hstepA, voffA);
            PG8_WAIT_V(8); PG8_WAIT_L(0); PG8_BAR; PG8_MMA(0, 0, At, B0); PG8_MMA(0, 1, At, B1); PG8_BAR; PG8_SCHED;
            PG8_LDA(At, 1, 1); PG8_STAGE(PG8_SB(1, 0), b3, voffB); PG8_STAGE(PG8_SB(1, 1), b3 + hstepB, voffB); PG8_STAGE(PG8_SA(1, 0), a3, voffA);
            PG8_WAIT_V(8); PG8_WAIT_L(0); PG8_BAR; PG8_MMA(1, 0, At, B0); PG8_MMA(1, 1, At, B1); PG8_BAR; PG8_SCHED;
        }
        if (wr == 0) PG8_BAR;
        { const int lnE = lane_id_opq(); const int frE = lnE & 15, fqE = lnE >> 4;
          float prn[8];
#pragma unroll
          for (int k = 0; k < 8; ++k) prn[k] = 1.0f;
          if constexpr (Epi::PRE) { if (has_next) { const float* pb = E.pre_base(nxt) + wr * 64 + frE;
#pragma unroll
              for (int k = 0; k < 8; ++k) prn[k] = pb[(k >> 2) * HALF + (k & 3) * 16]; } }
          E(acc, cur, wr, wc, frE, fqE, xl, prc);
          if constexpr (Epi::PRE) {
#pragma unroll
              for (int k = 0; k < 8; ++k) prc[k] = prn[k]; } }
        if (!has_next) break;
#pragma unroll
        for (int a = 0; a < 2; ++a)
#pragma unroll
            for (int b = 0; b < 2; ++b)
#pragma unroll
                for (int m = 0; m < 4; ++m)
#pragma unroll
                    for (int n = 0; n < 2; ++n) acc[a][b][m][n] = (f32x4){0.f, 0.f, 0.f, 0.f};
        cur = nxt; cA = nA; cB = nB; ++ui;
        if (wr == 1) PG8_BAR;
    }
    PG8_WAIT_V(0);
    PG8_BAR;
#undef PG8_SA
#undef PG8_SB
#undef PG8_STAGE
#undef PG8_LDA
#undef PG8_LDB
#undef PG8_MMA
#undef PG8_WAIT_V
#undef PG8_WAIT_L
#undef PG8_BAR
#undef PG8_SCHED
}
}

namespace attn {
using bf16x8 = __attribute__((ext_vector_type(8))) short;
using s16x4  = __attribute__((ext_vector_type(4))) short;
using f32x16 = __attribute__((ext_vector_type(16))) float;
using u32x4  = __attribute__((ext_vector_type(4))) unsigned;
typedef unsigned short bf16_t;
constexpr int D = 128, NW = 8, QBLK = 32, KVBLK = 64;
constexpr float SCALE = 0.088388347648318440f;
constexpr float THR = 8.f;
constexpr int LD = NIN;
constexpr int NBUF = 3;
constexpr size_t SHM_V = KVBLK * D * 2, SHM_K = KVBLK * D * 2, SHM_WS = NBUF * (SHM_V + SHM_K), SHM_OST = 0;
constexpr int OST_STRIDE = 272, OST_WAVE = 32 * OST_STRIDE;
constexpr size_t SHM_ATTN = SHM_WS + NW * 64 * 4;
static_assert(NW * OST_WAVE <= SHM_WS, "O staging fits inside the ring");
#define KSWZ(row, colB) ((row) * 256 + ((colB) ^ (((row) & 7) << 4)))
#define SBAR() __builtin_amdgcn_sched_barrier(0)
__device__ __forceinline__ int crow(int r, int hi) { return (r & 3) + 8 * (r >> 2) + 4 * hi; }
__device__ __forceinline__ unsigned cvtpk(float lo, float hi) { unsigned r; asm volatile("v_cvt_pk_bf16_f32 %0, %1, %2" : "=v"(r) : "v"(lo), "v"(hi)); return r; }
__device__ __forceinline__ bf16x8 ld8(const bf16_t* p) { return *reinterpret_cast<const bf16x8*>(p); }

__device__ __forceinline__ float fadd_s(float a, float b) { float r; asm("v_add_f32 %0, %1, %2" : "=v"(r) : "v"(a), "v"(b)); return r; }
__device__ __forceinline__ void expHalf(f32x16& p0) {
#pragma unroll
  for (int r = 0; r < 16; ++r) p0[r] = __builtin_amdgcn_exp2f(p0[r]);
}
__device__ __forceinline__ void finishSM(f32x16& p0, f32x16& p1, float& l_reg, bf16x8& pa0, bf16x8& pa1, bf16x8& pa2, bf16x8& pa3) {
#pragma unroll
  for (int r = 0; r < 16; ++r) p1[r] = __builtin_amdgcn_exp2f(p1[r]);
  float s0 = fadd_s(p0[0], p0[1]), s1 = fadd_s(p0[2], p0[3]), s2 = fadd_s(p0[4], p0[5]), s3 = fadd_s(p0[6], p0[7]);
#pragma unroll
  for (int r = 8; r < 16; r += 4) { s0 = fadd_s(s0, p0[r]); s1 = fadd_s(s1, p0[r + 1]); s2 = fadd_s(s2, p0[r + 2]); s3 = fadd_s(s3, p0[r + 3]); }
#pragma unroll
  for (int r = 0; r < 16; r += 4) { s0 = fadd_s(s0, p1[r]); s1 = fadd_s(s1, p1[r + 1]); s2 = fadd_s(s2, p1[r + 2]); s3 = fadd_s(s3, p1[r + 3]); }
  l_reg = fadd_s(l_reg, fadd_s(fadd_s(s0, s1), fadd_s(s2, s3)));
#define PK4(P, BASE, OUT) do { unsigned a0 = cvtpk(P[BASE + 0], P[BASE + 1]), a1 = cvtpk(P[BASE + 2], P[BASE + 3]);   \
    unsigned b0 = cvtpk(P[BASE + 4], P[BASE + 5]), b1 = cvtpk(P[BASE + 6], P[BASE + 7]);                              \
    auto r0 = __builtin_amdgcn_permlane32_swap(a0, b0, false, false); auto r1 = __builtin_amdgcn_permlane32_swap(a1, b1, false, false); \
    u32x4 w = {r0[0], r1[0], r0[1], r1[1]}; OUT = *reinterpret_cast<bf16x8*>(&w); } while (0)
  PK4(p0, 0, pa0); PK4(p0, 8, pa1); PK4(p1, 0, pa2); PK4(p1, 8, pa3);
#undef PK4
}
__device__ __forceinline__ void qkt(f32x16& p0, f32x16& p1, const bf16_t* Ks, const bf16x8* qr, int r32, int hi) {
  p0 = f32x16{}; p1 = f32x16{};
#pragma unroll
  for (int d0 = 0; d0 < 8; ++d0) { int cb = (d0 * 16 + hi * 8) * 2;
    bf16x8 b0 = *reinterpret_cast<const bf16x8*>((const char*)Ks + KSWZ(r32, cb));
    bf16x8 b1 = *reinterpret_cast<const bf16x8*>((const char*)Ks + KSWZ(32 + r32, cb));
    p0 = __builtin_amdgcn_mfma_f32_32x32x16_bf16(b0, qr[d0], p0, 0, 0, 0);
    p1 = __builtin_amdgcn_mfma_f32_32x32x16_bf16(b1, qr[d0], p1, 0, 0, 0); }
}
__device__ __forceinline__ int v_st(int k, int c) { const int kk = (k & ~0xC) | ((k & 4) << 1) | ((k & 8) >> 1); return ((kk >> 3) * 4 + (c >> 5)) * 512 + ((kk & 7) * 32 + (c & 31)) * 2; }
__device__ __forceinline__ int v_rd_base(int lane) { return ((lane & 3) << 3) | (((lane >> 2) & 3) << 6) | (((lane >> 4) & 1) << 5) | (((lane >> 5) & 1) << 8); }
constexpr int v_rd_off(int d0, int ks, int half) { return d0 * 512 + ks * 4096 + half * 2048; }
template <int OFF> __device__ __forceinline__ s16x4 tr_read(int vb) {
  s16x4 r; asm volatile("ds_read_b64_tr_b16 %0, %1 offset:%2" : "=&v"(r) : "v"(vb), "i"(OFF) : "memory"); return r;
}
template <int D0> __device__ __forceinline__ void pv_one(f32x16& od, int vb, bf16x8 pa0, bf16x8 pa1, bf16x8 pa2, bf16x8 pa3) {
  const s16x4 l0 = tr_read<v_rd_off(D0, 0, 0)>(vb), h0 = tr_read<v_rd_off(D0, 0, 1)>(vb), l1 = tr_read<v_rd_off(D0, 1, 0)>(vb), h1 = tr_read<v_rd_off(D0, 1, 1)>(vb);
  const s16x4 l2 = tr_read<v_rd_off(D0, 2, 0)>(vb), h2 = tr_read<v_rd_off(D0, 2, 1)>(vb), l3 = tr_read<v_rd_off(D0, 3, 0)>(vb), h3 = tr_read<v_rd_off(D0, 3, 1)>(vb);
  asm volatile("s_waitcnt lgkmcnt(0)" ::: "memory"); SBAR();
#define PK(L, H) (bf16x8){L[0], L[1], L[2], L[3], H[0], H[1], H[2], H[3]}
  od = __builtin_amdgcn_mfma_f32_32x32x16_bf16(pa0, PK(l0, h0), od, 0, 0, 0);
  od = __builtin_amdgcn_mfma_f32_32x32x16_bf16(pa1, PK(l1, h1), od, 0, 0, 0);
  od = __builtin_amdgcn_mfma_f32_32x32x16_bf16(pa2, PK(l2, h2), od, 0, 0, 0);
  od = __builtin_amdgcn_mfma_f32_32x32x16_bf16(pa3, PK(l3, h3), od, 0, 0, 0);
#undef PK
}
__device__ __forceinline__ void pv_d0(f32x16* o, int vb, bf16x8 pa0, bf16x8 pa1, bf16x8 pa2, bf16x8 pa3) {
  pv_one<0>(o[0], vb, pa0, pa1, pa2, pa3); pv_one<1>(o[1], vb, pa0, pa1, pa2, pa3); pv_one<2>(o[2], vb, pa0, pa1, pa2, pa3); pv_one<3>(o[3], vb, pa0, pa1, pa2, pa3);
}
__device__ __forceinline__ void attn_dense_body(const bf16_t* Qb, const bf16_t* __restrict__ Kh, const bf16_t* __restrict__ Vh, bf16_t* Ob, int seq, char* lds, const int wid,
                                                const float* __restrict__ qg, const float* __restrict__ rope, int t0) {
  const int lane = pg8::lane_id_opq(), tid = wid * 64 + lane;
  const int r32 = lane & 31, hi = lane >> 5;
  bf16_t* V_lds = (bf16_t*)lds; bf16_t* K_lds = (bf16_t*)(lds + NBUF * SHM_V);
  float* ws = (float*)(lds + SHM_WS) + wid * 64; float* li_l = ws;
  float l_reg = 0; f32x16 o[4] = {}; bf16x8 qr[8];
  const bf16_t* Qw = Qb + (long)(wid * QBLK + r32) * LD + hi * 8;
#pragma unroll
  for (int d0 = 0; d0 < 8; ++d0) qr[d0] = ld8(Qw + d0 * 16);
  {
    float y[8][8]; float ss = 0.f;
#pragma unroll
    for (int d0 = 0; d0 < 8; ++d0) { const u32x4 w = __builtin_bit_cast(u32x4, qr[d0]);
      y[d0][0] = __uint_as_float(w.x << 16); y[d0][1] = __uint_as_float(w.x & 0xffff0000u); y[d0][2] = __uint_as_float(w.y << 16); y[d0][3] = __uint_as_float(w.y & 0xffff0000u);
      y[d0][4] = __uint_as_float(w.z << 16); y[d0][5] = __uint_as_float(w.z & 0xffff0000u); y[d0][6] = __uint_as_float(w.w << 16); y[d0][7] = __uint_as_float(w.w & 0xffff0000u);
#pragma unroll
      for (int e = 0; e < 8; ++e) ss += y[d0][e] * y[d0][e]; }
    { auto rr = __builtin_amdgcn_permlane32_swap(__float_as_uint(ss), __float_as_uint(ss), false, false); ss = __uint_as_float(rr[0]) + __uint_as_float(rr[1]); }
    const float rs = (SCALE * 1.4426950408889634f) / sqrtf(ss * (1.f / 128.f) + 1e-6f);
#pragma unroll
    for (int d0 = 0; d0 < 8; ++d0) { const float* gp = qg + d0 * 16 + hi * 8;
#pragma unroll
      for (int e = 0; e < 8; ++e) y[d0][e] *= rs * gp[e]; }
    const int t = t0 + wid * QBLK + r32;
#pragma unroll
    for (int a = 0; a < 2; ++a) {
      const float* cp = rope + (size_t)((a ? (t & 63) : (t >> 6)) * 32 + hi * 8) * 2;
#pragma unroll
      for (int h1 = 0; h1 < 2; ++h1) {
        float c[8], sn[8];
#pragma unroll
        for (int e = 0; e < 8; ++e) { c[e] = cp[(h1 * 16 + e) * 2]; sn[e] = cp[(h1 * 16 + e) * 2 + 1]; }
        const int dA = a * 4 + h1, dB = dA + 2;
#pragma unroll
        for (int e = 0; e < 8; ++e) { const float xa = y[dA][e], xb = y[dB][e]; y[dA][e] = xa * c[e] - xb * sn[e]; y[dB][e] = xb * c[e] + xa * sn[e]; }
      } }
#pragma unroll
    for (int d0 = 0; d0 < 8; ++d0) { u32x4 w = {cvtpk(y[d0][0], y[d0][1]), cvtpk(y[d0][2], y[d0][3]), cvtpk(y[d0][4], y[d0][5]), cvtpk(y[d0][6], y[d0][7])}; qr[d0] = __builtin_bit_cast(bf16x8, w); }
  }
  const int sr = tid >> 4, sc = (tid & 15) * 8, vst0 = v_st(sr, sc), vst1 = v_st(32 + sr, sc);
  const int vb0 = (int)(uintptr_t)V_lds + v_rd_base(lane);
  struct { bf16x8 vs0, vs1, ks0, ks1; } sr_[1];
#define SLOAD(i, k0) do { sr_[i].vs0 = ld8(&Vh[(long)((k0) + sr) * LD + sc]); sr_[i].vs1 = ld8(&Vh[(long)((k0) + 32 + sr) * LD + sc]); \
    sr_[i].ks0 = ld8(&Kh[(long)((k0) + sr) * LD + sc]); sr_[i].ks1 = ld8(&Kh[(long)((k0) + 32 + sr) * LD + sc]); } while (0)
#define SWRITE(off, i) do { *(bf16x8*)((char*)V_lds + (off) + vst0) = sr_[i].vs0;          \
    *(bf16x8*)((char*)V_lds + (off) + vst1) = sr_[i].vs1; int kc = sc * 2;               \
    *(bf16x8*)((char*)K_lds + (off) + KSWZ(sr, kc)) = sr_[i].ks0;                       \
    *(bf16x8*)((char*)K_lds + (off) + KSWZ(32 + sr, kc)) = sr_[i].ks1; } while (0)
#define SWAIT() asm volatile("s_waitcnt vmcnt(0)" ::: "memory")
  f32x16 pA0, pA1, pB0, pB1; bf16x8 pa0, pa1, pa2, pa3; const int NT = seq / KVBLK;
  if (wid >= 4) __builtin_amdgcn_s_setprio(1);
  SLOAD(0, 0); SWAIT(); SWRITE(0, 0);
  SLOAD(0, KVBLK); SWAIT(); SWRITE((int)SHM_V, 0); __syncthreads();
  qkt(pA0, pA1, K_lds, qr, r32, hi); expHalf(pA0);
  int o0 = 0, o1 = (int)SHM_V, o2 = 2 * (int)SHM_V;
#define STEP(PC0, PC1, PN0, PN1, jj, DO_QKT, DO_LOAD) do { \
    SBAR(); if (DO_QKT) qkt(PN0, PN1, (bf16_t*)((char*)K_lds + o1), qr, r32, hi); \
    finishSM(PC0, PC1, l_reg, pa0, pa1, pa2, pa3); SBAR(); \
    if (DO_LOAD) SLOAD(0, ((jj) + 2) * KVBLK); SBAR(); \
    pv_d0(o, vb0 + o0, pa0, pa1, pa2, pa3); if (DO_QKT) expHalf(PN0); \
    if (DO_LOAD) { SWAIT(); SWRITE(o2, 0); } \
    __syncthreads(); \
    { const int t_ = o0; o0 = o1; o1 = o2; o2 = t_; } } while (0)
  int j = 0;
  for (; j + 3 < NT; j += 2) { STEP(pA0, pA1, pB0, pB1, j, true, true); STEP(pB0, pB1, pA0, pA1, j + 1, true, true); }
  STEP(pA0, pA1, pB0, pB1, j, true, false);
  STEP(pB0, pB1, pA0, pA1, j + 1, false, false);
#undef STEP
  __builtin_amdgcn_s_setprio(0);
  { auto rr = __builtin_amdgcn_permlane32_swap(__float_as_uint(l_reg), __float_as_uint(l_reg), false, false); l_reg = __uint_as_float(rr[0]) + __uint_as_float(rr[1]); }
  if (hi == 0) li_l[r32] = l_reg; asm volatile("s_waitcnt lgkmcnt(0)" ::: "memory");
  float rli[16];
#pragma unroll
  for (int r = 0; r < 16; ++r) rli[r] = __builtin_amdgcn_rcpf(li_l[crow(r, hi)]);
  char* stg = lds + SHM_OST + wid * OST_WAVE;
#pragma unroll
  for (int r = 0; r < 16; ++r) { const int orow = crow(r, hi);
#pragma unroll
    for (int d0 = 0; d0 < 4; ++d0) { const float v = o[d0][r] * rli[r]; const unsigned w = cvtpk(v, v); *(bf16_t*)(stg + orow * OST_STRIDE + (d0 * 32 + r32) * 2) = (bf16_t)(w & 0xffffu); } }
  asm volatile("s_waitcnt lgkmcnt(0)" ::: "memory");
  bf16_t* Ow = Ob + (long)(wid * QBLK) * LD;
#pragma unroll
  for (int i = 0; i < 8; ++i) { const int c = i * 64 + lane, row = c >> 4, ch = c & 15; const u32x4 v = *(const u32x4*)(stg + row * OST_STRIDE + ch * 16); *(u32x4*)(Ow + (long)row * LD + ch * 8) = v; }
  asm volatile("s_waitcnt lgkmcnt(0)" ::: "memory");
  __syncthreads();
#undef SLOAD
#undef SWRITE
#undef SWAIT
}
#undef KSWZ
#undef SBAR
}

constexpr size_t MiB = 1u << 20;
constexpr size_t WS_CTL = 0, CTL_ZERO_BYTES = 1 * MiB;
constexpr size_t WS_ROPE = 1 * MiB;
constexpr size_t WS_STATS = 2 * MiB;
constexpr size_t WS_W = 4 * MiB;
constexpr size_t W_IN_T = WS_W;
constexpr size_t W_AO_T = W_IN_T + (size_t)NIN * DM * 2;
constexpr size_t W_SO_T = W_AO_T + (size_t)DM * DM * 2;
constexpr size_t W_OUT_T = W_SO_T + (size_t)DM * DM * 2;
constexpr size_t W_XQ_B = W_OUT_T + (size_t)DM * DM * 2;
constexpr size_t W_XKV_T = W_XQ_B + (size_t)DM * DM * 2;
constexpr size_t W_XO_T = W_XKV_T + (size_t)2 * DM * DM * 2;
constexpr size_t W_UP_T = W_XO_T + (size_t)DM * DM * 2;
constexpr size_t W_DN_T = W_UP_T + (size_t)2 * DFF * DM * 2;
constexpr size_t W_SBLK = W_DN_T + (size_t)DM * DFF * 2;
constexpr size_t WS_WEND = W_SBLK + (size_t)8 * 256 * 256 * 2;
constexpr size_t WS_H = 172 * MiB;
constexpr size_t WS_MEMN = WS_H + (size_t)T * DM * 2;
constexpr size_t WS_KV = WS_MEMN + (size_t)MEMROWS * DM * 2;
constexpr size_t WS_QKT = WS_KV + (size_t)MEMROWS * 2 * DM * 2;
constexpr size_t WS_VWT = WS_QKT + (size_t)NB * 1024 * DM * 2;
constexpr size_t WS_P = WS_VWT + (size_t)NB * 1024 * DM * 2;
constexpr size_t WS_BIG = WS_P + (size_t)T * 1024 * 2;
constexpr size_t WS_END = WS_BIG + (size_t)T * NIN * 2;
static_assert(WS_WEND <= WS_H, "weights fit below H");
constexpr int CW_BAR = 4096;

constexpr int RING_OFF = 0, RING_BYTES = 131072;
constexpr int XCH_OFF = 131072;
constexpr int MISC_OFF = 139264;
constexpr int LDS_BYTES = 147456;
static_assert(attn::SHM_ATTN <= MISC_OFF, "attention LDS fits");

#define GAS __attribute__((address_space(1)))
#define LAS __attribute__((address_space(3)))
typedef unsigned short bf16;
typedef unsigned v4u __attribute__((ext_vector_type(4)));
typedef float f32x4 __attribute__((ext_vector_type(4)));
typedef float f32x2 __attribute__((ext_vector_type(2)));
typedef GAS unsigned gu32;
#define RLX_AGENT __ATOMIC_RELAXED, __HIP_MEMORY_SCOPE_AGENT
#define LDS_WAIT() asm volatile("s_waitcnt lgkmcnt(0)" ::: "memory")
#define VM_WAIT() asm volatile("s_waitcnt vmcnt(0)" ::: "memory")
__device__ __forceinline__ unsigned f2bf(float f) { unsigned u = __builtin_bit_cast(unsigned, f); return (u + 0x7fffu + ((u >> 16) & 1u)) >> 16; }
__device__ __forceinline__ unsigned pk2(float lo, float hi) { return f2bf(lo) | (f2bf(hi) << 16); }
__device__ __forceinline__ float blo(unsigned w) { return __uint_as_float(w << 16); }
__device__ __forceinline__ float bhi(unsigned w) { return __uint_as_float(w & 0xffff0000u); }

#define XB_TMO      128
#define XB_XCNT(j)  (256  + 64 * (j))
#define XB_XSUB(j)  (1280 + 64 * (j))
#define XB_XGEN(j)  (2304 + 64 * (j))
#define XB_TOP      3328
#define XB_TOPGEN   3392
#define XCD_BAR_WORDS 3456
#define XB_SPIN_CAP (1u << 18)
__device__ __forceinline__ unsigned xb_ld(unsigned* p)              { return __hip_atomic_load(p, __ATOMIC_RELAXED, __HIP_MEMORY_SCOPE_AGENT); }
__device__ __forceinline__ unsigned xb_add(unsigned* p, unsigned v) { return __hip_atomic_fetch_add(p, v, __ATOMIC_RELAXED, __HIP_MEMORY_SCOPE_AGENT); }
__device__ __forceinline__ unsigned xb_xcc_id() { return (unsigned)__builtin_amdgcn_s_getreg((3 << 11) | 20) & 0xFu; }
#define XB_SPIN(cond, bar) do { unsigned _sp = 0; while (cond) { __builtin_amdgcn_s_sleep(1); \
    if ((++_sp & 255u) == 0u) { if (xb_ld(&(bar)[XB_TMO])) break; if (_sp > XB_SPIN_CAP) { atomicAdd(&(bar)[XB_TMO], 1u); break; } } } } while (0)
struct XcdBarrier { unsigned* bar; unsigned x; volatile LAS unsigned* st; };
__device__ __forceinline__ XcdBarrier xcd_barrier_post(unsigned* bar, volatile LAS unsigned* st) {
    XcdBarrier b; b.bar = bar; b.x = xb_xcc_id(); b.st = st;
    if (threadIdx.x == 0) (void)xb_add(&bar[XB_XCNT(b.x)], 1u);
    return b;
}
__device__ __forceinline__ void xcd_barrier_complete(unsigned* bar, unsigned x, unsigned& nloc, unsigned& nx) {
    const unsigned G = gridDim.x * gridDim.y * gridDim.z;
    unsigned sum, cnt, mine, sp = 0u;
    for (;;) {
        sum = 0u; cnt = 0u; mine = 0u;
#pragma unroll
        for (unsigned j = 0; j < 16; ++j) { const unsigned c = xb_ld(&bar[XB_XCNT(j)]); sum += c; cnt += (c > 0u) ? 1u : 0u; mine = (j == x) ? c : mine; }
        if (sum == G) break;
        __builtin_amdgcn_s_sleep(1);
        if ((++sp & 255u) == 0u) { if (xb_ld(&bar[XB_TMO])) break; if (sp > XB_SPIN_CAP) { atomicAdd(&bar[XB_TMO], 1u); break; } }
    }
    nloc = mine > 0u ? mine : 1u; nx = cnt > 0u ? cnt : 1u;
}
__device__ __forceinline__ void xcd_barrier(const XcdBarrier& b, const int wave) {
    asm volatile("s_waitcnt vmcnt(0)" ::: "memory");
    __syncthreads();
    if (wave == 0 && pg8::lane_id_opq() == 0) {
        unsigned* bar = b.bar;
        __builtin_amdgcn_s_waitcnt(0);
        unsigned nloc = b.st[0], nx = b.st[1];
        if (nloc == 0u) { xcd_barrier_complete(bar, b.x, nloc, nx); b.st[0] = nloc; b.st[1] = nx; }
        const unsigned old = xb_add(&bar[XB_XSUB(b.x)], 1u);
        const unsigned gen = old / nloc;
        if (old + 1u == (gen + 1u) * nloc) {
            __builtin_amdgcn_fence(__ATOMIC_RELEASE, "agent");
            asm volatile("s_waitcnt vmcnt(0)" ::: "memory");
            const unsigned og = xb_add(&bar[XB_TOP], 1u);
            const unsigned tg = og / nx;
            if (og + 1u == (tg + 1u) * nx) xb_add(&bar[XB_TOPGEN], 1u);
            else XB_SPIN(xb_ld(&bar[XB_TOPGEN]) == tg, bar);
            __builtin_amdgcn_fence(__ATOMIC_ACQUIRE, "agent");
            xb_add(&bar[XB_XGEN(b.x)], 1u);
            asm volatile("s_waitcnt vmcnt(0)" ::: "memory");
        } else {
            XB_SPIN(xb_ld(&bar[XB_XGEN(b.x)]) == gen, bar);
            __builtin_amdgcn_fence(__ATOMIC_ACQUIRE, "agent");
            asm volatile("s_waitcnt vmcnt(0)" ::: "memory");
        }
    }
    __syncthreads();
}

__device__ __forceinline__ int opq(int v) { asm volatile("" : "+v"(v)); return v; }
__device__ __forceinline__ float wave_sum(float v, int lane) {
#pragma unroll
    for (int o = 1; o < 64; o <<= 1) v += pg8::shx(v, o, lane);
    return v;
}
__device__ __forceinline__ void transpose_item(const float* W, int N, bf16* WT, int ldt, int k0, int n0, long drow0, LAS float* scr, int lane, const float* gain = nullptr) {
    float wv[32];
#pragma unroll
    for (int i = 0; i < 32; ++i) { const int kk = 2 * i + (lane >> 5); wv[i] = __builtin_nontemporal_load(&W[(size_t)(k0 + kk) * N + n0 + (lane & 31)]); }
#pragma unroll
    for (int i = 0; i < 32; ++i) { const int kk = 2 * i + (lane >> 5); float w = wv[i]; if (gain) w *= gain[k0 + kk]; scr[kk * 33 + (lane & 31)] = w; }
    LDS_WAIT(); asm volatile("" ::: "memory");
    const int c = lane & 7;
#pragma unroll
    for (int j = 0; j < 4; ++j) { const int n = (lane >> 3) + 8 * j; const LAS float* s = scr + (8 * c) * 33 + n;
        v4u o; o.x = pk2(s[0 * 33], s[1 * 33]); o.y = pk2(s[2 * 33], s[3 * 33]); o.z = pk2(s[4 * 33], s[5 * 33]); o.w = pk2(s[6 * 33], s[7 * 33]);
        *(GAS v4u*)(WT + (size_t)(drow0 + n) * ldt + k0 + 8 * c) = o; }
    LDS_WAIT(); asm volatile("" ::: "memory");
}
__device__ __forceinline__ void rms_row_to_bf16(const float* xrow, const float* gain, bf16* orow, float* xcopy, int lane) {
    const GAS f32x4* xr = (const GAS f32x4*)xrow + lane;
    f32x4 v[8]; float s = 0.f;
#pragma unroll
    for (int j = 0; j < 8; ++j) { v[j] = xr[64 * j]; s += (v[j].x * v[j].x + v[j].y * v[j].y) + (v[j].z * v[j].z + v[j].w * v[j].w); }
    if (xcopy) { GAS f32x4* xc = (GAS f32x4*)xcopy + lane;
#pragma unroll
        for (int j = 0; j < 8; ++j) xc[64 * j] = v[j]; }
    const float rs = 1.0f / sqrtf(wave_sum(s, lane) * (1.f / DM) + EPS);
    const GAS f32x4* gr = (const GAS f32x4*)gain + lane;
    GAS unsigned long long* o8 = (GAS unsigned long long*)orow + lane;
#pragma unroll
    for (int j = 0; j < 8; ++j) { const f32x4 g = gr[64 * j];
        o8[64 * j] = (unsigned long long)pk2(v[j].x * rs * g.x, v[j].y * rs * g.y) | ((unsigned long long)pk2(v[j].z * rs * g.z, v[j].w * rs * g.w) << 32); }
}

__device__ __forceinline__ void x_row_init2(const float* xrow, bf16* orow, float* st, float* rsf, int lane) {
    f32x4 v[2][8];
#pragma unroll
    for (int r = 0; r < 2; ++r)
#pragma unroll
        for (int j = 0; j < 8; ++j) v[r][j] = ((const GAS f32x4*)(xrow + (size_t)r * DM) + lane)[64 * j];
#pragma unroll
    for (int r = 0; r < 2; ++r) {
        GAS unsigned long long* o8 = (GAS unsigned long long*)(orow + (size_t)r * DM) + lane;
        float s = 0.f;
#pragma unroll
        for (int j = 0; j < 8; ++j) { const f32x4 w = v[r][j]; s += (w.x * w.x + w.y * w.y) + (w.z * w.z + w.w * w.w);
            o8[64 * j] = (unsigned long long)pk2(w.x, w.y) | ((unsigned long long)pk2(w.z, w.w) << 32); }
        s = wave_sum(s, lane);
        if (lane < 8) st[r * 8 + lane] = lane == 0 ? s : 0.f;
        if (lane == 0) rsf[r] = 1.0f / sqrtf(s * (1.f / DM) + EPS);
    }
}

struct Args { const float* in[26]; float* out; unsigned char* ws; };
static_assert(sizeof(Args) == 28 * 8, "no padding in Args");

__global__ void __launch_bounds__(512, 2) fwd_kernel(Args args) {
    extern __shared__ __attribute__((aligned(16))) unsigned char lds[];
    LAS unsigned char* L = (LAS unsigned char*)lds;
    volatile LAS unsigned* MISC = (volatile LAS unsigned*)(L + MISC_OFF);
    const int tid = threadIdx.x, wave = __builtin_amdgcn_readfirstlane(tid >> 6);
#define lane0 (pg8::lane_id_opq())
    const int G = gridDim.x, bx = blockIdx.x;
    const int vcu = (G % 8 == 0) ? (bx % 8) * (G / 8) + bx / 8 : bx;
    const int gw = vcu * 8 + wave, NGW = G * 8;
    for (int u = tid; u < 64; u += 512) ((LAS unsigned*)(L + MISC_OFF))[u] = 0u;
    __syncthreads();
    XcdBarrier bar = xcd_barrier_post((unsigned*)(args.ws + WS_CTL) + CW_BAR, MISC + 8);
#define GRID_BAR() xcd_barrier(bar, wave)
    LAS unsigned char* const RING = L + RING_OFF;
    LAS unsigned char* const XCH = L + XCH_OFF;
typedef const Args __attribute__((address_space(4))) CArgs;
constexpr int I_IN = (DM / 64) * (NIN / 32), I_SQ = (DM / 64) * (DM / 32), I_KV = (DM / 64) * (2 * DM / 32), I_UP = (DM / 64) * (2 * DFF / 32), I_DN = (DFF / 64) * (DM / 32);
constexpr int NITEMS = I_IN + 4 * I_SQ + I_KV + I_UP + I_DN, I_EARLY7 = I_IN, I_EARLYU = I_IN + 4 * I_SQ + I_KV;
#define CONV_ITEMS(LL, IT_LO, IT_HI, W0, NW) do { \
    const float* w_in = ka->in[5] + (size_t)(LL) * DM * NIN; const float* w_ao = ka->in[8] + (size_t)(LL) * DM * DM; const float* w_so = ka->in[13] + (size_t)(LL) * DM * DM; \
    const float* w_out = ka->in[14] + (size_t)(LL) * DM * DM; const float* w_xkv = ka->in[18] + (size_t)(LL) * DM * 2 * DM; const float* w_xo = ka->in[19] + (size_t)(LL) * DM * DM; \
    const float* w_up = ka->in[21] + (size_t)(LL) * DM * 2 * DFF; const float* w_dn = ka->in[24] + (size_t)(LL) * DFF * DM; const float* gmix = ka->in[4] + (size_t)(LL) * DM; const float* gffn = ka->in[20] + (size_t)(LL) * DM; \
    for (int it = (IT_LO) + (W0); it < (IT_HI); it += (NW)) { \
                int r = it; \
                if (r < I_IN) { const int nb = NIN / 32; const int n0 = 32 * (r % nb); long d0 = n0; \
                    if (n0 >= C_GA) { const int iss = n0 >= C_GS, ch = n0 - (iss ? C_GS : C_GA); d0 = C_GA + (long)(ch / 128) * 256 + iss * 128 + (ch % 128); } \
                    transpose_item(w_in, NIN, (bf16*)(ws + W_IN_T), DM, 64 * (r / nb), n0, d0, scr, lane, gmix); continue; } r -= I_IN; \
                if (r < I_SQ) { const int nb = DM / 32; transpose_item(w_ao, DM, (bf16*)(ws + W_AO_T), DM, 64 * (r / nb), 32 * (r % nb), 32 * (r % nb), scr, lane); continue; } r -= I_SQ; \
                if (r < I_SQ) { const int nb = DM / 32; transpose_item(w_so, DM, (bf16*)(ws + W_SO_T), DM, 64 * (r / nb), 32 * (r % nb), 32 * (r % nb), scr, lane); continue; } r -= I_SQ; \
                if (r < I_SQ) { const int nb = DM / 32; transpose_item(w_out, DM, (bf16*)(ws + W_OUT_T), DM, 64 * (r / nb), 32 * (r % nb), 32 * (r % nb), scr, lane); continue; } r -= I_SQ; \
                if (r < I_SQ) { const int nb = DM / 32; transpose_item(w_xo, DM, (bf16*)(ws + W_XO_T), DM, 64 * (r / nb), 32 * (r % nb), 32 * (r % nb), scr, lane); continue; } r -= I_SQ; \
                if (r < I_KV) { const int nb = 2 * DM / 32; transpose_item(w_xkv, 2 * DM, (bf16*)(ws + W_XKV_T), DM, 64 * (r / nb), 32 * (r % nb), 32 * (r % nb), scr, lane); continue; } r -= I_KV; \
                if (r < I_UP) { const int nb = 2 * DFF / 32; const int n0 = 32 * (r % nb); const int isb = n0 >= DFF, ch = n0 - isb * DFF; \
                    transpose_item(w_up, 2 * DFF, (bf16*)(ws + W_UP_T), DM, 64 * (r / nb), n0, (long)(ch / 128) * 256 + isb * 128 + (ch % 128), scr, lane, gffn); continue; } r -= I_UP; \
                { const int nb = DM / 32; transpose_item(w_dn, DM, (bf16*)(ws + W_DN_T), DFF, 64 * (r / nb), 32 * (r % nb), 32 * (r % nb), scr, lane); } \
            } \
    } while (0)
#define PHASE_ENV \
    CArgs* ka = (CArgs*)__builtin_amdgcn_kernarg_segment_ptr(); asm volatile("" : "+s"(ka)); \
    int G_o = (int)gridDim.x; asm volatile("" : "+s"(G_o)); const int G = G_o, NGW = G_o * 8; (void)G; (void)NGW; \
    unsigned char* const ws = ka->ws; float* const X = ka->out; \
    bf16* const Hb = (bf16*)(ws + WS_H); bf16* const MEMN = (bf16*)(ws + WS_MEMN); bf16* const KV = (bf16*)(ws + WS_KV); bf16* const QKT = (bf16*)(ws + WS_QKT); \
    bf16* const VWT = (bf16*)(ws + WS_VWT); bf16* const Pb = (bf16*)(ws + WS_P); bf16* const BIG = (bf16*)(ws + WS_BIG); f32x2* const ROPE = (f32x2*)(ws + WS_ROPE); \
    float* const STATS = (float*)(ws + WS_STATS); float* const RSF0 = (float*)(ws + WS_STATS + 3 * MiB / 2); float* const RSF2 = RSF0 + T; bf16* const VLT = (bf16*)ka->out; float* const LNST = (float*)((char*)ka->out + (size_t)200 * MiB);   \
    (void)X; (void)Hb; (void)MEMN; (void)KV; (void)QKT; (void)VWT; (void)Pb; (void)BIG; (void)ROPE; (void)STATS; (void)RSF0; (void)RSF2; (void)VLT; (void)LNST

    for (int l = 0; l < DEPTH; ++l) {
#if PH(0)
        { PHASE_ENV;
        {
            const int lane = opq(lane0);
            LAS float* scr = (LAS float*)(RING + wave * 16384);
            const float* w_in = ka->in[5] + (size_t)l * DM * NIN;
            const float* w_ao = ka->in[8] + (size_t)l * DM * DM;
            const float* w_so = ka->in[13] + (size_t)l * DM * DM;
            const float* w_out = ka->in[14] + (size_t)l * DM * DM;
            const float* w_xq = ka->in[17] + (size_t)l * DM * DM;
            const float* w_xkv = ka->in[18] + (size_t)l * DM * 2 * DM;
            const float* w_xo = ka->in[19] + (size_t)l * DM * DM;
            const float* w_up = ka->in[21] + (size_t)l * DM * 2 * DFF;
            const float* w_dn = ka->in[24] + (size_t)l * DFF * DM;
            const float* gmix = ka->in[4] + (size_t)l * DM; const float* gffn = ka->in[20] + (size_t)l * DM; const float* gxn = ka->in[15] + (size_t)l * DM;
            { const int b7 = (NB * 8 * 4) % G, bu = ((T / 256) * (2 * DFF / 256)) % G;
              const int lo = l == 0 ? 0 : (bu > 0 ? I_EARLYU : (b7 > 0 ? I_EARLY7 : 0));
              CONV_ITEMS(l, lo, NITEMS, gw, NGW); }
            { const size_t n8 = (size_t)DM * DM / 8; bf16* dst = (bf16*)(ws + W_XQ_B);
              for (size_t i = (size_t)gw * 64 + lane; i < n8; i += (size_t)NGW * 64) { const float gd = gxn[i >> 8]; const f32x4 a = *(const f32x4*)(w_xq + i * 8) * gd, b = *(const f32x4*)(w_xq + i * 8 + 4) * gd;
                  v4u o; o.x = pk2(a.x, a.y); o.y = pk2(a.z, a.w); o.z = pk2(b.x, b.y); o.w = pk2(b.z, b.w); *(v4u*)(dst + i * 8) = o; } }
            { const float* wsp = ka->in[11] + (size_t)l * 8 * 128 * 128; bf16* dst = (bf16*)(ws + W_SBLK); const size_t n8 = (size_t)8 * 256 * 256 / 8;
              for (size_t i = (size_t)gw * 64 + lane; i < n8; i += (size_t)NGW * 64) { const int e = (int)(i * 8), g = e >> 16, pp = (e >> 8) & 255, qq = e & 255;
                  v4u o = (v4u){0u, 0u, 0u, 0u};
                  if ((pp >> 7) == (qq >> 7)) { const float* s = wsp + ((size_t)g * 128 + (pp & 127)) * 128 + (qq & 127); const f32x4 a = *(const f32x4*)s, b = *(const f32x4*)(s + 4);
                      o.x = pk2(a.x, a.y); o.y = pk2(a.z, a.w); o.z = pk2(b.x, b.y); o.w = pk2(b.z, b.w); }
                  *(v4u*)(dst + i * 8) = o; } }
            if (l == 0) for (int m = gw * 2; m < T; m += NGW * 2) {
                const float* src = m < 4 * SEQ ? ka->in[0] + (size_t)m * DM : ka->in[1] + (size_t)(m - 4 * SEQ) * DM;
                x_row_init2(src, Hb + (size_t)m * DM, STATS + (size_t)m * 8, RSF0 + m, lane);
            }
            else for (int i = gw * 64 + lane; i < T; i += NGW * 64) {
                const f32x4 a = *(const f32x4*)(STATS + (size_t)i * 8), b = *(const f32x4*)(STATS + (size_t)i * 8 + 4);
                RSF0[i] = 1.0f / sqrtf(((a[0] + a[1]) + (a[2] + a[3]) + (b[0] + b[1]) + (b[2] + b[3])) * (1.f / DM) + EPS); }
            const float* gmem = ka->in[16] + (size_t)l * DM;
            for (int m = gw; m < MEMROWS; m += NGW) {
                const float* src = m < 4 * NMEM ? ka->in[2] + (size_t)m * DM : ka->in[3] + (size_t)(m - 4 * NMEM) * DM;
                rms_row_to_bf16(src, gmem, MEMN + (size_t)m * DM, nullptr, lane);
            }
            if (l == 0 && bx == 0 && wave == 0 && lane < 32) {
                double inv = 1.0; for (int j = 0; j < lane; ++j) inv *= 0.74989420933245582;
                const double t2 = inv * inv; double c1 = 1.0, s1 = inv, tc = 1.0, tsn = inv;
                for (int k = 1; k < 14; ++k) { tc *= -t2 / (double)((2 * k - 1) * (2 * k)); c1 += tc; tsn *= -t2 / (double)((2 * k) * (2 * k + 1)); s1 += tsn; }
                double c = 1.0, s = 0.0;
                for (int pos = 0; pos < 64; ++pos) { ROPE[pos * 32 + lane] = (f32x2){(float)c, (float)s}; const double cn = c * c1 - s * s1, sn = s * c1 + c * s1; c = cn; s = sn; }
            }
        }
        }
#endif
        GRID_BAR();
#if PH(1)
        { PHASE_ENV;
        {
            pg8::Gemm g{MEMN, (const bf16*)(ws + W_XKV_T), DM, DM, DM, 0, 0, 0, 0}; pg8::Sched S; S.init(1, 1, MEMROWS / 256, 2 * DM / 256, G, G - 1 - bx);
            pg8::EpiBf16<0> E{KV, 2 * DM, 0, 0, nullptr, nullptr};
            pg8::gemm_phase(RING, XCH, g, S, E, wave);
        }
        {
            pg8::Gemm g{Hb, (const bf16*)(ws + W_IN_T), DM, DM, DM, 0, 0, 0, 0}; pg8::Sched S; S.init(1, 1, T / 256, 28, G, bx, 1);
            pg8::EpiBf16<1, true> E{BIG, NIN, 0, 0, RSF0, LNST};
            pg8::gemm_phase(RING, XCH, g, S, E, wave);
        }
        }
#endif
        GRID_BAR();
#if PH(2)
        { PHASE_ENV;
        {
            const int lane = opq(lane0);
            const float* qg = ka->in[6] + (size_t)l * 128; const float* kg = ka->in[7] + (size_t)l * 128;
            const int hh = lane >> 4, li = lane & 15;
            const int a_ = li >> 3, p_ = (li >> 2) & 1, j0 = (li & 3) * 8;
            for (int row0 = gw * 4; row0 < T; row0 += NGW * 4) {
                bf16* p0 = BIG + (size_t)row0 * NIN + C_K + hh * 128 + li * 8;
                v4u wq[4];
#pragma unroll
                for (int rr = 0; rr < 4; ++rr) wq[rr] = *(const v4u*)(p0 + (size_t)rr * NIN);
#pragma unroll
                for (int rr = 0; rr < 4; ++rr) {
                    const int t = (row0 + rr) & (SEQ - 1), pos = a_ ? (t & 63) : (t >> 6);
                    const v4u w = wq[rr];
                    float y[8] = {blo(w.x), bhi(w.x), blo(w.y), bhi(w.y), blo(w.z), bhi(w.z), blo(w.w), bhi(w.w)};
                    float s = 0.f;
#pragma unroll
                    for (int e = 0; e < 8; ++e) s += y[e] * y[e];
                    s += pg8::shx(s, 1, lane); s += pg8::shx(s, 2, lane); s += pg8::shx(s, 4, lane); s += pg8::shx(s, 8, lane);
                    const float rs = 1.0f / sqrtf(s * (1.f / 128.f) + EPS);
                    const float* gv = kg + li * 8;
                    float o[8];
#pragma unroll
                    for (int e = 0; e < 8; ++e) y[e] = y[e] * rs * gv[e];
#pragma unroll
                    for (int e = 0; e < 8; ++e) { const float yp = pg8::shx(y[e], 4, lane); const f32x2 cs = ROPE[pos * 32 + j0 + e]; o[e] = y[e] * cs.x + (p_ ? yp : -yp) * cs.y; }
                    v4u ow; ow.x = pk2(o[0], o[1]); ow.y = pk2(o[2], o[3]); ow.z = pk2(o[4], o[5]); ow.w = pk2(o[6], o[7]);
                    *(v4u*)(p0 + (size_t)rr * NIN) = ow;
                }
            }
            const float* lng = ka->in[9] + (size_t)l * DM; const float* lnb = ka->in[10] + (size_t)l * DM;
            for (int it = vcu; it < (T / 64) * 2; it += G) {
                const int blk = it >> 1, half = it & 1, t0 = blk * 64 + wave * 8;
                float my_mu = 0.f, my_rs = 0.f;
                {
                    const int r = lane & 7;
                    const float* q = LNST + (size_t)(t0 + r) * 16;
                    const f32x4 a = *(const f32x4*)q, b = *(const f32x4*)(q + 4), c = *(const f32x4*)(q + 8), d = *(const f32x4*)(q + 12);
                    const float s = ((a[0] + a[2]) + (b[0] + b[2])) + ((c[0] + c[2]) + (d[0] + d[2])), s2 = ((a[1] + a[3]) + (b[1] + b[3])) + ((c[1] + c[3]) + (d[1] + d[3]));
                    const float mu = s * (1.f / DM); float var = s2 * (1.f / DM) - mu * mu; var = var < 0.f ? 0.f : var;
                    my_mu = mu; my_rs = 1.0f / sqrtf(var + EPS);
                }
                const int z1 = t0 >> 8, tt = t0 & 255;
#pragma unroll
                for (int q = 0; q < 2; ++q) {
                    const int c0 = half * 1024 + q * 512 + lane * 8;
                    float gch[8], bch[8];
#pragma unroll
                    for (int e = 0; e < 8; ++e) { gch[e] = lng[c0 + e]; bch[e] = lnb[c0 + e]; }
                    unsigned ow[8][4];
                    v4u wr8[8];
#pragma unroll
                    for (int r = 0; r < 8; ++r) wr8[r] = *(const v4u*)(BIG + (size_t)(t0 + r) * NIN + C_VS + c0);
#pragma unroll
                    for (int rp2 = 0; rp2 < 4; ++rp2) {
                        const v4u wa = wr8[2 * rp2], wb = wr8[2 * rp2 + 1];
                        const float mua = __int_as_float(__builtin_amdgcn_readlane(__float_as_int(my_mu), 2 * rp2)), rsa = __int_as_float(__builtin_amdgcn_readlane(__float_as_int(my_rs), 2 * rp2)), mub = __int_as_float(__builtin_amdgcn_readlane(__float_as_int(my_mu), 2 * rp2 + 1)), rsb = __int_as_float(__builtin_amdgcn_readlane(__float_as_int(my_rs), 2 * rp2 + 1));
                        const float fa[8] = {blo(wa.x), bhi(wa.x), blo(wa.y), bhi(wa.y), blo(wa.z), bhi(wa.z), blo(wa.w), bhi(wa.w)};
                        const float fb[8] = {blo(wb.x), bhi(wb.x), blo(wb.y), bhi(wb.y), blo(wb.z), bhi(wb.z), blo(wb.w), bhi(wb.w)};
#pragma unroll
                        for (int e = 0; e < 8; ++e) ow[e][rp2] = pg8::cvt_pk_bf16((fa[e] - mua) * rsa * gch[e] + bch[e], (fb[e] - mub) * rsb * gch[e] + bch[e]);
                    }
#pragma unroll
                    for (int e = 0; e < 8; ++e) { v4u o; o.x = ow[e][0]; o.y = ow[e][1]; o.z = ow[e][2]; o.w = ow[e][3];
                        *(LAS v4u*)(RING + (q * 512 + lane * 8 + e) * 128 + ((wave ^ (lane & 7)) << 4)) = o; }
                }
                __syncthreads();
                {
                    const int p8 = lane & 7, chl = lane >> 3;
                    bf16* dst = VLT + ((size_t)(blk >> 2) * DM + half * 1024 + wave * 128 + chl) * 256 + (blk & 3) * 64 + p8 * 8;
                    v4u rr[16];
#pragma unroll
                    for (int i = 0; i < 16; ++i) { const int ch = wave * 128 + i * 8 + chl; rr[i] = *(const LAS v4u*)(RING + ch * 128 + ((p8 ^ ((ch >> 3) & 7)) << 4)); }
#pragma unroll
                    for (int i = 0; i < 16; ++i) *(v4u*)(dst + (size_t)i * 8 * 256) = rr[i];
                }
                __syncthreads();
            }
        }
        {
            pg8::Gemm g{KV, (const bf16*)(ws + W_XQ_B), 2 * DM, DM, 512, (long)NMEM * 2 * DM, 512, 0, 512}; pg8::Sched S; S.init(NB * 4, 4, 1, 8, G, bx);
            pg8::EpiBf16<0> E{QKT, DM, (long)1024 * DM, (long)256 * DM, nullptr, nullptr};
            pg8::gemm_phase(RING, XCH, g, S, E, wave);
        }
        {
            pg8::Gemm g{(const bf16*)(ws + W_XO_T), KV + DM, DM, 2 * DM, 512, 0, 512, (long)NMEM * 2 * DM, 512}; pg8::Sched S; S.init(NB * 4, 4, 8, 1, G, G - 1 - bx);
            pg8::EpiBf16<0> E{VWT, 1024, (long)DM * 1024, 256, nullptr, nullptr};
            pg8::gemm_phase(RING, XCH, g, S, E, wave);
        }
        }
#endif
        GRID_BAR();
#if PH(3)
        { PHASE_ENV;
        {
            for (int i = 0; ; ++i) {
                const int U = i * G + vcu; if (U >= NB * 128) break;
                const int qb = U & 7, hq = ((U >> 5) & 3) * 4 + ((U >> 3) & 3), kvh = (U >> 5) & 3, b = U >> 7;
                const bf16* Qb = BIG + (size_t)(b * SEQ + qb * 256) * NIN + C_Q + hq * 128;
                const bf16* Kh = BIG + (size_t)(b * SEQ) * NIN + C_K + kvh * 128;
                const bf16* Vh = BIG + (size_t)(b * SEQ) * NIN + C_V + kvh * 128;
                attn::attn_dense_body(Qb, Kh, Vh, (bf16*)Qb, SEQ, (char*)lds, wave, ka->in[6] + (size_t)l * 128, (const float*)ROPE, qb * 256);
            }
        }
        {
            pg8::Gemm g{(const bf16*)(ws + W_SBLK), VLT, 256, 256, 256, 0, (long)256 * 256, (long)DM * 256, (long)256 * 256}; pg8::Sched S; S.init(T / 256 * 8, 8, 1, 1, G, bx);
            pg8::EpiSpatial E{BIG + C_U, NIN, ka->in[12] + (size_t)l * 8 * 128};
            pg8::gemm_phase(RING, XCH, g, S, E, wave);
        }
        {
            pg8::Gemm g{Hb, (const bf16*)(ws + W_IN_T) + (size_t)28 * 256 * DM, DM, DM, DM, 0, 0, 0, 0}; pg8::Sched S; S.init(1, 1, T / 256, 16, G, bx);
            pg8::EpiBf16<1, true> E{BIG, NIN, 0, 0, RSF0, LNST, 28};
            pg8::gemm_phase(RING, XCH, g, S, E, wave);
        }
        }
#endif
        GRID_BAR();
#if PH(4)
        { PHASE_ENV;
        {
            pg8::Gemm g{BIG + C_Q, (const bf16*)(ws + W_AO_T), NIN, DM, 2 * DM, 0, 0, 0, 0, (long)(C_U - C_Q - DM) * 2, (long)W_SO_T - (long)W_AO_T - (long)DM * 2, DM / 64};
            pg8::Sched S; S.init(1, 1, T / 256, DM / 256, G, bx, 1);
            pg8::EpiMixF E{BIG + C_GA, BIG + C_GS, BIG + C_VS, NIN};
            pg8::gemm_phase(RING, XCH, g, S, E, wave);
        }
        }
#endif
        GRID_BAR();
#if PH(5)
        { PHASE_ENV;
        {
            pg8::Gemm g{BIG + C_VS, (const bf16*)(ws + W_OUT_T), NIN, DM, DM, 0, 0, 0, 0}; pg8::Sched S; S.init(1, 1, T / 256, DM / 256, G, bx);
            pg8::EpiRes E{Hb, DM, 0, STATS, 0};
            pg8::gemm_phase(RING, XCH, g, S, E, wave);
        }
        }
#endif
        GRID_BAR();
#if PH(7)
        { PHASE_ENV;
        {
            pg8::Gemm g{Hb, QKT, DM, DM, DM, (long)SEQ * DM, 0, (long)1024 * DM, 0}; pg8::Sched S; S.init(NB, 1, 8, 4, G, bx, 1);
            pg8::EpiSoftmax E{Pb, 1024, (long)SEQ * 1024, 0.044194173824159216f * 1.4426950408889634f, STATS, SEQ};
            pg8::gemm_phase(RING, XCH, g, S, E, wave);
        }
        { const int b7 = (NB * 8 * 4) % G;
          if (l + 1 < DEPTH && b7 > 0 && bx >= b7) { const int lane = opq(lane0); LAS float* scr = (LAS float*)(RING + wave * 16384);
              CONV_ITEMS(l + 1, 0, I_EARLY7, (bx - b7) * 8 + wave, (G - b7) * 8); } }
        }
#endif
        GRID_BAR();
#if PH(8)
        { PHASE_ENV;
        {
            pg8::Gemm g{Pb, VWT, 1024, 1024, 1024, (long)SEQ * 1024, 0, (long)DM * 1024, 0}; pg8::Sched S; S.init(NB, 1, 8, 8, G, bx);
            pg8::EpiRes E{Hb, DM, (long)SEQ * DM, STATS, SEQ};
            pg8::gemm_phase(RING, XCH, g, S, E, wave);
        }
        }
#endif
        GRID_BAR();
#if PH(10)
        { PHASE_ENV; const int lane = opq(lane0);
          for (int i = gw * 64 + lane; i < T; i += NGW * 64) { const f32x4 a = *(const f32x4*)(STATS + (size_t)i * 8), b = *(const f32x4*)(STATS + (size_t)i * 8 + 4);
              RSF2[i] = 1.0f / sqrtf(((a[0] + a[1]) + (a[2] + a[3]) + (b[0] + b[1]) + (b[2] + b[3])) * (1.f / DM) + EPS); } }
        GRID_BAR();
#define FFN_ENV PHASE_ENV; bf16* const ACT = BIG + (size_t)T * DFF;   float* const EA = (float*)BIG;   float* const EB = EA + (size_t)(T / 256) * 4 * DFF;   (void)ACT; (void)EA; (void)EB
        { FFN_ENV;
            pg8::Gemm g{Hb, (const bf16*)(ws + W_UP_T), DM, DM, DM, 0, 0, 0, 0}; pg8::Sched S; S.init(1, 1, T / 256, 2 * DFF / 256, G, bx, 1);
            pg8::EpiUp E{ACT, DFF, RSF2, ka->in[22] + (size_t)l * 3 * DFF, ka->in[23] + (size_t)l * DFF, EA, EB};
            pg8::gemm_phase(RING, XCH, g, S, E, wave);
            { const int bu = ((T / 256) * (2 * DFF / 256)) % G, b7 = (NB * 8 * 4) % G;
              if (l + 1 < DEPTH && bu > 0 && bx >= bu) { const int lane = opq(lane0); LAS float* scr = (LAS float*)(RING + wave * 16384);
                  CONV_ITEMS(l + 1, b7 > 0 ? I_EARLY7 : 0, I_EARLYU, (bx - bu) * 8 + wave, (G - bu) * 8); } }
        }
        GRID_BAR();
        { FFN_ENV; const int lane = opq(lane0);
            const float* cw = ka->in[22] + (size_t)l * 3 * DFF; const float* cb = ka->in[23] + (size_t)l * DFF;
            constexpr int NC8 = DFF / 8, NIT = (T / 256) * 2 * NC8;
            for (int it = gw * 64 + lane; it < NIT; it += NGW * 64) {
                const int c8 = it % NC8, tw = it / NC8, pm = tw >> 1, bot = tw & 1, c0 = c8 * 8;
                const float* ac = EA + ((size_t)pm * 4 + (bot ? 3 : 0)) * DFF + c0;
                const float* ap = bot ? EA + ((size_t)pm * 4 + 2) * DFF + c0 : EA + ((size_t)(pm - 1) * 4 + 3) * DFF + c0;
                const float* an = bot ? EA + ((size_t)(pm + 1) * 4 + 0) * DFF + c0 : EA + ((size_t)pm * 4 + 1) * DFF + c0;
                const bool pz = !bot && (pm & 7) == 0, nz = bot && (pm & 7) == 7;
                const float* bp = EB + ((size_t)pm * 2 + bot) * DFF + c0;
                float o[8];
#pragma unroll
                for (int h = 0; h < 2; ++h) {
                    const f32x4 z = (f32x4){0.f, 0.f, 0.f, 0.f};
                    const f32x4 vc = *(const f32x4*)(ac + 4 * h), vp = pz ? z : *(const f32x4*)((pz ? ac : ap) + 4 * h), vn = nz ? z : *(const f32x4*)((nz ? ac : an) + 4 * h), vb = *(const f32x4*)(bp + 4 * h);
                    const f32x4 w0 = *(const f32x4*)(cw + c0 + 4 * h), w1 = *(const f32x4*)(cw + DFF + c0 + 4 * h), w2 = *(const f32x4*)(cw + 2 * DFF + c0 + 4 * h), bb = *(const f32x4*)(cb + c0 + 4 * h);
#pragma unroll
                    for (int e = 0; e < 4; ++e) o[4 * h + e] = pg8::gelu_t(bb[e] + w0[e] * vp[e] + w1[e] * vc[e] + w2[e] * vn[e]) * vb[e]; }
                v4u ow; ow.x = pk2(o[0], o[1]); ow.y = pk2(o[2], o[3]); ow.z = pk2(o[4], o[5]); ow.w = pk2(o[6], o[7]);
                *(v4u*)(ACT + (size_t)(pm * 256 + (bot ? 255 : 0)) * DFF + c0) = ow;
            }
        }
        GRID_BAR();
        { FFN_ENV;
            pg8::Gemm g{ACT, (const bf16*)(ws + W_DN_T), DFF, DFF, DFF, 0, 0, 0, 0}; pg8::Sched S; S.init(1, 1, T / 256, DM / 256, G, bx);
            pg8::EpiRes E{Hb, DM, 0, STATS, 0};
            pg8::gemm_phase(RING, XCH, g, S, E, wave);
        }
        GRID_BAR();
#endif
    }
    { PHASE_ENV;
        const int lane = opq(lane0);
        const float* gfin = ka->in[25];
        for (int m0 = T - 4 - gw * 4; m0 >= 0; m0 -= NGW * 4) {
            v4u wq[4][4];
#pragma unroll
            for (int r = 0; r < 4; ++r)
#pragma unroll
                for (int j = 0; j < 4; ++j) wq[r][j] = ((const v4u*)(Hb + (size_t)(m0 + r) * DM) + lane)[64 * j];
#pragma unroll
            for (int r = 0; r < 4; ++r) {
                float v[4][8]; float s = 0.f;
#pragma unroll
                for (int j = 0; j < 4; ++j) { const v4u w = wq[r][j]; v[j][0] = blo(w.x); v[j][1] = bhi(w.x); v[j][2] = blo(w.y); v[j][3] = bhi(w.y); v[j][4] = blo(w.z); v[j][5] = bhi(w.z); v[j][6] = blo(w.w); v[j][7] = bhi(w.w);
#pragma unroll
                    for (int e = 0; e < 8; ++e) s += v[j][e] * v[j][e]; }
                const float rs = 1.0f / sqrtf(wave_sum(s, lane) * (1.f / DM) + EPS);
#pragma unroll
                for (int j = 0; j < 4; ++j) { const float* gp = gfin + j * 512 + lane * 8; float* op = X + (size_t)(m0 + r) * DM + j * 512 + lane * 8;
                    const f32x4 g0 = *(const f32x4*)gp, g1 = *(const f32x4*)(gp + 4);
                    *(f32x4*)op = (f32x4){v[j][0] * rs * g0.x, v[j][1] * rs * g0.y, v[j][2] * rs * g0.z, v[j][3] * rs * g0.w};
                    *(f32x4*)(op + 4) = (f32x4){v[j][4] * rs * g1.x, v[j][5] * rs * g1.y, v[j][6] * rs * g1.z, v[j][7] * rs * g1.w}; }
            }
        }
    }
}

extern "C" void kernel_launch(void* const* d_in, const int* in_sizes, int n_in, void* d_out, int out_size, void* d_ws, size_t ws_size, hipStream_t stream) {
    static int grid = 0;
    if (grid == 0) {
        if (n_in != 26 || out_size != T * DM || ws_size < WS_END) { fprintf(stderr, "kernel_launch: shape/workspace mismatch: n_in %d out %d ws %zu (need %zu)\n", n_in, out_size, ws_size, (size_t)WS_END); grid = -1; return; }
        int dev = 0, cus = 0, per_cu = 0;
        if (hipGetDevice(&dev) != hipSuccess || hipDeviceGetAttribute(&cus, hipDeviceAttributeMultiprocessorCount, dev) != hipSuccess) { grid = -1; return; }
        if (hipFuncSetAttribute((const void*)fwd_kernel, hipFuncAttributeMaxDynamicSharedMemorySize, LDS_BYTES) != hipSuccess) { fprintf(stderr, "kernel_launch: hipFuncSetAttribute failed\n"); grid = -1; return; }
        if (hipOccupancyMaxActiveBlocksPerMultiprocessor(&per_cu, (const void*)fwd_kernel, 512, LDS_BYTES) != hipSuccess || per_cu < 1) { fprintf(stderr, "kernel_launch: occupancy query says %d\n", per_cu); }
        (void)hipGetLastError();
        grid = cus;
    }
    if (grid < 0) return;
    (void)hipMemsetAsync((char*)d_ws + WS_CTL, 0, CTL_ZERO_BYTES, stream);
    Args a{};
    for (int i = 0; i < 26; ++i) a.in[i] = (const float*)d_in[i];
    a.out = (float*)d_out; a.ws = (unsigned char*)d_ws;
    hipLaunchKernelGGL(fwd_kernel, dim3(grid), dim3(512), LDS_BYTES, stream, a);
    const hipError_t le = hipPeekAtLastError();
    if (le != hipSuccess) fprintf(stderr, "kernel_launch: launch failed: %s\n", hipGetErrorName(le));
}
```

```cpp
#include <hip/hip_runtime.h>
#include <hip/hip_bf16.h>
#include <cstdio>
#include <cstdint>

#ifndef ONLY
#define ONLY -1
#endif
#define PH(n) (ONLY < 0 || ONLY == (n))
constexpr int DM = 2048, NB = 20, SEQ = 2048, T = NB * SEQ, DEPTH = 4;
constexpr int NIN = 11264, DFF = 5632, HFF = DFF / 2  , NMEM = 256, MEMROWS = NB * NMEM;
constexpr int C_Q = 0, C_K = 2048, C_V = 2560, C_U = 3072, C_VS = 5120, C_GA = 7168, C_GS = 9216;
constexpr float EPS = 1e-6f;

namespace pg8 {
#define PG8_LAS __attribute__((address_space(3)))
typedef unsigned short bf16_t;
typedef short bf16x8 __attribute__((ext_vector_type(8)));
typedef float f32x4 __attribute__((ext_vector_type(4)));
typedef float f32x2 __attribute__((ext_vector_type(2)));
typedef unsigned u32x4 __attribute__((ext_vector_type(4)));
constexpr int BM = 256, BK = 64, HALF = 128, HTB = HALF * BK * 2, STAGE_BYTES = 8 * HTB, NXCD = 8, WGM = 4;

__host__ __device__ __forceinline__ int lds_byte(int r, int c) { const int st = (r >> 4) * 2 + (c >> 5), rr = r & 15, cc = c & 31, ob = rr * 64 + cc * 2; return st * 1024 + (ob ^ (((ob >> 9) & 1) << 5)); }
__host__ __device__ __forceinline__ void stage_rc(int b, int& R, int& C) { const int st = b / 1024, sb = b % 1024, swz = sb ^ (((sb >> 9) & 1) << 5); R = (st >> 1) * 16 + swz / 64; C = (st & 1) * 32 + (swz % 64) / 2; }
__host__ __device__ __forceinline__ int perm32(int rho) { const int n = rho >> 4, i = rho & 15; return 8 * (i >> 2) + 4 * n + (i & 3); }

struct Unit { int z1, z2, pm, pn; };
struct Gemm { const bf16_t* A; const bf16_t* Bt; int lda, ldb, K; long aS1, aS2, bS1, bS2; long jA = 0, jB = 0; int tj = 0; };
struct Sched {
    int Z2, nM, nN, nwg, G, c, rev;
    __device__ __forceinline__ void init(int Z, int Z2_, int nM_, int nN_, int G_, int c_, int rev_ = 0) { Z2 = Z2_; nM = nM_; nN = nN_; nwg = Z * nM_ * nN_; G = G_; c = c_; rev = rev_; }
    __device__ __forceinline__ bool next(int i, Unit& u) const {
        int nM = this->nM, nN = this->nN, Z2 = this->Z2; asm volatile("" : "+s"(nM), "+s"(nN), "+s"(Z2));
        const long L = (long)i * G + c; if (L >= nwg) return false;
        int wgid = (int)L; { const int q = nwg / NXCD, r = nwg % NXCD, xcd = wgid % NXCD, off = wgid / NXCD; wgid = (xcd < r ? xcd * (q + 1) : r * (q + 1) + (xcd - r) * q) + off; }
        if (rev) wgid = nwg - 1 - wgid;
        const int per = nM * nN, z = wgid / per, rem = wgid - z * per;
        const int nig = WGM * nN, gid = rem / nig, fm = gid * WGM, gsz = (nM - fm) < WGM ? (nM - fm) : WGM, ri = rem - gid * nig;
        u.pm = fm + (ri % gsz); u.pn = ri / gsz; u.z1 = z / Z2; u.z2 = z - u.z1 * Z2; return true;
    }
};
__device__ __forceinline__ const char* a_tile(const Gemm& g, const Unit& u) { return (const char*)(g.A + ((long)u.z1 * g.aS1 + (long)u.z2 * g.aS2 + (long)u.pm * BM * g.lda)); }
__device__ __forceinline__ const char* b_tile(const Gemm& g, const Unit& u) { return (const char*)(g.Bt + ((long)u.z1 * g.bS1 + (long)u.z2 * g.bS2 + (long)u.pn * BM * g.ldb)); }

__device__ __forceinline__ unsigned cvt_pk_bf16(float lo, float hi) { unsigned r; asm volatile("v_cvt_pk_bf16_f32 %0, %1, %2" : "=v"(r) : "v"(lo), "v"(hi)); return r; }
__device__ __forceinline__ float bf_lo(unsigned w) { return __uint_as_float(w << 16); }
__device__ __forceinline__ float bf_hi(unsigned w) { return __uint_as_float(w & 0xffff0000u); }
__device__ __forceinline__ float gelu_t(float x) { const float e = __builtin_amdgcn_exp2f(x * (-2.302208198f - 0.1029432397f * x * x)); return x * __builtin_amdgcn_rcpf(1.0f + e); }
__device__ __forceinline__ float sigm(float x) { return __builtin_amdgcn_rcpf(1.0f + __builtin_amdgcn_exp2f(-1.4426950409f * x)); }
__device__ __forceinline__ f32x2 gelu_t2(f32x2 x) { const f32x2 t = x * x, u = t * (-0.1029432397f) + (-2.302208198f), a = x * u;
    f32x2 e; e.x = __builtin_amdgcn_exp2f(a.x); e.y = __builtin_amdgcn_exp2f(a.y); const f32x2 d = e + 1.0f;
    f32x2 r; r.x = __builtin_amdgcn_rcpf(d.x); r.y = __builtin_amdgcn_rcpf(d.y); return x * r; }
__device__ __forceinline__ f32x2 sigm2(f32x2 x) { const f32x2 a = x * (-1.4426950409f);
    f32x2 e; e.x = __builtin_amdgcn_exp2f(a.x); e.y = __builtin_amdgcn_exp2f(a.y); const f32x2 d = e + 1.0f;
    f32x2 r; r.x = __builtin_amdgcn_rcpf(d.x); r.y = __builtin_amdgcn_rcpf(d.y); return r; }
#define ACT4(v, F) do { const f32x2 _lo = F((f32x2){v[0], v[1]}), _hi = F((f32x2){v[2], v[3]}); v = (f32x4){_lo.x, _lo.y, _hi.x, _hi.y}; } while (0)

__device__ __forceinline__ int lane_id_opq() { int l; asm volatile("v_mbcnt_lo_u32_b32 %0, -1, 0\n\tv_mbcnt_hi_u32_b32 %0, -1, %0" : "=v"(l)); return l; }
__device__ __forceinline__ float shx(float v, int mask, int lane) { return __int_as_float(__builtin_amdgcn_ds_bpermute((lane ^ mask) << 2, __float_as_int(v))); }
typedef f32x4 Acc[2][2][4][2];
#define EPI_ARGS Acc& acc, const Unit& u, int wr, int wc, int fr, int fq, PG8_LAS unsigned char* xl, const float (&pre)[8]

#define PACK8(w, v0, v1) do { w.x = cvt_pk_bf16(v0[0], v0[1]); w.y = cvt_pk_bf16(v0[2], v0[3]); w.z = cvt_pk_bf16(v1[0], v1[1]); w.w = cvt_pk_bf16(v1[2], v1[3]); } while (0)
#define MUL8(v0, v1, g) do { v0[0] *= bf_lo(g.x); v0[1] *= bf_hi(g.x); v0[2] *= bf_lo(g.y); v0[3] *= bf_hi(g.y); v1[0] *= bf_lo(g.z); v1[1] *= bf_hi(g.z); v1[2] *= bf_lo(g.w); v1[3] *= bf_hi(g.w); } while (0)
#define ADD8(v0, v1, g) do { v0[0] += bf_lo(g.x); v0[1] += bf_hi(g.x); v0[2] += bf_lo(g.y); v0[3] += bf_hi(g.y); v1[0] += bf_lo(g.z); v1[1] += bf_hi(g.z); v1[2] += bf_lo(g.w); v1[3] += bf_hi(g.w); } while (0)
#define ROW_RS8(rs, stats, row0) do { f32x4 _a[2][4], _b[2][4]; \
    _Pragma("unroll") for (int ai = 0; ai < 2; ++ai) _Pragma("unroll") for (int m = 0; m < 4; ++m) { const float* _p = (stats) + (size_t)((row0) + ai * HALF + m * 16) * 8; _a[ai][m] = *(const f32x4*)_p; _b[ai][m] = *(const f32x4*)(_p + 4); } \
    _Pragma("unroll") for (int ai = 0; ai < 2; ++ai) _Pragma("unroll") for (int m = 0; m < 4; ++m) \
        rs[ai][m] = 1.0f / sqrtf(((_a[ai][m][0] + _a[ai][m][1]) + (_a[ai][m][2] + _a[ai][m][3]) + (_b[ai][m][0] + _b[ai][m][1]) + (_b[ai][m][2] + _b[ai][m][3])) * (1.0f / 2048.0f) + 1e-6f); } while (0)
__device__ __forceinline__ void gate2(f32x2& a, f32x2& s, float k) { const f32x2 ta = a * k, ts = s * k;
    f32x2 ea, es; ea.x = __builtin_amdgcn_exp2f(ta.x); ea.y = __builtin_amdgcn_exp2f(ta.y); es.x = __builtin_amdgcn_exp2f(ts.x); es.y = __builtin_amdgcn_exp2f(ts.y);
    const f32x2 da = ea + 1.0f, ds = es + 1.0f;
    f32x2 ra, rs; ra.x = __builtin_amdgcn_rcpf(da.x); ra.y = __builtin_amdgcn_rcpf(da.y); rs.x = __builtin_amdgcn_rcpf(ds.x); rs.y = __builtin_amdgcn_rcpf(ds.y);
    a = ds * ra; s = rs; }
#define GATE4(a, s, k) do { f32x2 _al = {a[0], a[1]}, _ah = {a[2], a[3]}, _sl = {s[0], s[1]}, _sh = {s[2], s[3]}; gate2(_al, _sl, k); gate2(_ah, _sh, k); \
    a = (f32x4){_al.x, _al.y, _ah.x, _ah.y}; s = (f32x4){_sl.x, _sl.y, _sh.x, _sh.y}; } while (0)
template <int MODE, bool PRE_ = false> struct EpiBf16 {
    static constexpr bool MID = false, PERM = true, PRE = PRE_;
    bf16_t* C; int ldc; long cS1, cS2; const float* stats;
    float* lnst; int pn0 = 0;
    __device__ __forceinline__ const float* pre_base(const Unit& u) const { return stats + (size_t)u.pm * BM; }
    __device__ __forceinline__ void operator()(EPI_ARGS) const {
        const int pn = u.pn + pn0;
        int act = 0; if (MODE == 1) act = pn < 20 ? 0 : (pn < 28 ? 1 : 2);
        const bool lnrows = (MODE == 1) && pn >= 20 && pn < 28;
        char* ub = (char*)(C + (long)u.z1 * cS1 + (long)u.z2 * cS2 + (long)u.pm * BM * ldc + pn * BM);
        const unsigned lo = (unsigned)((wr * 64 + fr) * ldc + wc * 32 + 8 * fq) * 2u;
        float rs[2][4];
        if (PRE) {
#pragma unroll
            for (int ai = 0; ai < 2; ++ai)
#pragma unroll
                for (int m = 0; m < 4; ++m) rs[ai][m] = pre[ai * 4 + m]; }
        else if (stats) ROW_RS8(rs, stats, u.pm * BM + wr * 64 + fr);
        else {
#pragma unroll
            for (int ai = 0; ai < 2; ++ai)
#pragma unroll
                for (int m = 0; m < 4; ++m) rs[ai][m] = 1.0f; }
        if (MODE == 1 && act == 2) {
            char* g0 = (char*)(C + (long)u.pm * BM * ldc + C_GA + 128 * (pn - 28));
#pragma unroll
            for (int ai = 0; ai < 2; ++ai)
#pragma unroll
                for (int m = 0; m < 4; ++m) { char* rb = g0 + (size_t)(ai * HALF + m * 16) * ldc * 2;
                    f32x4 a0 = acc[ai][0][m][0], a1 = acc[ai][0][m][1], s0 = acc[ai][1][m][0], s1 = acc[ai][1][m][1]; const float kk = rs[ai][m] * (-1.4426950409f);
                    GATE4(a0, s0, kk); GATE4(a1, s1, kk);
                    asm volatile("s_nop 0" : "+v"(s0), "+v"(s1));
                    { u32x4 w; PACK8(w, a0, a1); *(u32x4*)(rb + lo) = w; }
                    { u32x4 w; PACK8(w, s0, s1); *(u32x4*)(rb + lo + (C_GS - C_GA) * 2) = w; } }
            return; }
#pragma unroll
        for (int ai = 0; ai < 2; ++ai)
#pragma unroll
            for (int m = 0; m < 4; ++m) { char* rb = ub + (size_t)(ai * HALF + m * 16) * ldc * 2;
                float s1 = 0.f, s2 = 0.f;
#pragma unroll
                for (int bj = 0; bj < 2; ++bj) { f32x4 v0 = acc[ai][bj][m][0] * rs[ai][m], v1 = acc[ai][bj][m][1] * rs[ai][m];
                    if (act == 1) { ACT4(v0, gelu_t2); ACT4(v1, gelu_t2); }
                    else if (act == 2) { ACT4(v0, sigm2); ACT4(v1, sigm2); }
                    u32x4 w; PACK8(w, v0, v1);
                    *(u32x4*)(rb + lo + bj * 256) = w;
                    if (MODE == 1 && lnrows) { const f32x4 t = v0 + v1, q = v0 * v0 + v1 * v1; s1 += (t[0] + t[1]) + (t[2] + t[3]); s2 += (q[0] + q[1]) + (q[2] + q[3]); } }
                if (MODE == 1 && lnrows) { const int ln = fq * 16 + fr; s1 += shx(s1, 16, ln); s1 += shx(s1, 32, ln); s2 += shx(s2, 16, ln); s2 += shx(s2, 32, ln);
                    if (fq == 0) ((PG8_LAS f32x2*)xl)[(ai * HALF + wr * 64 + m * 16 + fr) * 4 + wc] = (f32x2){s1, s2}; } }
        if (MODE == 1 && lnrows) {
            asm volatile("s_waitcnt lgkmcnt(0)" ::: "memory"); __builtin_amdgcn_s_barrier(); asm volatile("" ::: "memory");
            if (fq == 0) {
#pragma unroll
                for (int ai = 0; ai < 2; ++ai) { const int r = ai * HALF + wr * 64 + wc * 16 + fr; const PG8_LAS f32x2* q = (const PG8_LAS f32x2*)xl + r * 4;
                    const f32x2 a = q[0], b = q[1], c = q[2], d = q[3];
                    *(f32x2*)(lnst + ((size_t)(u.pm * BM + r) * 8 + (pn - 20)) * 2) = (f32x2){(a.x + b.x) + (c.x + d.x), (a.y + b.y) + (c.y + d.y)}; } }
        }
    }
};
struct EpiRes {
    static constexpr bool MID = false, PERM = true, PRE = false;
    bf16_t* XB; int ldc; long cS1; float* stats; int rows_per_z;
    __device__ __forceinline__ void operator()(EPI_ARGS) const {
        char* ub = (char*)(XB + (long)u.z1 * cS1 + (long)u.pm * BM * ldc + u.pn * BM);
        const unsigned lo = (unsigned)((wr * 64 + fr) * ldc + wc * 32 + 8 * fq) * 2u;
        PG8_LAS float* XS = (PG8_LAS float*)xl;
        const int ln = fq * 16 + fr;
        u32x4 xq[2][4][2];
#pragma unroll
        for (int ai = 0; ai < 2; ++ai)
#pragma unroll
            for (int m = 0; m < 4; ++m)
#pragma unroll
                for (int bj = 0; bj < 2; ++bj) xq[ai][m][bj] = *(const u32x4*)(ub + (size_t)(ai * HALF + m * 16) * ldc * 2 + lo + bj * 256);
        asm volatile("" ::: "memory");
#pragma unroll
        for (int ai = 0; ai < 2; ++ai)
#pragma unroll
            for (int m = 0; m < 4; ++m) { float ss = 0.f;
#pragma unroll
                for (int bj = 0; bj < 2; ++bj) { f32x4 v0 = acc[ai][bj][m][0], v1 = acc[ai][bj][m][1];
                    ADD8(v0, v1, xq[ai][m][bj]);
                    u32x4 w; PACK8(w, v0, v1); *(u32x4*)(ub + (size_t)(ai * HALF + m * 16) * ldc * 2 + lo + bj * 256) = w;
                    ss += (v0[0] * v0[0] + v0[1] * v0[1]) + (v0[2] * v0[2] + v0[3] * v0[3]) + (v1[0] * v1[0] + v1[1] * v1[1]) + (v1[2] * v1[2] + v1[3] * v1[3]); }
                ss += shx(ss, 16, ln); ss += shx(ss, 32, ln); if (fq == 0) XS[(ai * HALF + wr * 64 + m * 16 + fr) * 4 + wc] = ss; }
        asm volatile("s_waitcnt lgkmcnt(0)" ::: "memory"); __builtin_amdgcn_s_barrier(); asm volatile("" ::: "memory");
        if (fq == 0) {
#pragma unroll
            for (int ai = 0; ai < 2; ++ai) { const int r = ai * HALF + wr * 64 + wc * 16 + fr; const f32x4 q = *(const PG8_LAS f32x4*)(XS + r * 4);
                stats[((size_t)u.z1 * rows_per_z + u.pm * BM + r) * 8 + u.pn] = (q[0] + q[1]) + (q[2] + q[3]); } }
    }
};
template <bool FIRST> struct EpiMix {
    static constexpr bool MID = false, PERM = true, PRE = false;
    const bf16_t* G; bf16_t* O; int ld;
    __device__ __forceinline__ void operator()(EPI_ARGS) const {
        const long uo = (long)u.pm * BM * ld + u.pn * BM;
        const char* gb = (const char*)(G + uo); char* ob = (char*)(O + uo);
        const unsigned lo = (unsigned)((wr * 64 + fr) * ld + wc * 32 + 8 * fq) * 2u;
#pragma unroll
        for (int ai = 0; ai < 2; ++ai) {
            u32x4 gq[4][2], oq[4][2];
#pragma unroll
            for (int m = 0; m < 4; ++m)
#pragma unroll
                for (int bj = 0; bj < 2; ++bj) { const size_t ro = (size_t)(ai * HALF + m * 16) * ld * 2; gq[m][bj] = *(const u32x4*)(gb + ro + lo + bj * 256); if (!FIRST) oq[m][bj] = *(const u32x4*)(ob + ro + lo + bj * 256); }
            asm volatile("" ::: "memory");
#pragma unroll
            for (int m = 0; m < 4; ++m)
#pragma unroll
                for (int bj = 0; bj < 2; ++bj) { const size_t ro = (size_t)(ai * HALF + m * 16) * ld * 2;
                    f32x4 v0 = acc[ai][bj][m][0], v1 = acc[ai][bj][m][1];
                    MUL8(v0, v1, gq[m][bj]);
                    if (!FIRST) ADD8(v0, v1, oq[m][bj]);
                    u32x4 w; PACK8(w, v0, v1);
                    *(u32x4*)(ob + ro + lo + bj * 256) = w; }
            asm volatile("" ::: "memory"); }
    }
};
struct EpiMixF {
    static constexpr bool MID = true, PERM = true, PRE = false;
    const bf16_t* GA; const bf16_t* GS; bf16_t* O; int ld;
    __device__ __forceinline__ void mid(Acc& acc, const Unit& u, int wr, int wc, int fr, int fq) const {
        const char* ab = (const char*)(GA + ((long)u.pm * BM * ld + u.pn * BM));
        const unsigned lo = (unsigned)((wr * 64 + fr) * ld + wc * 32 + 8 * fq) * 2u;
#pragma unroll
        for (int ai = 0; ai < 2; ++ai) {
            u32x4 aq[4][2];
#pragma unroll
            for (int m = 0; m < 4; ++m)
#pragma unroll
                for (int bj = 0; bj < 2; ++bj) aq[m][bj] = *(const u32x4*)(ab + (size_t)(ai * HALF + m * 16) * ld * 2 + lo + bj * 256);
            asm volatile("" ::: "memory");
#pragma unroll
            for (int m = 0; m < 4; ++m)
#pragma unroll
                for (int bj = 0; bj < 2; ++bj) MUL8(acc[ai][bj][m][0], acc[ai][bj][m][1], aq[m][bj]);
            asm volatile("" ::: "memory"); }
    }
    __device__ __forceinline__ void operator()(EPI_ARGS) const {
        const long uo = (long)u.pm * BM * ld + u.pn * BM;
        const char* gb = (const char*)(GS + uo); char* ob = (char*)(O + uo);
        const unsigned lo = (unsigned)((wr * 64 + fr) * ld + wc * 32 + 8 * fq) * 2u;
#pragma unroll
        for (int ai = 0; ai < 2; ++ai) {
            u32x4 gq[4][2];
#pragma unroll
            for (int m = 0; m < 4; ++m)
#pragma unroll
                for (int bj = 0; bj < 2; ++bj) { const size_t ro = (size_t)(ai * HALF + m * 16) * ld * 2; gq[m][bj] = *(const u32x4*)(gb + ro + lo + bj * 256); }
            asm volatile("" ::: "memory");
#pragma unroll
            for (int m = 0; m < 4; ++m)
#pragma unroll
                for (int bj = 0; bj < 2; ++bj) { const size_t ro = (size_t)(ai * HALF + m * 16) * ld * 2;
                    f32x4 v0 = acc[ai][bj][m][0], v1 = acc[ai][bj][m][1];
                    MUL8(v0, v1, gq[m][bj]);
                    u32x4 w; PACK8(w, v0, v1);
                    *(u32x4*)(ob + ro + lo + bj * 256) = w; }
            asm volatile("" ::: "memory"); }
    }
};
struct EpiSpatial {
    static constexpr bool MID = false, PERM = true, PRE = false;
    bf16_t* U; int ld; const float* bs;
    __device__ __forceinline__ void operator()(EPI_ARGS) const {
        char* ub = (char*)(U + (long)u.z1 * BM * ld + u.z2 * BM);
        const unsigned lo = (unsigned)((wr * 64 + fr) * ld + wc * 32 + 8 * fq) * 2u;
        const float* bp = bs + u.z2 * 128 + wr * 64;
        u32x4 uq[2][4][2]; float bq[4];
#pragma unroll
        for (int m = 0; m < 4; ++m) bq[m] = bp[m * 16 + fr];
#pragma unroll
        for (int ai = 0; ai < 2; ++ai)
#pragma unroll
            for (int m = 0; m < 4; ++m)
#pragma unroll
                for (int bj = 0; bj < 2; ++bj) uq[ai][m][bj] = *(const u32x4*)(ub + (size_t)(ai * HALF + m * 16) * ld * 2 + lo + bj * 256);
        asm volatile("" ::: "memory");
#pragma unroll
        for (int ai = 0; ai < 2; ++ai)
#pragma unroll
            for (int m = 0; m < 4; ++m)
#pragma unroll
                for (int bj = 0; bj < 2; ++bj) {
                    const u32x4 q = uq[ai][m][bj];
                    f32x4 u0 = (f32x4){bf_lo(q.x), bf_hi(q.x), bf_lo(q.y), bf_hi(q.y)}, u1 = (f32x4){bf_lo(q.z), bf_hi(q.z), bf_lo(q.w), bf_hi(q.w)};
                    ACT4(u0, gelu_t2); ACT4(u1, gelu_t2);
                    const f32x4 v0 = (acc[ai][bj][m][0] + bq[m]) * u0, v1 = (acc[ai][bj][m][1] + bq[m]) * u1;
                    u32x4 w; PACK8(w, v0, v1);
                    *(u32x4*)(ub + (size_t)(ai * HALF + m * 16) * ld * 2 + lo + bj * 256) = w; }
    }
};
#define DPP_SHR1 0x111
#define DPP_SHL1 0x101
#define DPP_ROR1 0x121
#define DPP_ROR15 0x12F
#define DPPI(old, src, ctrl) ((unsigned)__builtin_amdgcn_update_dpp((int)(old), (int)(src), ctrl, 0xF, 0xF, false))
struct EpiConv {
    static constexpr bool MID = false, PERM = true, PRE = true;
    __device__ __forceinline__ const float* pre_base(const Unit& u) const { return stats + (size_t)u.pm * BM; }
    const bf16_t* A; bf16_t* O; int ld; const float* stats; const float* cw; const float* cb;
    __device__ __forceinline__ void operator()(EPI_ARGS) const {
        {
#pragma unroll
          for (int ai = 0; ai < 2; ++ai)
#pragma unroll
            for (int m = 0; m < 4; ++m)
#pragma unroll
                for (int bj = 0; bj < 2; ++bj) { acc[ai][bj][m][0] *= pre[ai * 4 + m]; acc[ai][bj][m][1] *= pre[ai * 4 + m]; } }
        const long uo = (long)u.pm * BM * ld + u.pn * BM;
        const char* ab = (const char*)(A + uo); char* ob = (char*)(O + uo);
        const int ld2 = ld * 2;
        const unsigned lo = (unsigned)((wr * 64 + fr) * ld + wc * 32 + 8 * fq) * 2u;
        const unsigned loe = (unsigned)((wr * 64) * ld + wc * 32 + 8 * fq) * 2u;
        const int pm8 = u.pm & 7;
#pragma unroll
        for (int bj = 0; bj < 2; ++bj) {
            const float* pp = cw + u.pn * BM + bj * HALF + wc * 32 + 8 * fq; const float* pb = cb + u.pn * BM + bj * HALF + wc * 32 + 8 * fq;
            const f32x4 w0a = *(const f32x4*)pp, w0b = *(const f32x4*)(pp + 4), w1a = *(const f32x4*)(pp + ld), w1b = *(const f32x4*)(pp + ld + 4),
                        w2a = *(const f32x4*)(pp + 2 * ld), w2b = *(const f32x4*)(pp + 2 * ld + 4), cba = *(const f32x4*)pb, cbb = *(const f32x4*)(pb + 4);
#pragma unroll
            for (int ai = 0; ai < 2; ++ai) {
                const bool tz = (pm8 == 0) && (ai == 0) && (wr == 0), bz = (pm8 == 7) && (ai == 1) && (wr == 1);
                u32x4 qc[4], et, eb;
#pragma unroll
                for (int m = 0; m < 4; ++m) qc[m] = *(const u32x4*)(ab + (size_t)(ai * HALF + m * 16) * ld2 + lo + bj * 256);
                et = *(const u32x4*)(ab + (long)(ai * HALF + (tz ? 0 : -1)) * ld2 + loe + bj * 256);
                eb = *(const u32x4*)(ab + (long)(ai * HALF + (bz ? 63 : 64)) * ld2 + loe + bj * 256);
                asm volatile("" ::: "memory");
                if (tz) et = (u32x4){0u, 0u, 0u, 0u};
                if (bz) eb = (u32x4){0u, 0u, 0u, 0u};
#pragma unroll
                for (int m = 0; m < 4; ++m) {
                    u32x4 zp, zn; const u32x4 zc = qc[m];
#pragma unroll
                    for (int d = 0; d < 4; ++d) {
                        const unsigned X = (m == 0) ? et[d] : DPPI(0, qc[m > 0 ? m - 1 : 0][d], DPP_ROR1);
                        zp[d] = DPPI(X, zc[d], DPP_SHR1);
                        const unsigned Y = (m == 3) ? eb[d] : DPPI(0, qc[m < 3 ? m + 1 : 3][d], DPP_ROR15);
                        zn[d] = DPPI(Y, zc[d], DPP_SHL1); }
#define UNP4(lo4, hi4, QQ) const f32x4 lo4 = (f32x4){bf_lo(QQ.x), bf_hi(QQ.x), bf_lo(QQ.y), bf_hi(QQ.y)}, hi4 = (f32x4){bf_lo(QQ.z), bf_hi(QQ.z), bf_lo(QQ.w), bf_hi(QQ.w)}
                    UNP4(pl, ph, zp); UNP4(cl, ch, zc); UNP4(nl, nh, zn);
#undef UNP4
                    f32x4 c0 = cba + w0a * pl + w1a * cl + w2a * nl, c1 = cbb + w0b * ph + w1b * ch + w2b * nh;
                    ACT4(c0, gelu_t2); ACT4(c1, gelu_t2);
                    const f32x4 v0 = acc[ai][bj][m][0] * c0, v1 = acc[ai][bj][m][1] * c1;
                    u32x4 w; PACK8(w, v0, v1);
                    *(u32x4*)(ob + (size_t)(ai * HALF + m * 16) * ld2 + lo + bj * 256) = w; }
                asm volatile("" ::: "memory"); }
        }
    }
};
struct EpiUp {
    static constexpr bool MID = false, PERM = true, PRE = true;
    bf16_t* O; int ldo; const float* stats; const float* cw; const float* cb; float* EA; float* EB;
    __device__ __forceinline__ const float* pre_base(const Unit& u) const { return stats + (size_t)u.pm * BM; }
    __device__ __forceinline__ void operator()(EPI_ARGS) const {
#pragma unroll
        for (int ai = 0; ai < 2; ++ai)
#pragma unroll
            for (int m = 0; m < 4; ++m)
#pragma unroll
                for (int bj = 0; bj < 2; ++bj) { acc[ai][bj][m][0] *= pre[ai * 4 + m]; acc[ai][bj][m][1] *= pre[ai * 4 + m]; }
        const int ch0 = u.pn * HALF + wc * 32 + 8 * fq;
        const float* pp = cw + ch0; const float* pb = cb + ch0;
        const f32x4 w0a = *(const f32x4*)pp, w0b = *(const f32x4*)(pp + 4), w1a = *(const f32x4*)(pp + ldo), w1b = *(const f32x4*)(pp + ldo + 4),
                    w2a = *(const f32x4*)(pp + 2 * ldo), w2b = *(const f32x4*)(pp + 2 * ldo + 4), cba = *(const f32x4*)pb, cbb = *(const f32x4*)(pb + 4);
        PG8_LAS float* E = (PG8_LAS float*)xl;
        const int cl = wc * 32 + 8 * fq;
#pragma unroll
        for (int ai = 0; ai < 2; ++ai) { const int blk = ai * 2 + wr;
            if (fr == 0)  { *(PG8_LAS f32x4*)(E + (blk * 2 + 0) * HALF + cl) = acc[ai][0][0][0]; *(PG8_LAS f32x4*)(E + (blk * 2 + 0) * HALF + cl + 4) = acc[ai][0][0][1]; }
            if (fr == 15) { *(PG8_LAS f32x4*)(E + (blk * 2 + 1) * HALF + cl) = acc[ai][0][3][0]; *(PG8_LAS f32x4*)(E + (blk * 2 + 1) * HALF + cl + 4) = acc[ai][0][3][1]; } }
        asm volatile("s_waitcnt lgkmcnt(0)" ::: "memory"); __builtin_amdgcn_s_barrier(); asm volatile("" ::: "memory");
        char* ob = (char*)(O + (long)u.pm * BM * ldo + ch0);
        const unsigned lo = (unsigned)((wr * 64 + fr) * ldo) * 2u;
#define DPPF(old, src, ctrl) __uint_as_float((unsigned)__builtin_amdgcn_update_dpp((int)__float_as_uint(old), (int)__float_as_uint(src), ctrl, 0xF, 0xF, false))
#pragma unroll
        for (int ai = 0; ai < 2; ++ai) { const int blk = ai * 2 + wr;
            f32x4 et0 = (f32x4){0.f, 0.f, 0.f, 0.f}, et1 = et0, eb0 = et0, eb1 = et0;
            if (blk > 0) { et0 = *(const PG8_LAS f32x4*)(E + ((blk - 1) * 2 + 1) * HALF + cl); et1 = *(const PG8_LAS f32x4*)(E + ((blk - 1) * 2 + 1) * HALF + cl + 4); }
            if (blk < 3) { eb0 = *(const PG8_LAS f32x4*)(E + ((blk + 1) * 2 + 0) * HALF + cl); eb1 = *(const PG8_LAS f32x4*)(E + ((blk + 1) * 2 + 0) * HALF + cl + 4); }
#pragma unroll
            for (int m = 0; m < 4; ++m) {
                const f32x4 c0 = acc[ai][0][m][0], c1 = acc[ai][0][m][1]; f32x4 p0, p1, n0, n1;
#pragma unroll
                for (int e = 0; e < 4; ++e) {
                    const float X0 = (m == 0) ? et0[e] : DPPF(0.f, acc[ai][0][m > 0 ? m - 1 : 0][0][e], DPP_ROR1), X1 = (m == 0) ? et1[e] : DPPF(0.f, acc[ai][0][m > 0 ? m - 1 : 0][1][e], DPP_ROR1);
                    p0[e] = DPPF(X0, c0[e], DPP_SHR1); p1[e] = DPPF(X1, c1[e], DPP_SHR1);
                    const float Y0 = (m == 3) ? eb0[e] : DPPF(0.f, acc[ai][0][m < 3 ? m + 1 : 3][0][e], DPP_ROR15), Y1 = (m == 3) ? eb1[e] : DPPF(0.f, acc[ai][0][m < 3 ? m + 1 : 3][1][e], DPP_ROR15);
                    n0[e] = DPPF(Y0, c0[e], DPP_SHL1); n1[e] = DPPF(Y1, c1[e], DPP_SHL1); }
                f32x4 g0 = cba + w0a * p0 + w1a * c0 + w2a * n0, g1 = cbb + w0b * p1 + w1b * c1 + w2b * n1;
                ACT4(g0, gelu_t2); ACT4(g1, gelu_t2);
                const f32x4 v0 = acc[ai][1][m][0] * g0, v1 = acc[ai][1][m][1] * g1;
                u32x4 w; PACK8(w, v0, v1);
                *(u32x4*)(ob + (size_t)(ai * HALF + m * 16) * ldo * 2 + lo) = w; } }
#undef DPPF
        if (wr == 0 && fr < 2) { float* ea = EA + ((size_t)u.pm * 4 + fr) * ldo + ch0; *(f32x4*)ea = acc[0][0][0][0]; *(f32x4*)(ea + 4) = acc[0][0][0][1];
            if (fr == 0) { float* eb = EB + ((size_t)u.pm * 2 + 0) * ldo + ch0; *(f32x4*)eb = acc[0][1][0][0]; *(f32x4*)(eb + 4) = acc[0][1][0][1]; } }
        if (wr == 1 && fr >= 14) { float* ea = EA + ((size_t)u.pm * 4 + 2 + (fr - 14)) * ldo + ch0; *(f32x4*)ea = acc[1][0][3][0]; *(f32x4*)(ea + 4) = acc[1][0][3][1];
            if (fr == 15) { float* eb = EB + ((size_t)u.pm * 2 + 1) * ldo + ch0; *(f32x4*)eb = acc[1][1][3][0]; *(f32x4*)(eb + 4) = acc[1][1][3][1]; } }
    }
};
struct EpiSoftmax {
    static constexpr bool MID = false, PERM = true, PRE = false;
    bf16_t* P; int ldc; long cS1; float sc2; const float* stats; int rows_per_z;
    __device__ __forceinline__ void operator()(EPI_ARGS) const {
        PG8_LAS f32x2* X = (PG8_LAS f32x2*)xl;
        float mw[2][4], rsr[2][4]; const int ln = fq * 16 + fr;
        ROW_RS8(rsr, stats, u.z1 * rows_per_z + u.pm * BM + wr * 64 + fr);
#pragma unroll
        for (int ai = 0; ai < 2; ++ai)
#pragma unroll
            for (int m = 0; m < 4; ++m) {
                float mx = -3.0e38f; const float rsc = sc2 * rsr[ai][m];
#pragma unroll
                for (int bj = 0; bj < 2; ++bj)
#pragma unroll
                    for (int n = 0; n < 2; ++n)
#pragma unroll
                        for (int e = 0; e < 4; ++e) { const float v = acc[ai][bj][m][n][e] * rsc; acc[ai][bj][m][n][e] = v; mx = fmaxf(mx, v); }
                mx = fmaxf(mx, shx(mx, 16, ln)); mx = fmaxf(mx, shx(mx, 32, ln));
                float s = 0.f;
#pragma unroll
                for (int bj = 0; bj < 2; ++bj)
#pragma unroll
                    for (int n = 0; n < 2; ++n)
#pragma unroll
                        for (int e = 0; e < 4; ++e) { const float p = __builtin_amdgcn_exp2f(acc[ai][bj][m][n][e] - mx); acc[ai][bj][m][n][e] = p; s += p; }
                s += shx(s, 16, ln); s += shx(s, 32, ln);
                mw[ai][m] = mx;
                if (fq == 0) X[(ai * HALF + wr * 64 + m * 16 + fr) * 4 + wc] = (f32x2){mx, s};
            }
        asm volatile("s_waitcnt lgkmcnt(0)" ::: "memory"); __builtin_amdgcn_s_barrier(); asm volatile("" ::: "memory");
        char* ub = (char*)(P + (long)u.z1 * cS1 + (long)u.pm * BM * ldc + u.pn * BM);
        const unsigned lo = (unsigned)((wr * 64 + fr) * ldc + wc * 32 + 8 * fq) * 2u;
#pragma unroll
        for (int ai = 0; ai < 2; ++ai)
#pragma unroll
            for (int m = 0; m < 4; ++m) { const int r = ai * HALF + wr * 64 + m * 16 + fr;
                const f32x2 a = X[r * 4 + 0], b = X[r * 4 + 1], c = X[r * 4 + 2], d = X[r * 4 + 3];
                const float mt = fmaxf(fmaxf(a.x, b.x), fmaxf(c.x, d.x));
                const float l = a.y * __builtin_amdgcn_exp2f(a.x - mt) + b.y * __builtin_amdgcn_exp2f(b.x - mt) + c.y * __builtin_amdgcn_exp2f(c.x - mt) + d.y * __builtin_amdgcn_exp2f(d.x - mt);
                const float f = __builtin_amdgcn_exp2f(mw[ai][m] - mt) / l;
                char* rb = ub + (size_t)(ai * HALF + m * 16) * ldc * 2;
#pragma unroll
                for (int bj = 0; bj < 2; ++bj) { const f32x4 v0 = acc[ai][bj][m][0] * f, v1 = acc[ai][bj][m][1] * f; u32x4 w; PACK8(w, v0, v1);
                    *(u32x4*)(rb + lo + bj * 256) = w; } }
    }
};

template <class Epi>
__device__ __forceinline__ void gemm_phase(PG8_LAS unsigned char* lds, PG8_LAS unsigned char* xl, const Gemm g, const Sched& S, const Epi& E, const int wid) {
    const int lane = lane_id_opq(), tid = wid * 64 + lane;
    const int wr = wid >> 2, wc = wid & 3, fr = lane & 15, fq = lane >> 4;
    const int K = g.K, nt = K / BK;
    unsigned voffA[2], voffB[2];
#pragma unroll
    for (int i = 0; i < 2; ++i) { int R, C; stage_rc(tid * 16 + i * 8192, R, C); const int Rb = Epi::PERM ? ((R & ~31) + perm32(R & 31)) : R;
        voffA[i] = (unsigned)(R * g.lda + C) * 2u; voffB[i] = (unsigned)(Rb * g.ldb + C) * 2u; }
    const size_t kstep = (size_t)(BK * 2);
    const size_t hstepA = (size_t)HALF * g.lda * 2, hstepB = (size_t)HALF * g.ldb * 2;
    const unsigned ldsw = (unsigned)wid * 1024u;
    const int aoff = lds_byte(wr * 64 + fr, fq * 8), boff = lds_byte(wc * 32 + fr, fq * 8);
#define PG8_SA(b, h) (((b) * 2 + (h)) * HTB)
#define PG8_SB(b, h) ((4 + (b) * 2 + (h)) * HTB)
#define PG8_STAGE(bufoff, gbase, voff) do { _Pragma("unroll") for (int _i = 0; _i < 2; ++_i) \
        __builtin_amdgcn_global_load_lds((const unsigned*)((const char*)(gbase) + (voff)[_i]), (PG8_LAS unsigned*)(lds + (bufoff) + ldsw + _i * 8192), 16, 0, 0); } while (0)
#define PG8_LDA(dst, b, h) do { _Pragma("unroll") for (int m = 0; m < 4; ++m) _Pragma("unroll") for (int k = 0; k < 2; ++k) dst[m][k] = *(const PG8_LAS bf16x8*)(lds + PG8_SA(b, h) + aoff + m * 2048 + k * 1024); } while (0)
#define PG8_LDB(dst, b, h) do { _Pragma("unroll") for (int n = 0; n < 2; ++n) _Pragma("unroll") for (int k = 0; k < 2; ++k) dst[n][k] = *(const PG8_LAS bf16x8*)(lds + PG8_SB(b, h) + boff + n * 2048 + k * 1024); } while (0)
#define PG8_MMA(ai, bj, At, Bt) do { __builtin_amdgcn_s_setprio(1); _Pragma("unroll") for (int m = 0; m < 4; ++m) _Pragma("unroll") for (int n = 0; n < 2; ++n) _Pragma("unroll") for (int k = 0; k < 2; ++k) \
        acc[ai][bj][m][n] = __builtin_amdgcn_mfma_f32_16x16x32_bf16(Bt[n][k], At[m][k], acc[ai][bj][m][n], 0, 0, 0); __builtin_amdgcn_s_setprio(0); } while (0)
#define PG8_WAIT_V(n) asm volatile("s_waitcnt vmcnt(" #n ")" ::: "memory")
#define PG8_WAIT_L(n) asm volatile("s_waitcnt lgkmcnt(" #n ")" ::: "memory")
#define PG8_BAR __builtin_amdgcn_s_barrier()
#define PG8_SCHED __builtin_amdgcn_sched_barrier(0)
    Unit cur, nxt; int ui = 0;
    if (!S.next(0, cur)) return;
    Acc acc;
#pragma unroll
    for (int a = 0; a < 2; ++a)
#pragma unroll
        for (int b = 0; b < 2; ++b)
#pragma unroll
            for (int m = 0; m < 4; ++m)
#pragma unroll
                for (int n = 0; n < 2; ++n) acc[a][b][m][n] = (f32x4){0.f, 0.f, 0.f, 0.f};
    bf16x8 At[4][2], B0[2][2], B1[2][2];
    float prc[8];
#pragma unroll
    for (int k = 0; k < 8; ++k) prc[k] = 1.0f;
    if constexpr (Epi::PRE) { const float* pb = E.pre_base(cur) + wr * 64 + fr;
#pragma unroll
        for (int k = 0; k < 8; ++k) prc[k] = pb[(k >> 2) * HALF + (k & 3) * 16]; }
    const char* cA = a_tile(g, cur); const char* cB = b_tile(g, cur);
    PG8_STAGE(PG8_SB(0, 0), cB, voffB); PG8_STAGE(PG8_SB(0, 1), cB + hstepB, voffB); PG8_STAGE(PG8_SA(0, 0), cA, voffA); PG8_STAGE(PG8_SA(0, 1), cA + hstepA, voffA);
    if (wr == 1) PG8_BAR;
    PG8_WAIT_V(2); PG8_BAR;
    PG8_STAGE(PG8_SB(1, 0), cB + kstep, voffB); PG8_STAGE(PG8_SA(1, 0), cA + kstep, voffA); PG8_STAGE(PG8_SB(1, 1), cB + hstepB + kstep, voffB);
    PG8_WAIT_V(6); PG8_BAR;
    for (;;) {
        const bool has_next = S.next(ui + 1, nxt);
        const char* nA = has_next ? a_tile(g, nxt) : cA; const char* nB = has_next ? b_tile(g, nxt) : cB;
        for (int t = 0; t < nt; t += 2) {
            const bool last = (t == nt - 2);
            long j1 = 0, ja2 = 0, jb2 = 0;
            if constexpr (Epi::MID) {
                if (t == g.tj) { const int lnM = lane_id_opq(); E.mid(acc, cur, wr, wc, lnM & 15, lnM >> 4); }
                if (t >= g.tj) j1 = g.jA;
                if (t + 2 >= g.tj) { ja2 = g.jA; jb2 = g.jB; } }
            const char* a1 = cA + (size_t)(t + 1) * kstep + j1;
            const char* a2 = last ? nA : cA + (size_t)(t + 2) * kstep + ja2; const char* b2 = last ? nB : cB + (size_t)(t + 2) * kstep + jb2;
            const char* a3 = a2 + kstep; const char* b3 = b2 + kstep;
            PG8_LDB(B0, 0, 0); PG8_LDB(B1, 0, 1); PG8_SCHED; PG8_LDA(At, 0, 0); PG8_STAGE(PG8_SA(1, 1), a1 + hstepA, voffA);
            PG8_WAIT_V(8); PG8_WAIT_L(0); PG8_BAR; PG8_MMA(0, 0, At, B0); PG8_MMA(0, 1, At, B1); PG8_BAR; PG8_SCHED;
            PG8_LDA(At, 0, 1); PG8_STAGE(PG8_SB(0, 0), b2, voffB); PG8_STAGE(PG8_SB(0, 1), b2 + hstepB, voffB); PG8_STAGE(PG8_SA(0, 0), a2, voffA);
            PG8_WAIT_V(8); PG8_WAIT_L(0); PG8_BAR; PG8_MMA(1, 0, At, B0); PG8_MMA(1, 1, At, B1); PG8_BAR; PG8_SCHED;
            PG8_LDB(B0, 1, 0); PG8_LDB(B1, 1, 1); PG8_SCHED; PG8_LDA(At, 1, 0); PG8_STAGE(PG8_SA(0, 1), a2 + hstepA, voffA);
            PG8_WAIT_V(8); PG8_WAIT_L(0); PG8_BAR; PG8_MMA(0, 0, At, B0); PG8_MMA(0, 1, At, B1); PG8_BAR; PG8_SCHED;
            PG8_LDA(At, 1, 1); PG8_STAGE(PG8_SB(1, 0), b3, voffB); PG8_STAGE(PG8_SB(1, 1), b3 + hstepB, voffB); PG8_STAGE(PG8_SA(1, 0), a3, voffA);
            PG8_WAIT_V(8); PG8_WAIT_L(0); PG8_BAR; PG8_MMA(1, 0, At, B0); PG8_MMA(1, 1, At, B1); PG8_BAR; PG8_SCHED;
        }
        if (wr == 0) PG8_BAR;
        { const int lnE = lane_id_opq(); const int frE = lnE & 15, fqE = lnE >> 4;
          float prn[8];
#pragma unroll
          for (int k = 0; k < 8; ++k) prn[k] = 1.0f;
          if constexpr (Epi::PRE) { if (has_next) { const float* pb = E.pre_base(nxt) + wr * 64 + frE;
#pragma unroll
              for (int k = 0; k < 8; ++k) prn[k] = pb[(k >> 2) * HALF + (k & 3) * 16]; } }
          E(acc, cur, wr, wc, frE, fqE, xl, prc);
          if constexpr (Epi::PRE) {
#pragma unroll
              for (int k = 0; k < 8; ++k) prc[k] = prn[k]; } }
        if (!has_next) break;
#pragma unroll
        for (int a = 0; a < 2; ++a)
#pragma unroll
            for (int b = 0; b < 2; ++b)
#pragma unroll
                for (int m = 0; m < 4; ++m)
#pragma unroll
                    for (int n = 0; n < 2; ++n) acc[a][b][m][n] = (f32x4){0.f, 0.f, 0.f, 0.f};
        cur = nxt; cA = nA; cB = nB; ++ui;
        if (wr == 1) PG8_BAR;
    }
    PG8_WAIT_V(0);
    PG8_BAR;
#undef PG8_SA
#undef PG8_SB
#undef PG8_STAGE
#undef PG8_LDA
#undef PG8_LDB
#undef PG8_MMA
#undef PG8_WAIT_V
#undef PG8_WAIT_L
#undef PG8_BAR
#undef PG8_SCHED
}
}

namespace attn {
using bf16x8 = __attribute__((ext_vector_type(8))) short;
using s16x4  = __attribute__((ext_vector_type(4))) short;
using f32x16 = __attribute__((ext_vector_type(16))) float;
using u32x4  = __attribute__((ext_vector_type(4))) unsigned;
typedef unsigned short bf16_t;
constexpr int D = 128, NW = 8, QBLK = 32, KVBLK = 64;
constexpr float SCALE = 0.088388347648318440f;
constexpr float THR = 8.f;
constexpr int LD = NIN;
constexpr int NBUF = 3;
constexpr size_t SHM_V = KVBLK * D * 2, SHM_K = KVBLK * D * 2, SHM_WS = NBUF * (SHM_V + SHM_K), SHM_OST = 0;
constexpr int OST_STRIDE = 272, OST_WAVE = 32 * OST_STRIDE;
constexpr size_t SHM_ATTN = SHM_WS + NW * 64 * 4;
static_assert(NW * OST_WAVE <= SHM_WS, "O staging fits inside the ring");
#define KSWZ(row, colB) ((row) * 256 + ((colB) ^ (((row) & 7) << 4)))
#define SBAR() __builtin_amdgcn_sched_barrier(0)
__device__ __forceinline__ int crow(int r, int hi) { return (r & 3) + 8 * (r >> 2) + 4 * hi; }
__device__ __forceinline__ unsigned cvtpk(float lo, float hi) { unsigned r; asm volatile("v_cvt_pk_bf16_f32 %0, %1, %2" : "=v"(r) : "v"(lo), "v"(hi)); return r; }
__device__ __forceinline__ bf16x8 ld8(const bf16_t* p) { return *reinterpret_cast<const bf16x8*>(p); }

__device__ __forceinline__ float fadd_s(float a, float b) { float r; asm("v_add_f32 %0, %1, %2" : "=v"(r) : "v"(a), "v"(b)); return r; }
__device__ __forceinline__ void expHalf(f32x16& p0) {
#pragma unroll
  for (int r = 0; r < 16; ++r) p0[r] = __builtin_amdgcn_exp2f(p0[r]);
}
__device__ __forceinline__ void finishSM(f32x16& p0, f32x16& p1, float& l_reg, bf16x8& pa0, bf16x8& pa1, bf16x8& pa2, bf16x8& pa3) {
#pragma unroll
  for (int r = 0; r < 16; ++r) p1[r] = __builtin_amdgcn_exp2f(p1[r]);
  asm volatile("s_nop 0" : "+v"(p1));
  float s0 = fadd_s(p0[0], p0[1]), s1 = fadd_s(p0[2], p0[3]), s2 = fadd_s(p0[4], p0[5]), s3 = fadd_s(p0[6], p0[7]);
#pragma unroll
  for (int r = 8; r < 16; r += 4) { s0 = fadd_s(s0, p0[r]); s1 = fadd_s(s1, p0[r + 1]); s2 = fadd_s(s2, p0[r + 2]); s3 = fadd_s(s3, p0[r + 3]); }
#pragma unroll
  for (int r = 0; r < 16; r += 4) { s0 = fadd_s(s0, p1[r]); s1 = fadd_s(s1, p1[r + 1]); s2 = fadd_s(s2, p1[r + 2]); s3 = fadd_s(s3, p1[r + 3]); }
  l_reg = fadd_s(l_reg, fadd_s(fadd_s(s0, s1), fadd_s(s2, s3)));
#define PK4(P, BASE, OUT) do { unsigned a0 = cvtpk(P[BASE + 0], P[BASE + 1]), a1 = cvtpk(P[BASE + 2], P[BASE + 3]);   \
    unsigned b0 = cvtpk(P[BASE + 4], P[BASE + 5]), b1 = cvtpk(P[BASE + 6], P[BASE + 7]);                              \
    auto r0 = __builtin_amdgcn_permlane32_swap(a0, b0, false, false); auto r1 = __builtin_amdgcn_permlane32_swap(a1, b1, false, false); \
    u32x4 w = {r0[0], r1[0], r0[1], r1[1]}; OUT = *reinterpret_cast<bf16x8*>(&w); } while (0)
  PK4(p0, 0, pa0); PK4(p0, 8, pa1); PK4(p1, 0, pa2); PK4(p1, 8, pa3);
#undef PK4
}
__device__ __forceinline__ void qkt(f32x16& p0, f32x16& p1, const bf16_t* Ks, const bf16x8* qr, int r32, int hi) {
  p0 = f32x16{}; p1 = f32x16{};
#pragma unroll
  for (int d0 = 0; d0 < 8; ++d0) { int cb = (d0 * 16 + hi * 8) * 2;
    bf16x8 b0 = *reinterpret_cast<const bf16x8*>((const char*)Ks + KSWZ(r32, cb));
    bf16x8 b1 = *reinterpret_cast<const bf16x8*>((const char*)Ks + KSWZ(32 + r32, cb));
    p0 = __builtin_amdgcn_mfma_f32_32x32x16_bf16(b0, qr[d0], p0, 0, 0, 0);
    p1 = __builtin_amdgcn_mfma_f32_32x32x16_bf16(b1, qr[d0], p1, 0, 0, 0); }
}
__device__ __forceinline__ int v_st(int k, int c) { const int kk = (k & ~0xC) | ((k & 4) << 1) | ((k & 8) >> 1); return ((kk >> 3) * 4 + (c >> 5)) * 512 + ((kk & 7) * 32 + (c & 31)) * 2; }
__device__ __forceinline__ int v_rd_base(int lane) { return ((lane & 3) << 3) | (((lane >> 2) & 3) << 6) | (((lane >> 4) & 1) << 5) | (((lane >> 5) & 1) << 8); }
constexpr int v_rd_off(int d0, int ks, int half) { return d0 * 512 + ks * 4096 + half * 2048; }
template <int OFF> __device__ __forceinline__ s16x4 tr_read(int vb) {
  s16x4 r; asm volatile("ds_read_b64_tr_b16 %0, %1 offset:%2" : "=&v"(r) : "v"(vb), "i"(OFF) : "memory"); return r;
}
template <int D0> __device__ __forceinline__ void pv_one(f32x16& od, int vb, bf16x8 pa0, bf16x8 pa1, bf16x8 pa2, bf16x8 pa3) {
  const s16x4 l0 = tr_read<v_rd_off(D0, 0, 0)>(vb), h0 = tr_read<v_rd_off(D0, 0, 1)>(vb), l1 = tr_read<v_rd_off(D0, 1, 0)>(vb), h1 = tr_read<v_rd_off(D0, 1, 1)>(vb);
  const s16x4 l2 = tr_read<v_rd_off(D0, 2, 0)>(vb), h2 = tr_read<v_rd_off(D0, 2, 1)>(vb), l3 = tr_read<v_rd_off(D0, 3, 0)>(vb), h3 = tr_read<v_rd_off(D0, 3, 1)>(vb);
  asm volatile("s_waitcnt lgkmcnt(0)" ::: "memory"); SBAR();
#define PK(L, H) (bf16x8){L[0], L[1], L[2], L[3], H[0], H[1], H[2], H[3]}
  od = __builtin_amdgcn_mfma_f32_32x32x16_bf16(pa0, PK(l0, h0), od, 0, 0, 0);
  od = __builtin_amdgcn_mfma_f32_32x32x16_bf16(pa1, PK(l1, h1), od, 0, 0, 0);
  od = __builtin_amdgcn_mfma_f32_32x32x16_bf16(pa2, PK(l2, h2), od, 0, 0, 0);
  od = __builtin_amdgcn_mfma_f32_32x32x16_bf16(pa3, PK(l3, h3), od, 0, 0, 0);
#undef PK
}
__device__ __forceinline__ void pv_d0(f32x16* o, int vb, bf16x8 pa0, bf16x8 pa1, bf16x8 pa2, bf16x8 pa3) {
  pv_one<0>(o[0], vb, pa0, pa1, pa2, pa3); pv_one<1>(o[1], vb, pa0, pa1, pa2, pa3); pv_one<2>(o[2], vb, pa0, pa1, pa2, pa3); pv_one<3>(o[3], vb, pa0, pa1, pa2, pa3);
}
__device__ __forceinline__ void attn_dense_body(const bf16_t* Qb, const bf16_t* __restrict__ Kh, const bf16_t* __restrict__ Vh, bf16_t* Ob, int seq, char* lds, const int wid,
                                                const float* __restrict__ qg, const float* __restrict__ rope, int t0) {
  const int lane = pg8::lane_id_opq(), tid = wid * 64 + lane;
  const int r32 = lane & 31, hi = lane >> 5;
  bf16_t* V_lds = (bf16_t*)lds; bf16_t* K_lds = (bf16_t*)(lds + NBUF * SHM_V);
  float* ws = (float*)(lds + SHM_WS) + wid * 64; float* li_l = ws;
  float l_reg = 0; f32x16 o[4] = {}; bf16x8 qr[8];
  const bf16_t* Qw = Qb + (long)(wid * QBLK + r32) * LD + hi * 8;
#pragma unroll
  for (int d0 = 0; d0 < 8; ++d0) qr[d0] = ld8(Qw + d0 * 16);
  {
    float y[8][8]; float ss = 0.f;
#pragma unroll
    for (int d0 = 0; d0 < 8; ++d0) { const u32x4 w = __builtin_bit_cast(u32x4, qr[d0]);
      y[d0][0] = __uint_as_float(w.x << 16); y[d0][1] = __uint_as_float(w.x & 0xffff0000u); y[d0][2] = __uint_as_float(w.y << 16); y[d0][3] = __uint_as_float(w.y & 0xffff0000u);
      y[d0][4] = __uint_as_float(w.z << 16); y[d0][5] = __uint_as_float(w.z & 0xffff0000u); y[d0][6] = __uint_as_float(w.w << 16); y[d0][7] = __uint_as_float(w.w & 0xffff0000u);
#pragma unroll
      for (int e = 0; e < 8; ++e) ss += y[d0][e] * y[d0][e]; }
    { auto rr = __builtin_amdgcn_permlane32_swap(__float_as_uint(ss), __float_as_uint(ss), false, false); ss = __uint_as_float(rr[0]) + __uint_as_float(rr[1]); }
    const float rs = (SCALE * 1.4426950408889634f) / sqrtf(ss * (1.f / 128.f) + 1e-6f);
#pragma unroll
    for (int d0 = 0; d0 < 8; ++d0) { const float* gp = qg + d0 * 16 + hi * 8;
#pragma unroll
      for (int e = 0; e < 8; ++e) y[d0][e] *= rs * gp[e]; }
    const int t = t0 + wid * QBLK + r32;
#pragma unroll
    for (int a = 0; a < 2; ++a) {
      const float* cp = rope + (size_t)((a ? (t & 63) : (t >> 6)) * 32 + hi * 8) * 2;
#pragma unroll
      for (int h1 = 0; h1 < 2; ++h1) {
        float c[8], sn[8];
#pragma unroll
        for (int e = 0; e < 8; ++e) { c[e] = cp[(h1 * 16 + e) * 2]; sn[e] = cp[(h1 * 16 + e) * 2 + 1]; }
        const int dA = a * 4 + h1, dB = dA + 2;
#pragma unroll
        for (int e = 0; e < 8; ++e) { const float xa = y[dA][e], xb = y[dB][e]; y[dA][e] = xa * c[e] - xb * sn[e]; y[dB][e] = xb * c[e] + xa * sn[e]; }
      } }
#pragma unroll
    for (int d0 = 0; d0 < 8; ++d0) { u32x4 w = {cvtpk(y[d0][0], y[d0][1]), cvtpk(y[d0][2], y[d0][3]), cvtpk(y[d0][4], y[d0][5]), cvtpk(y[d0][6], y[d0][7])}; qr[d0] = __builtin_bit_cast(bf16x8, w); }
  }
  const int sr = tid >> 4, sc = (tid & 15) * 8, vst0 = v_st(sr, sc), vst1 = v_st(32 + sr, sc);
  const int vb0 = (int)(uintptr_t)V_lds + v_rd_base(lane);
  struct { bf16x8 vs0, vs1, ks0, ks1; } sr_[1];
#define SLOAD(i, k0) do { sr_[i].vs0 = ld8(&Vh[(long)((k0) + sr) * LD + sc]); sr_[i].vs1 = ld8(&Vh[(long)((k0) + 32 + sr) * LD + sc]); \
    sr_[i].ks0 = ld8(&Kh[(long)((k0) + sr) * LD + sc]); sr_[i].ks1 = ld8(&Kh[(long)((k0) + 32 + sr) * LD + sc]); } while (0)
#define SWRITE(off, i) do { *(bf16x8*)((char*)V_lds + (off) + vst0) = sr_[i].vs0;          \
    *(bf16x8*)((char*)V_lds + (off) + vst1) = sr_[i].vs1; int kc = sc * 2;               \
    *(bf16x8*)((char*)K_lds + (off) + KSWZ(sr, kc)) = sr_[i].ks0;                       \
    *(bf16x8*)((char*)K_lds + (off) + KSWZ(32 + sr, kc)) = sr_[i].ks1; } while (0)
#define SWAIT() asm volatile("s_waitcnt vmcnt(0)" ::: "memory")
  f32x16 pA0, pA1, pB0, pB1; bf16x8 pa0, pa1, pa2, pa3; const int NT = seq / KVBLK;
  if (wid >= 4) __builtin_amdgcn_s_setprio(1);
  SLOAD(0, 0); SWAIT(); SWRITE(0, 0);
  SLOAD(0, KVBLK); SWAIT(); SWRITE((int)SHM_V, 0); __syncthreads();
  qkt(pA0, pA1, K_lds, qr, r32, hi); expHalf(pA0);
  int o0 = 0, o1 = (int)SHM_V, o2 = 2 * (int)SHM_V;
#define STEP(PC0, PC1, PN0, PN1, jj, DO_QKT, DO_LOAD) do { \
    SBAR(); if (DO_QKT) qkt(PN0, PN1, (bf16_t*)((char*)K_lds + o1), qr, r32, hi); \
    finishSM(PC0, PC1, l_reg, pa0, pa1, pa2, pa3); SBAR(); \
    if (DO_LOAD) SLOAD(0, ((jj) + 2) * KVBLK); SBAR(); \
    pv_d0(o, vb0 + o0, pa0, pa1, pa2, pa3); if (DO_QKT) expHalf(PN0); \
    if (DO_LOAD) { SWAIT(); SWRITE(o2, 0); } \
    __syncthreads(); \
    { const int t_ = o0; o0 = o1; o1 = o2; o2 = t_; } } while (0)
  int j = 0;
  for (; j + 3 < NT; j += 2) { STEP(pA0, pA1, pB0, pB1, j, true, true); STEP(pB0, pB1, pA0, pA1, j + 1, true, true); }
  STEP(pA0, pA1, pB0, pB1, j, true, false);
  STEP(pB0, pB1, pA0, pA1, j + 1, false, false);
#undef STEP
  __builtin_amdgcn_s_setprio(0);
  { auto rr = __builtin_amdgcn_permlane32_swap(__float_as_uint(l_reg), __float_as_uint(l_reg), false, false); l_reg = __uint_as_float(rr[0]) + __uint_as_float(rr[1]); }
  if (hi == 0) li_l[r32] = l_reg; asm volatile("s_waitcnt lgkmcnt(0)" ::: "memory");
  float rli[16];
#pragma unroll
  for (int r = 0; r < 16; ++r) rli[r] = __builtin_amdgcn_rcpf(li_l[crow(r, hi)]);
  char* stg = lds + SHM_OST + wid * OST_WAVE;
#pragma unroll
  for (int r = 0; r < 16; ++r) { const int orow = crow(r, hi);
#pragma unroll
    for (int d0 = 0; d0 < 4; ++d0) { const float v = o[d0][r] * rli[r]; const unsigned w = cvtpk(v, v); *(bf16_t*)(stg + orow * OST_STRIDE + (d0 * 32 + r32) * 2) = (bf16_t)(w & 0xffffu); } }
  asm volatile("s_waitcnt lgkmcnt(0)" ::: "memory");
  bf16_t* Ow = Ob + (long)(wid * QBLK) * LD;
#pragma unroll
  for (int i = 0; i < 8; ++i) { const int c = i * 64 + lane, row = c >> 4, ch = c & 15; const u32x4 v = *(const u32x4*)(stg + row * OST_STRIDE + ch * 16); *(u32x4*)(Ow + (long)row * LD + ch * 8) = v; }
  asm volatile("s_waitcnt lgkmcnt(0)" ::: "memory");
  __syncthreads();
#undef SLOAD
#undef SWRITE
#undef SWAIT
}
#undef KSWZ
#undef SBAR
}

constexpr size_t MiB = 1u << 20;
constexpr size_t WS_CTL = 0, CTL_ZERO_BYTES = 1 * MiB;
constexpr size_t WS_ROPE = 1 * MiB;
constexpr size_t WS_STATS = 2 * MiB;
constexpr size_t WS_W = 4 * MiB;
constexpr size_t W_IN_T = WS_W;
constexpr size_t W_AO_T = W_IN_T + (size_t)NIN * DM * 2;
constexpr size_t W_SO_T = W_AO_T + (size_t)DM * DM * 2;
constexpr size_t W_OUT_T = W_SO_T + (size_t)DM * DM * 2;
constexpr size_t W_XQ_B = W_OUT_T + (size_t)DM * DM * 2;
constexpr size_t W_XKV_T = W_XQ_B + (size_t)DM * DM * 2;
constexpr size_t W_XO_T = W_XKV_T + (size_t)2 * DM * DM * 2;
constexpr size_t W_UP_T = W_XO_T + (size_t)DM * DM * 2;
constexpr size_t W_DN_T = W_UP_T + (size_t)2 * DFF * DM * 2;
constexpr size_t W_SBLK = W_DN_T + (size_t)DM * DFF * 2;
constexpr size_t WS_WEND = W_SBLK + (size_t)8 * 256 * 256 * 2;
constexpr size_t WS_H = 172 * MiB;
constexpr size_t WS_MEMN = WS_H + (size_t)T * DM * 2;
constexpr size_t WS_KV = WS_MEMN + (size_t)MEMROWS * DM * 2;
constexpr size_t WS_QKT = WS_KV + (size_t)MEMROWS * 2 * DM * 2;
constexpr size_t WS_VWT = WS_QKT + (size_t)NB * 1024 * DM * 2;
constexpr size_t WS_P = WS_VWT + (size_t)NB * 1024 * DM * 2;
constexpr size_t WS_BIG = WS_P + (size_t)T * 1024 * 2;
constexpr size_t WS_END = WS_BIG + (size_t)T * NIN * 2;
static_assert(WS_WEND <= WS_H, "weights fit below H");
constexpr int CW_BAR = 4096;

constexpr int RING_OFF = 0, RING_BYTES = 131072;
constexpr int XCH_OFF = 131072;
constexpr int MISC_OFF = 139264;
constexpr int LDS_BYTES = 147456;
static_assert(attn::SHM_ATTN <= MISC_OFF, "attention LDS fits");

#define GAS __attribute__((address_space(1)))
#define LAS __attribute__((address_space(3)))
typedef unsigned short bf16;
typedef unsigned v4u __attribute__((ext_vector_type(4)));
typedef float f32x4 __attribute__((ext_vector_type(4)));
typedef float f32x2 __attribute__((ext_vector_type(2)));
typedef GAS unsigned gu32;
#define RLX_AGENT __ATOMIC_RELAXED, __HIP_MEMORY_SCOPE_AGENT
#define LDS_WAIT() asm volatile("s_waitcnt lgkmcnt(0)" ::: "memory")
#define VM_WAIT() asm volatile("s_waitcnt vmcnt(0)" ::: "memory")
__device__ __forceinline__ unsigned f2bf(float f) { unsigned u = __builtin_bit_cast(unsigned, f); return (u + 0x7fffu + ((u >> 16) & 1u)) >> 16; }
__device__ __forceinline__ unsigned pk2(float lo, float hi) { return f2bf(lo) | (f2bf(hi) << 16); }
__device__ __forceinline__ float blo(unsigned w) { return __uint_as_float(w << 16); }
__device__ __forceinline__ float bhi(unsigned w) { return __uint_as_float(w & 0xffff0000u); }

#define XB_TMO      128
#define XB_XCNT(j)  (256  + 64 * (j))
#define XB_XSUB(j)  (1280 + 64 * (j))
#define XB_XGEN(j)  (2304 + 64 * (j))
#define XB_TOP      3328
#define XB_TOPGEN   3392
#define XCD_BAR_WORDS 3456
#define XB_SPIN_CAP (1u << 18)
__device__ __forceinline__ unsigned xb_ld(unsigned* p)              { return __hip_atomic_load(p, __ATOMIC_RELAXED, __HIP_MEMORY_SCOPE_AGENT); }
__device__ __forceinline__ unsigned xb_add(unsigned* p, unsigned v) { return __hip_atomic_fetch_add(p, v, __ATOMIC_RELAXED, __HIP_MEMORY_SCOPE_AGENT); }
__device__ __forceinline__ unsigned xb_xcc_id() { return (unsigned)__builtin_amdgcn_s_getreg((3 << 11) | 20) & 0xFu; }
#define XB_SPIN(cond, bar) do { unsigned _sp = 0; while (cond) { __builtin_amdgcn_s_sleep(1); \
    if ((++_sp & 255u) == 0u) { if (xb_ld(&(bar)[XB_TMO])) break; if (_sp > XB_SPIN_CAP) { atomicAdd(&(bar)[XB_TMO], 1u); break; } } } } while (0)
struct XcdBarrier { unsigned* bar; unsigned x; volatile LAS unsigned* st; };
__device__ __forceinline__ XcdBarrier xcd_barrier_post(unsigned* bar, volatile LAS unsigned* st) {
    XcdBarrier b; b.bar = bar; b.x = xb_xcc_id(); b.st = st;
    if (threadIdx.x == 0) (void)xb_add(&bar[XB_XCNT(b.x)], 1u);
    return b;
}
__device__ __forceinline__ void xcd_barrier_complete(unsigned* bar, unsigned x, unsigned& nloc, unsigned& nx) {
    const unsigned G = gridDim.x * gridDim.y * gridDim.z;
    unsigned sum, cnt, mine, sp = 0u;
    for (;;) {
        sum = 0u; cnt = 0u; mine = 0u;
#pragma unroll
        for (unsigned j = 0; j < 16; ++j) { const unsigned c = xb_ld(&bar[XB_XCNT(j)]); sum += c; cnt += (c > 0u) ? 1u : 0u; mine = (j == x) ? c : mine; }
        if (sum == G) break;
        __builtin_amdgcn_s_sleep(1);
        if ((++sp & 255u) == 0u) { if (xb_ld(&bar[XB_TMO])) break; if (sp > XB_SPIN_CAP) { atomicAdd(&bar[XB_TMO], 1u); break; } }
    }
    nloc = mine > 0u ? mine : 1u; nx = cnt > 0u ? cnt : 1u;
}
__device__ __forceinline__ void xcd_barrier(const XcdBarrier& b, const int wave) {
    asm volatile("s_waitcnt vmcnt(0)" ::: "memory");
    __syncthreads();
    if (wave == 0 && pg8::lane_id_opq() == 0) {
        unsigned* bar = b.bar;
        __builtin_amdgcn_s_waitcnt(0);
        unsigned nloc = b.st[0], nx = b.st[1];
        if (nloc == 0u) { xcd_barrier_complete(bar, b.x, nloc, nx); b.st[0] = nloc; b.st[1] = nx; }
        const unsigned old = xb_add(&bar[XB_XSUB(b.x)], 1u);
        const unsigned gen = old / nloc;
        if (old + 1u == (gen + 1u) * nloc) {
            __builtin_amdgcn_fence(__ATOMIC_RELEASE, "agent");
            asm volatile("s_waitcnt vmcnt(0)" ::: "memory");
            const unsigned og = xb_add(&bar[XB_TOP], 1u);
            const unsigned tg = og / nx;
            if (og + 1u == (tg + 1u) * nx) xb_add(&bar[XB_TOPGEN], 1u);
            else XB_SPIN(xb_ld(&bar[XB_TOPGEN]) == tg, bar);
            __builtin_amdgcn_fence(__ATOMIC_ACQUIRE, "agent");
            xb_add(&bar[XB_XGEN(b.x)], 1u);
            asm volatile("s_waitcnt vmcnt(0)" ::: "memory");
        } else {
            XB_SPIN(xb_ld(&bar[XB_XGEN(b.x)]) == gen, bar);
            __builtin_amdgcn_fence(__ATOMIC_ACQUIRE, "agent");
            asm volatile("s_waitcnt vmcnt(0)" ::: "memory");
        }
    }
    __syncthreads();
}

__device__ __forceinline__ int opq(int v) { asm volatile("" : "+v"(v)); return v; }
__device__ __forceinline__ float wave_sum(float v, int lane) {
#pragma unroll
    for (int o = 1; o < 64; o <<= 1) v += pg8::shx(v, o, lane);
    return v;
}
__device__ __forceinline__ void transpose_item(const float* W, int N, bf16* WT, int ldt, int k0, int n0, long drow0, LAS float* scr, int lane, const float* gain = nullptr) {
    float wv[32];
#pragma unroll
    for (int i = 0; i < 32; ++i) { const int kk = 2 * i + (lane >> 5); wv[i] = __builtin_nontemporal_load(&W[(size_t)(k0 + kk) * N + n0 + (lane & 31)]); }
#pragma unroll
    for (int i = 0; i < 32; ++i) { const int kk = 2 * i + (lane >> 5); float w = wv[i]; if (gain) w *= gain[k0 + kk]; scr[kk * 33 + (lane & 31)] = w; }
    LDS_WAIT(); asm volatile("" ::: "memory");
    const int c = lane & 7;
#pragma unroll
    for (int j = 0; j < 4; ++j) { const int n = (lane >> 3) + 8 * j; const LAS float* s = scr + (8 * c) * 33 + n;
        v4u o; o.x = pk2(s[0 * 33], s[1 * 33]); o.y = pk2(s[2 * 33], s[3 * 33]); o.z = pk2(s[4 * 33], s[5 * 33]); o.w = pk2(s[6 * 33], s[7 * 33]);
        *(GAS v4u*)(WT + (size_t)(drow0 + n) * ldt + k0 + 8 * c) = o; }
    LDS_WAIT(); asm volatile("" ::: "memory");
}
__device__ __forceinline__ void rms_row_to_bf16(const float* xrow, const float* gain, bf16* orow, float* xcopy, int lane) {
    const GAS f32x4* xr = (const GAS f32x4*)xrow + lane;
    f32x4 v[8]; float s = 0.f;
#pragma unroll
    for (int j = 0; j < 8; ++j) { v[j] = xr[64 * j]; s += (v[j].x * v[j].x + v[j].y * v[j].y) + (v[j].z * v[j].z + v[j].w * v[j].w); }
    if (xcopy) { GAS f32x4* xc = (GAS f32x4*)xcopy + lane;
#pragma unroll
        for (int j = 0; j < 8; ++j) xc[64 * j] = v[j]; }
    const float rs = 1.0f / sqrtf(wave_sum(s, lane) * (1.f / DM) + EPS);
    const GAS f32x4* gr = (const GAS f32x4*)gain + lane;
    GAS unsigned long long* o8 = (GAS unsigned long long*)orow + lane;
#pragma unroll
    for (int j = 0; j < 8; ++j) { const f32x4 g = gr[64 * j];
        o8[64 * j] = (unsigned long long)pk2(v[j].x * rs * g.x, v[j].y * rs * g.y) | ((unsigned long long)pk2(v[j].z * rs * g.z, v[j].w * rs * g.w) << 32); }
}

__device__ __forceinline__ void x_row_init2(const float* xrow, bf16* orow, float* st, float* rsf, int lane) {
    f32x4 v[2][8];
#pragma unroll
    for (int r = 0; r < 2; ++r)
#pragma unroll
        for (int j = 0; j < 8; ++j) v[r][j] = ((const GAS f32x4*)(xrow + (size_t)r * DM) + lane)[64 * j];
#pragma unroll
    for (int r = 0; r < 2; ++r) {
        GAS unsigned long long* o8 = (GAS unsigned long long*)(orow + (size_t)r * DM) + lane;
        float s = 0.f;
#pragma unroll
        for (int j = 0; j < 8; ++j) { const f32x4 w = v[r][j]; s += (w.x * w.x + w.y * w.y) + (w.z * w.z + w.w * w.w);
            o8[64 * j] = (unsigned long long)pk2(w.x, w.y) | ((unsigned long long)pk2(w.z, w.w) << 32); }
        s = wave_sum(s, lane);
        if (lane < 8) st[r * 8 + lane] = lane == 0 ? s : 0.f;
        if (lane == 0) rsf[r] = 1.0f / sqrtf(s * (1.f / DM) + EPS);
    }
}

struct Args { const float* in[26]; float* out; unsigned char* ws; };
static_assert(sizeof(Args) == 28 * 8, "no padding in Args");

__global__ void __launch_bounds__(512, 2) fwd_kernel(Args args) {
    extern __shared__ __attribute__((aligned(16))) unsigned char lds[];
    LAS unsigned char* L = (LAS unsigned char*)lds;
    volatile LAS unsigned* MISC = (volatile LAS unsigned*)(L + MISC_OFF);
    const int tid = threadIdx.x, wave = __builtin_amdgcn_readfirstlane(tid >> 6);
#define lane0 (pg8::lane_id_opq())
    const int G = gridDim.x, bx = blockIdx.x;
    const int vcu = (G % 8 == 0) ? (bx % 8) * (G / 8) + bx / 8 : bx;
    const int gw = vcu * 8 + wave, NGW = G * 8;
    for (int u = tid; u < 64; u += 512) ((LAS unsigned*)(L + MISC_OFF))[u] = 0u;
    __syncthreads();
    XcdBarrier bar = xcd_barrier_post((unsigned*)(args.ws + WS_CTL) + CW_BAR, MISC + 8);
#define GRID_BAR() xcd_barrier(bar, wave)
    LAS unsigned char* const RING = L + RING_OFF;
    LAS unsigned char* const XCH = L + XCH_OFF;
typedef const Args __attribute__((address_space(4))) CArgs;
constexpr int I_IN = (DM / 64) * (NIN / 32), I_SQ = (DM / 64) * (DM / 32), I_KV = (DM / 64) * (2 * DM / 32), I_UP = (DM / 64) * (2 * DFF / 32), I_DN = (DFF / 64) * (DM / 32);
constexpr int NITEMS = I_IN + 4 * I_SQ + I_KV + I_UP + I_DN, I_EARLY7 = I_IN, I_EARLYU = I_IN + 4 * I_SQ + I_KV;
#define CONV_ITEMS(LL, IT_LO, IT_HI, W0, NW) do { \
    const float* w_in = ka->in[5] + (size_t)(LL) * DM * NIN; const float* w_ao = ka->in[8] + (size_t)(LL) * DM * DM; const float* w_so = ka->in[13] + (size_t)(LL) * DM * DM; \
    const float* w_out = ka->in[14] + (size_t)(LL) * DM * DM; const float* w_xkv = ka->in[18] + (size_t)(LL) * DM * 2 * DM; const float* w_xo = ka->in[19] + (size_t)(LL) * DM * DM; \
    const float* w_up = ka->in[21] + (size_t)(LL) * DM * 2 * DFF; const float* w_dn = ka->in[24] + (size_t)(LL) * DFF * DM; const float* gmix = ka->in[4] + (size_t)(LL) * DM; const float* gffn = ka->in[20] + (size_t)(LL) * DM; \
    for (int it = (IT_LO) + (W0); it < (IT_HI); it += (NW)) { \
                int r = it; \
                if (r < I_IN) { const int nb = NIN / 32; const int n0 = 32 * (r % nb); long d0 = n0; \
                    if (n0 >= C_GA) { const int iss = n0 >= C_GS, ch = n0 - (iss ? C_GS : C_GA); d0 = C_GA + (long)(ch / 128) * 256 + iss * 128 + (ch % 128); } \
                    transpose_item(w_in, NIN, (bf16*)(ws + W_IN_T), DM, 64 * (r / nb), n0, d0, scr, lane, gmix); continue; } r -= I_IN; \
                if (r < I_SQ) { const int nb = DM / 32; transpose_item(w_ao, DM, (bf16*)(ws + W_AO_T), DM, 64 * (r / nb), 32 * (r % nb), 32 * (r % nb), scr, lane); continue; } r -= I_SQ; \
                if (r < I_SQ) { const int nb = DM / 32; transpose_item(w_so, DM, (bf16*)(ws + W_SO_T), DM, 64 * (r / nb), 32 * (r % nb), 32 * (r % nb), scr, lane); continue; } r -= I_SQ; \
                if (r < I_SQ) { const int nb = DM / 32; transpose_item(w_out, DM, (bf16*)(ws + W_OUT_T), DM, 64 * (r / nb), 32 * (r % nb), 32 * (r % nb), scr, lane); continue; } r -= I_SQ; \
                if (r < I_SQ) { const int nb = DM / 32; transpose_item(w_xo, DM, (bf16*)(ws + W_XO_T), DM, 64 * (r / nb), 32 * (r % nb), 32 * (r % nb), scr, lane); continue; } r -= I_SQ; \
                if (r < I_KV) { const int nb = 2 * DM / 32; transpose_item(w_xkv, 2 * DM, (bf16*)(ws + W_XKV_T), DM, 64 * (r / nb), 32 * (r % nb), 32 * (r % nb), scr, lane); continue; } r -= I_KV; \
                if (r < I_UP) { const int nb = 2 * DFF / 32; const int n0 = 32 * (r % nb); const int isb = n0 >= DFF, ch = n0 - isb * DFF; \
                    transpose_item(w_up, 2 * DFF, (bf16*)(ws + W_UP_T), DM, 64 * (r / nb), n0, (long)(ch / 128) * 256 + isb * 128 + (ch % 128), scr, lane, gffn); continue; } r -= I_UP; \
                { const int nb = DM / 32; transpose_item(w_dn, DM, (bf16*)(ws + W_DN_T), DFF, 64 * (r / nb), 32 * (r % nb), 32 * (r % nb), scr, lane); } \
            } \
    } while (0)
#define PHASE_ENV \
    CArgs* ka = (CArgs*)__builtin_amdgcn_kernarg_segment_ptr(); asm volatile("" : "+s"(ka)); \
    int G_o = (int)gridDim.x; asm volatile("" : "+s"(G_o)); const int G = G_o, NGW = G_o * 8; (void)G; (void)NGW; \
    unsigned char* const ws = ka->ws; float* const X = ka->out; \
    bf16* const Hb = (bf16*)(ws + WS_H); bf16* const MEMN = (bf16*)(ws + WS_MEMN); bf16* const KV = (bf16*)(ws + WS_KV); bf16* const QKT = (bf16*)(ws + WS_QKT); \
    bf16* const VWT = (bf16*)(ws + WS_VWT); bf16* const Pb = (bf16*)(ws + WS_P); bf16* const BIG = (bf16*)(ws + WS_BIG); f32x2* const ROPE = (f32x2*)(ws + WS_ROPE); \
    float* const STATS = (float*)(ws + WS_STATS); float* const RSF0 = (float*)(ws + WS_STATS + 3 * MiB / 2); float* const RSF2 = RSF0 + T; bf16* const VLT = (bf16*)ka->out; float* const LNST = (float*)((char*)ka->out + (size_t)200 * MiB);   \
    (void)X; (void)Hb; (void)MEMN; (void)KV; (void)QKT; (void)VWT; (void)Pb; (void)BIG; (void)ROPE; (void)STATS; (void)RSF0; (void)RSF2; (void)VLT; (void)LNST

    for (int l = 0; l < DEPTH; ++l) {
#if PH(0)
        { PHASE_ENV;
        {
            const int lane = opq(lane0);
            LAS float* scr = (LAS float*)(RING + wave * 16384);
            const float* w_in = ka->in[5] + (size_t)l * DM * NIN;
            const float* w_ao = ka->in[8] + (size_t)l * DM * DM;
            const float* w_so = ka->in[13] + (size_t)l * DM * DM;
            const float* w_out = ka->in[14] + (size_t)l * DM * DM;
            const float* w_xq = ka->in[17] + (size_t)l * DM * DM;
            const float* w_xkv = ka->in[18] + (size_t)l * DM * 2 * DM;
            const float* w_xo = ka->in[19] + (size_t)l * DM * DM;
            const float* w_up = ka->in[21] + (size_t)l * DM * 2 * DFF;
            const float* w_dn = ka->in[24] + (size_t)l * DFF * DM;
            const float* gmix = ka->in[4] + (size_t)l * DM; const float* gffn = ka->in[20] + (size_t)l * DM; const float* gxn = ka->in[15] + (size_t)l * DM;
            { const int b7 = (NB * 8 * 4) % G, bu = ((T / 256) * (2 * DFF / 256)) % G;
              const int lo = l == 0 ? 0 : (bu > 0 ? I_EARLYU : (b7 > 0 ? I_EARLY7 : 0));
              CONV_ITEMS(l, lo, NITEMS, gw, NGW); }
            { const size_t n8 = (size_t)DM * DM / 8; bf16* dst = (bf16*)(ws + W_XQ_B);
              for (size_t i = (size_t)gw * 64 + lane; i < n8; i += (size_t)NGW * 64) { const float gd = gxn[i >> 8]; const f32x4 a = *(const f32x4*)(w_xq + i * 8) * gd, b = *(const f32x4*)(w_xq + i * 8 + 4) * gd;
                  v4u o; o.x = pk2(a.x, a.y); o.y = pk2(a.z, a.w); o.z = pk2(b.x, b.y); o.w = pk2(b.z, b.w); *(v4u*)(dst + i * 8) = o; } }
            { const float* wsp = ka->in[11] + (size_t)l * 8 * 128 * 128; bf16* dst = (bf16*)(ws + W_SBLK); const size_t n8 = (size_t)8 * 256 * 256 / 8;
              for (size_t i = (size_t)gw * 64 + lane; i < n8; i += (size_t)NGW * 64) { const int e = (int)(i * 8), g = e >> 16, pp = (e >> 8) & 255, qq = e & 255;
                  v4u o = (v4u){0u, 0u, 0u, 0u};
                  if ((pp >> 7) == (qq >> 7)) { const float* s = wsp + ((size_t)g * 128 + (pp & 127)) * 128 + (qq & 127); const f32x4 a = *(const f32x4*)s, b = *(const f32x4*)(s + 4);
                      o.x = pk2(a.x, a.y); o.y = pk2(a.z, a.w); o.z = pk2(b.x, b.y); o.w = pk2(b.z, b.w); }
                  *(v4u*)(dst + i * 8) = o; } }
            if (l == 0) for (int m = gw * 2; m < T; m += NGW * 2) {
                const float* src = m < 4 * SEQ ? ka->in[0] + (size_t)m * DM : ka->in[1] + (size_t)(m - 4 * SEQ) * DM;
                x_row_init2(src, Hb + (size_t)m * DM, STATS + (size_t)m * 8, RSF0 + m, lane);
            }
            else for (int i = gw * 64 + lane; i < T; i += NGW * 64) {
                const f32x4 a = *(const f32x4*)(STATS + (size_t)i * 8), b = *(const f32x4*)(STATS + (size_t)i * 8 + 4);
                RSF0[i] = 1.0f / sqrtf(((a[0] + a[1]) + (a[2] + a[3]) + (b[0] + b[1]) + (b[2] + b[3])) * (1.f / DM) + EPS); }
            const float* gmem = ka->in[16] + (size_t)l * DM;
            for (int m = gw; m < MEMROWS; m += NGW) {
                const float* src = m < 4 * NMEM ? ka->in[2] + (size_t)m * DM : ka->in[3] + (size_t)(m - 4 * NMEM) * DM;
                rms_row_to_bf16(src, gmem, MEMN + (size_t)m * DM, nullptr, lane);
            }
            if (l == 0 && bx == 0 && wave == 0 && lane < 32) {
                double inv = 1.0; for (int j = 0; j < lane; ++j) inv *= 0.74989420933245582;
                const double t2 = inv * inv; double c1 = 1.0, s1 = inv, tc = 1.0, tsn = inv;
                for (int k = 1; k < 14; ++k) { tc *= -t2 / (double)((2 * k - 1) * (2 * k)); c1 += tc; tsn *= -t2 / (double)((2 * k) * (2 * k + 1)); s1 += tsn; }
                double c = 1.0, s = 0.0;
                for (int pos = 0; pos < 64; ++pos) { ROPE[pos * 32 + lane] = (f32x2){(float)c, (float)s}; const double cn = c * c1 - s * s1, sn = s * c1 + c * s1; c = cn; s = sn; }
            }
        }
        }
#endif
        GRID_BAR();
#if PH(1)
        { PHASE_ENV;
        {
            pg8::Gemm g{MEMN, (const bf16*)(ws + W_XKV_T), DM, DM, DM, 0, 0, 0, 0}; pg8::Sched S; S.init(1, 1, MEMROWS / 256, 2 * DM / 256, G, G - 1 - bx);
            pg8::EpiBf16<0> E{KV, 2 * DM, 0, 0, nullptr, nullptr};
            pg8::gemm_phase(RING, XCH, g, S, E, wave);
        }
        {
            pg8::Gemm g{Hb, (const bf16*)(ws + W_IN_T), DM, DM, DM, 0, 0, 0, 0}; pg8::Sched S; S.init(1, 1, T / 256, 28, G, bx, 1);
            pg8::EpiBf16<1, true> E{BIG, NIN, 0, 0, RSF0, LNST};
            pg8::gemm_phase(RING, XCH, g, S, E, wave);
        }
        }
#endif
        GRID_BAR();
#if PH(2)
        { PHASE_ENV;
        {
            const int lane = opq(lane0);
            const float* qg = ka->in[6] + (size_t)l * 128; const float* kg = ka->in[7] + (size_t)l * 128;
            const int hh = lane >> 4, li = lane & 15;
            const int a_ = li >> 3, p_ = (li >> 2) & 1, j0 = (li & 3) * 8;
            for (int row0 = gw * 4; row0 < T; row0 += NGW * 4) {
                bf16* p0 = BIG + (size_t)row0 * NIN + C_K + hh * 128 + li * 8;
                v4u wq[4];
#pragma unroll
                for (int rr = 0; rr < 4; ++rr) wq[rr] = *(const v4u*)(p0 + (size_t)rr * NIN);
#pragma unroll
                for (int rr = 0; rr < 4; ++rr) {
                    const int t = (row0 + rr) & (SEQ - 1), pos = a_ ? (t & 63) : (t >> 6);
                    const v4u w = wq[rr];
                    float y[8] = {blo(w.x), bhi(w.x), blo(w.y), bhi(w.y), blo(w.z), bhi(w.z), blo(w.w), bhi(w.w)};
                    float s = 0.f;
#pragma unroll
                    for (int e = 0; e < 8; ++e) s += y[e] * y[e];
                    s += pg8::shx(s, 1, lane); s += pg8::shx(s, 2, lane); s += pg8::shx(s, 4, lane); s += pg8::shx(s, 8, lane);
                    const float rs = 1.0f / sqrtf(s * (1.f / 128.f) + EPS);
                    const float* gv = kg + li * 8;
                    float o[8];
#pragma unroll
                    for (int e = 0; e < 8; ++e) y[e] = y[e] * rs * gv[e];
#pragma unroll
                    for (int e = 0; e < 8; ++e) { const float yp = pg8::shx(y[e], 4, lane); const f32x2 cs = ROPE[pos * 32 + j0 + e]; o[e] = y[e] * cs.x + (p_ ? yp : -yp) * cs.y; }
                    v4u ow; ow.x = pk2(o[0], o[1]); ow.y = pk2(o[2], o[3]); ow.z = pk2(o[4], o[5]); ow.w = pk2(o[6], o[7]);
                    *(v4u*)(p0 + (size_t)rr * NIN) = ow;
                }
            }
            const float* lng = ka->in[9] + (size_t)l * DM; const float* lnb = ka->in[10] + (size_t)l * DM;
            for (int it = vcu; it < (T / 64) * 2; it += G) {
                const int blk = it >> 1, half = it & 1, t0 = blk * 64 + wave * 8;
                float my_mu = 0.f, my_rs = 0.f;
                {
                    const int r = lane & 7;
                    const float* q = LNST + (size_t)(t0 + r) * 16;
                    const f32x4 a = *(const f32x4*)q, b = *(const f32x4*)(q + 4), c = *(const f32x4*)(q + 8), d = *(const f32x4*)(q + 12);
                    const float s = ((a[0] + a[2]) + (b[0] + b[2])) + ((c[0] + c[2]) + (d[0] + d[2])), s2 = ((a[1] + a[3]) + (b[1] + b[3])) + ((c[1] + c[3]) + (d[1] + d[3]));
                    const float mu = s * (1.f / DM); float var = s2 * (1.f / DM) - mu * mu; var = var < 0.f ? 0.f : var;
                    my_mu = mu; my_rs = 1.0f / sqrtf(var + EPS);
                }
                const int z1 = t0 >> 8, tt = t0 & 255;
#pragma unroll
                for (int q = 0; q < 2; ++q) {
                    const int c0 = half * 1024 + q * 512 + lane * 8;
                    float gch[8], bch[8];
#pragma unroll
                    for (int e = 0; e < 8; ++e) { gch[e] = lng[c0 + e]; bch[e] = lnb[c0 + e]; }
                    unsigned ow[8][4];
                    v4u wr8[8];
#pragma unroll
                    for (int r = 0; r < 8; ++r) wr8[r] = *(const v4u*)(BIG + (size_t)(t0 + r) * NIN + C_VS + c0);
#pragma unroll
                    for (int rp2 = 0; rp2 < 4; ++rp2) {
                        const v4u wa = wr8[2 * rp2], wb = wr8[2 * rp2 + 1];
                        const float mua = __int_as_float(__builtin_amdgcn_readlane(__float_as_int(my_mu), 2 * rp2)), rsa = __int_as_float(__builtin_amdgcn_readlane(__float_as_int(my_rs), 2 * rp2)), mub = __int_as_float(__builtin_amdgcn_readlane(__float_as_int(my_mu), 2 * rp2 + 1)), rsb = __int_as_float(__builtin_amdgcn_readlane(__float_as_int(my_rs), 2 * rp2 + 1));
                        const float fa[8] = {blo(wa.x), bhi(wa.x), blo(wa.y), bhi(wa.y), blo(wa.z), bhi(wa.z), blo(wa.w), bhi(wa.w)};
                        const float fb[8] = {blo(wb.x), bhi(wb.x), blo(wb.y), bhi(wb.y), blo(wb.z), bhi(wb.z), blo(wb.w), bhi(wb.w)};
#pragma unroll
                        for (int e = 0; e < 8; ++e) ow[e][rp2] = pg8::cvt_pk_bf16((fa[e] - mua) * rsa * gch[e] + bch[e], (fb[e] - mub) * rsb * gch[e] + bch[e]);
                    }
#pragma unroll
                    for (int e = 0; e < 8; ++e) { v4u o; o.x = ow[e][0]; o.y = ow[e][1]; o.z = ow[e][2]; o.w = ow[e][3];
                        *(LAS v4u*)(RING + (q * 512 + lane * 8 + e) * 128 + ((wave ^ (lane & 7)) << 4)) = o; }
                }
                __syncthreads();
                {
                    const int p8 = lane & 7, chl = lane >> 3;
                    bf16* dst = VLT + ((size_t)(blk >> 2) * DM + half * 1024 + wave * 128 + chl) * 256 + (blk & 3) * 64 + p8 * 8;
                    v4u rr[16];
#pragma unroll
                    for (int i = 0; i < 16; ++i) { const int ch = wave * 128 + i * 8 + chl; rr[i] = *(const LAS v4u*)(RING + ch * 128 + ((p8 ^ ((ch >> 3) & 7)) << 4)); }
#pragma unroll
                    for (int i = 0; i < 16; ++i) *(v4u*)(dst + (size_t)i * 8 * 256) = rr[i];
                }
                __syncthreads();
            }
        }
        {
            pg8::Gemm g{KV, (const bf16*)(ws + W_XQ_B), 2 * DM, DM, 512, (long)NMEM * 2 * DM, 512, 0, 512}; pg8::Sched S; S.init(NB * 4, 4, 1, 8, G, bx);
            pg8::EpiBf16<0> E{QKT, DM, (long)1024 * DM, (long)256 * DM, nullptr, nullptr};
            pg8::gemm_phase(RING, XCH, g, S, E, wave);
        }
        {
            pg8::Gemm g{(const bf16*)(ws + W_XO_T), KV + DM, DM, 2 * DM, 512, 0, 512, (long)NMEM * 2 * DM, 512}; pg8::Sched S; S.init(NB * 4, 4, 8, 1, G, G - 1 - bx);
            pg8::EpiBf16<0> E{VWT, 1024, (long)DM * 1024, 256, nullptr, nullptr};
            pg8::gemm_phase(RING, XCH, g, S, E, wave);
        }
        }
#endif
        GRID_BAR();
#if PH(3)
        { PHASE_ENV;
        {
            for (int i = 0; ; ++i) {
                const int U = i * G + vcu; if (U >= NB * 128) break;
                const int qb = U & 7, hq = ((U >> 5) & 3) * 4 + ((U >> 3) & 3), kvh = (U >> 5) & 3, b = U >> 7;
                const bf16* Qb = BIG + (size_t)(b * SEQ + qb * 256) * NIN + C_Q + hq * 128;
                const bf16* Kh = BIG + (size_t)(b * SEQ) * NIN + C_K + kvh * 128;
                const bf16* Vh = BIG + (size_t)(b * SEQ) * NIN + C_V + kvh * 128;
                attn::attn_dense_body(Qb, Kh, Vh, (bf16*)Qb, SEQ, (char*)lds, wave, ka->in[6] + (size_t)l * 128, (const float*)ROPE, qb * 256);
            }
        }
        {
            pg8::Gemm g{(const bf16*)(ws + W_SBLK), VLT, 256, 256, 256, 0, (long)256 * 256, (long)DM * 256, (long)256 * 256}; pg8::Sched S; S.init(T / 256 * 8, 8, 1, 1, G, bx);
            pg8::EpiSpatial E{BIG + C_U, NIN, ka->in[12] + (size_t)l * 8 * 128};
            pg8::gemm_phase(RING, XCH, g, S, E, wave);
        }
        {
            pg8::Gemm g{Hb, (const bf16*)(ws + W_IN_T) + (size_t)28 * 256 * DM, DM, DM, DM, 0, 0, 0, 0}; pg8::Sched S; S.init(1, 1, T / 256, 16, G, bx);
            pg8::EpiBf16<1, true> E{BIG, NIN, 0, 0, RSF0, LNST, 28};
            pg8::gemm_phase(RING, XCH, g, S, E, wave);
        }
        }
#endif
        GRID_BAR();
#if PH(4)
        { PHASE_ENV;
        {
            pg8::Gemm g{BIG + C_Q, (const bf16*)(ws + W_AO_T), NIN, DM, 2 * DM, 0, 0, 0, 0, (long)(C_U - C_Q - DM) * 2, (long)W_SO_T - (long)W_AO_T - (long)DM * 2, DM / 64};
            pg8::Sched S; S.init(1, 1, T / 256, DM / 256, G, bx, 1);
            pg8::EpiMixF E{BIG + C_GA, BIG + C_GS, BIG + C_VS, NIN};
            pg8::gemm_phase(RING, XCH, g, S, E, wave);
        }
        }
#endif
        GRID_BAR();
#if PH(5)
        { PHASE_ENV;
        {
            pg8::Gemm g{BIG + C_VS, (const bf16*)(ws + W_OUT_T), NIN, DM, DM, 0, 0, 0, 0}; pg8::Sched S; S.init(1, 1, T / 256, DM / 256, G, bx);
            pg8::EpiRes E{Hb, DM, 0, STATS, 0};
            pg8::gemm_phase(RING, XCH, g, S, E, wave);
        }
        }
#endif
        GRID_BAR();
#if PH(7)
        { PHASE_ENV;
        {
            pg8::Gemm g{Hb, QKT, DM, DM, DM, (long)SEQ * DM, 0, (long)1024 * DM, 0}; pg8::Sched S; S.init(NB, 1, 8, 4, G, bx, 1);
            pg8::EpiSoftmax E{Pb, 1024, (long)SEQ * 1024, 0.044194173824159216f * 1.4426950408889634f, STATS, SEQ};
            pg8::gemm_phase(RING, XCH, g, S, E, wave);
        }
        { const int b7 = (NB * 8 * 4) % G;
          if (l + 1 < DEPTH && b7 > 0 && bx >= b7) { const int lane = opq(lane0); LAS float* scr = (LAS float*)(RING + wave * 16384);
              CONV_ITEMS(l + 1, 0, I_EARLY7, (bx - b7) * 8 + wave, (G - b7) * 8); } }
        }
#endif
        GRID_BAR();
#if PH(8)
        { PHASE_ENV;
        {
            pg8::Gemm g{Pb, VWT, 1024, 1024, 1024, (long)SEQ * 1024, 0, (long)DM * 1024, 0}; pg8::Sched S; S.init(NB, 1, 8, 8, G, bx);
            pg8::EpiRes E{Hb, DM, (long)SEQ * DM, STATS, SEQ};
            pg8::gemm_phase(RING, XCH, g, S, E, wave);
        }
        }
#endif
        GRID_BAR();
#if PH(10)
        { PHASE_ENV; const int lane = opq(lane0);
          for (int i = gw * 64 + lane; i < T; i += NGW * 64) { const f32x4 a = *(const f32x4*)(STATS + (size_t)i * 8), b = *(const f32x4*)(STATS + (size_t)i * 8 + 4);
              RSF2[i] = 1.0f / sqrtf(((a[0] + a[1]) + (a[2] + a[3]) + (b[0] + b[1]) + (b[2] + b[3])) * (1.f / DM) + EPS); } }
        GRID_BAR();
#define FFN_ENV PHASE_ENV; bf16* const ACT = BIG + (size_t)T * DFF;   float* const EA = (float*)BIG;   float* const EB = EA + (size_t)(T / 256) * 4 * DFF;   (void)ACT; (void)EA; (void)EB
        { FFN_ENV;
            pg8::Gemm g{Hb, (const bf16*)(ws + W_UP_T), DM, DM, DM, 0, 0, 0, 0}; pg8::Sched S; S.init(1, 1, T / 256, 2 * DFF / 256, G, bx, 1);
            pg8::EpiUp E{ACT, DFF, RSF2, ka->in[22] + (size_t)l * 3 * DFF, ka->in[23] + (size_t)l * DFF, EA, EB};
            pg8::gemm_phase(RING, XCH, g, S, E, wave);
            { const int bu = ((T / 256) * (2 * DFF / 256)) % G, b7 = (NB * 8 * 4) % G;
              if (l + 1 < DEPTH && bu > 0 && bx >= bu) { const int lane = opq(lane0); LAS float* scr = (LAS float*)(RING + wave * 16384);
                  CONV_ITEMS(l + 1, b7 > 0 ? I_EARLY7 : 0, I_EARLYU, (bx - bu) * 8 + wave, (G - bu) * 8); } }
        }
        GRID_BAR();
        { FFN_ENV; const int lane = opq(lane0);
            const float* cw = ka->in[22] + (size_t)l * 3 * DFF; const float* cb = ka->in[23] + (size_t)l * DFF;
            constexpr int NC8 = DFF / 8, NIT = (T / 256) * 2 * NC8;
            for (int it = gw * 64 + lane; it < NIT; it += NGW * 64) {
                const int c8 = it % NC8, tw = it / NC8, pm = tw >> 1, bot = tw & 1, c0 = c8 * 8;
                const float* ac = EA + ((size_t)pm * 4 + (bot ? 3 : 0)) * DFF + c0;
                const float* ap = bot ? EA + ((size_t)pm * 4 + 2) * DFF + c0 : EA + ((size_t)(pm - 1) * 4 + 3) * DFF + c0;
                const float* an = bot ? EA + ((size_t)(pm + 1) * 4 + 0) * DFF + c0 : EA + ((size_t)pm * 4 + 1) * DFF + c0;
                const bool pz = !bot && (pm & 7) == 0, nz = bot && (pm & 7) == 7;
                const float* bp = EB + ((size_t)pm * 2 + bot) * DFF + c0;
                float o[8];
#pragma unroll
                for (int h = 0; h < 2; ++h) {
                    const f32x4 z = (f32x4){0.f, 0.f, 0.f, 0.f};
                    const f32x4 vc = *(const f32x4*)(ac + 4 * h), vp = pz ? z : *(const f32x4*)((pz ? ac : ap) + 4 * h), vn = nz ? z : *(const f32x4*)((nz ? ac : an) + 4 * h), vb = *(const f32x4*)(bp + 4 * h);
                    const f32x4 w0 = *(const f32x4*)(cw + c0 + 4 * h), w1 = *(const f32x4*)(cw + DFF + c0 + 4 * h), w2 = *(const f32x4*)(cw + 2 * DFF + c0 + 4 * h), bb = *(const f32x4*)(cb + c0 + 4 * h);
#pragma unroll
                    for (int e = 0; e < 4; ++e) o[4 * h + e] = pg8::gelu_t(bb[e] + w0[e] * vp[e] + w1[e] * vc[e] + w2[e] * vn[e]) * vb[e]; }
                v4u ow; ow.x = pk2(o[0], o[1]); ow.y = pk2(o[2], o[3]); ow.z = pk2(o[4], o[5]); ow.w = pk2(o[6], o[7]);
                *(v4u*)(ACT + (size_t)(pm * 256 + (bot ? 255 : 0)) * DFF + c0) = ow;
            }
        }
        GRID_BAR();
        { FFN_ENV;
            pg8::Gemm g{ACT, (const bf16*)(ws + W_DN_T), DFF, DFF, DFF, 0, 0, 0, 0}; pg8::Sched S; S.init(1, 1, T / 256, DM / 256, G, bx);
            pg8::EpiRes E{Hb, DM, 0, STATS, 0};
            pg8::gemm_phase(RING, XCH, g, S, E, wave);
        }
        GRID_BAR();
#endif
    }
    { PHASE_ENV;
        const int lane = opq(lane0);
        const float* gfin = ka->in[25];
        for (int m0 = T - 4 - gw * 4; m0 >= 0; m0 -= NGW * 4) {
            v4u wq[4][4];
#pragma unroll
            for (int r = 0; r < 4; ++r)
#pragma unroll
                for (int j = 0; j < 4; ++j) wq[r][j] = ((const v4u*)(Hb + (size_t)(m0 + r) * DM) + lane)[64 * j];
#pragma unroll
            for (int r = 0; r < 4; ++r) {
                float v[4][8]; float s = 0.f;
#pragma unroll
                for (int j = 0; j < 4; ++j) { const v4u w = wq[r][j]; v[j][0] = blo(w.x); v[j][1] = bhi(w.x); v[j][2] = blo(w.y); v[j][3] = bhi(w.y); v[j][4] = blo(w.z); v[j][5] = bhi(w.z); v[j][6] = blo(w.w); v[j][7] = bhi(w.w);
#pragma unroll
                    for (int e = 0; e < 8; ++e) s += v[j][e] * v[j][e]; }
                const float rs = 1.0f / sqrtf(wave_sum(s, lane) * (1.f / DM) + EPS);
#pragma unroll
                for (int j = 0; j < 4; ++j) { const float* gp = gfin + j * 512 + lane * 8; float* op = X + (size_t)(m0 + r) * DM + j * 512 + lane * 8;
                    const f32x4 g0 = *(const f32x4*)gp, g1 = *(const f32x4*)(gp + 4);
                    *(f32x4*)op = (f32x4){v[j][0] * rs * g0.x, v[j][1] * rs * g0.y, v[j][2] * rs * g0.z, v[j][3] * rs * g0.w};
                    *(f32x4*)(op + 4) = (f32x4){v[j][4] * rs * g1.x, v[j][5] * rs * g1.y, v[j][6] * rs * g1.z, v[j][7] * rs * g1.w}; }
            }
        }
    }
}

extern "C" void kernel_launch(void* const* d_in, const int* in_sizes, int n_in, void* d_out, int out_size, void* d_ws, size_t ws_size, hipStream_t stream) {
    static int grid = 0;
    if (grid == 0) {
        if (n_in != 26 || out_size != T * DM || ws_size < WS_END) { fprintf(stderr, "kernel_launch: shape/workspace mismatch: n_in %d out %d ws %zu (need %zu)\n", n_in, out_size, ws_size, (size_t)WS_END); grid = -1; return; }
        int dev = 0, cus = 0, per_cu = 0;
        if (hipGetDevice(&dev) != hipSuccess || hipDeviceGetAttribute(&cus, hipDeviceAttributeMultiprocessorCount, dev) != hipSuccess) { grid = -1; return; }
        if (hipFuncSetAttribute((const void*)fwd_kernel, hipFuncAttributeMaxDynamicSharedMemorySize, LDS_BYTES) != hipSuccess) { fprintf(stderr, "kernel_launch: hipFuncSetAttribute failed\n"); grid = -1; return; }
        if (hipOccupancyMaxActiveBlocksPerMultiprocessor(&per_cu, (const void*)fwd_kernel, 512, LDS_BYTES) != hipSuccess || per_cu < 1) { fprintf(stderr, "kernel_launch: occupancy query says %d\n", per_cu); }
        (void)hipGetLastError();
        grid = cus;
    }
    if (grid < 0) return;
    (void)hipMemsetAsync((char*)d_ws + WS_CTL, 0, CTL_ZERO_BYTES, stream);
    Args a{};
    for (int i = 0; i < 26; ++i) a.in[i] = (const float*)d_in[i];
    a.out = (float*)d_out; a.ws = (unsigned char*)d_ws;
    hipLaunchKernelGGL(fwd_kernel, dim3(grid), dim3(512), LDS_BYTES, stream, a);
    const hipError_t le = hipPeekAtLastError();
    if (le != hipSuccess) fprintf(stderr, "kernel_launch: launch failed: %s\n", hipGetErrorName(le));
}
```

```cpp
#include <hip/hip_runtime.h>
#include <hip/hip_bf16.h>
#include <cstdio>
#include <cstdint>

#ifndef ONLY
#define ONLY -1
#endif
#define PH(n) (ONLY < 0 || ONLY == (n))
constexpr int DM = 2048, NB = 20, SEQ = 2048, T = NB * SEQ, DEPTH = 4;
constexpr int NIN = 11264, DFF = 5632, HFF = DFF / 2  , NMEM = 256, MEMROWS = NB * NMEM;
constexpr int C_Q = 0, C_K = 2048, C_V = 2560, C_U = 3072, C_VS = 5120, C_GA = 7168, C_GS = 9216;
constexpr float EPS = 1e-6f;

namespace pg8 {
#define PG8_LAS __attribute__((address_space(3)))
typedef unsigned short bf16_t;
typedef short bf16x8 __attribute__((ext_vector_type(8)));
typedef float f32x4 __attribute__((ext_vector_type(4)));
typedef float f32x2 __attribute__((ext_vector_type(2)));
typedef unsigned u32x4 __attribute__((ext_vector_type(4)));
constexpr int BM = 256, BK = 64, HALF = 128, HTB = HALF * BK * 2, STAGE_BYTES = 8 * HTB, NXCD = 8, WGM = 4;

__host__ __device__ __forceinline__ int lds_byte(int r, int c) { const int st = (r >> 4) * 2 + (c >> 5), rr = r & 15, cc = c & 31, ob = rr * 64 + cc * 2; return st * 1024 + (ob ^ (((ob >> 9) & 1) << 5)); }
__host__ __device__ __forceinline__ void stage_rc(int b, int& R, int& C) { const int st = b / 1024, sb = b % 1024, swz = sb ^ (((sb >> 9) & 1) << 5); R = (st >> 1) * 16 + swz / 64; C = (st & 1) * 32 + (swz % 64) / 2; }
__host__ __device__ __forceinline__ int perm32(int rho) { const int n = rho >> 4, i = rho & 15; return 8 * (i >> 2) + 4 * n + (i & 3); }

struct Unit { int z1, z2, pm, pn; };
struct Gemm { const bf16_t* A; const bf16_t* Bt; int lda, ldb, K; long aS1, aS2, bS1, bS2; long jA = 0, jB = 0; int tj = 0; };
struct Sched {
    int Z2, nM, nN, nwg, G, c, rev;
    __device__ __forceinline__ void init(int Z, int Z2_, int nM_, int nN_, int G_, int c_, int rev_ = 0) { Z2 = Z2_; nM = nM_; nN = nN_; nwg = Z * nM_ * nN_; G = G_; c = c_; rev = rev_; }
    __device__ __forceinline__ bool next(int i, Unit& u) const {
        int nM = this->nM, nN = this->nN, Z2 = this->Z2; asm volatile("" : "+s"(nM), "+s"(nN), "+s"(Z2));
        const long L = (long)i * G + c; if (L >= nwg) return false;
        int wgid = (int)L; { const int q = nwg / NXCD, r = nwg % NXCD, xcd = wgid % NXCD, off = wgid / NXCD; wgid = (xcd < r ? xcd * (q + 1) : r * (q + 1) + (xcd - r) * q) + off; }
        if (rev) wgid = nwg - 1 - wgid;
        const int per = nM * nN, z = wgid / per, rem = wgid - z * per;
        const int nig = WGM * nN, gid = rem / nig, fm = gid * WGM, gsz = (nM - fm) < WGM ? (nM - fm) : WGM, ri = rem - gid * nig;
        u.pm = fm + (ri % gsz); u.pn = ri / gsz; u.z1 = z / Z2; u.z2 = z - u.z1 * Z2; return true;
    }
};
__device__ __forceinline__ const char* a_tile(const Gemm& g, const Unit& u) { return (const char*)(g.A + ((long)u.z1 * g.aS1 + (long)u.z2 * g.aS2 + (long)u.pm * BM * g.lda)); }
__device__ __forceinline__ const char* b_tile(const Gemm& g, const Unit& u) { return (const char*)(g.Bt + ((long)u.z1 * g.bS1 + (long)u.z2 * g.bS2 + (long)u.pn * BM * g.ldb)); }

__device__ __forceinline__ unsigned cvt_pk_bf16(float lo, float hi) { unsigned r; asm volatile("v_cvt_pk_bf16_f32 %0, %1, %2" : "=v"(r) : "v"(lo), "v"(hi)); return r; }
__device__ __forceinline__ float bf_lo(unsigned w) { return __uint_as_float(w << 16); }
__device__ __forceinline__ float bf_hi(unsigned w) { return __uint_as_float(w & 0xffff0000u); }
__device__ __forceinline__ float gelu_t(float x) { const float e = __builtin_amdgcn_exp2f(x * (-2.302208198f - 0.1029432397f * x * x)); return x * __builtin_amdgcn_rcpf(1.0f + e); }
__device__ __forceinline__ float sigm(float x) { return __builtin_amdgcn_rcpf(1.0f + __builtin_amdgcn_exp2f(-1.4426950409f * x)); }
__device__ __forceinline__ f32x2 gelu_t2(f32x2 x) { const f32x2 t = x * x, u = t * (-0.1029432397f) + (-2.302208198f), a = x * u;
    f32x2 e; e.x = __builtin_amdgcn_exp2f(a.x); e.y = __builtin_amdgcn_exp2f(a.y); const f32x2 d = e + 1.0f;
    f32x2 r; r.x = __builtin_amdgcn_rcpf(d.x); r.y = __builtin_amdgcn_rcpf(d.y); return x * r; }
__device__ __forceinline__ f32x2 sigm2(f32x2 x) { const f32x2 a = x * (-1.4426950409f);
    f32x2 e; e.x = __builtin_amdgcn_exp2f(a.x); e.y = __builtin_amdgcn_exp2f(a.y); const f32x2 d = e + 1.0f;
    f32x2 r; r.x = __builtin_amdgcn_rcpf(d.x); r.y = __builtin_amdgcn_rcpf(d.y); return r; }
#define ACT4(v, F) do { const f32x2 _lo = F((f32x2){v[0], v[1]}), _hi = F((f32x2){v[2], v[3]}); v = (f32x4){_lo.x, _lo.y, _hi.x, _hi.y}; } while (0)

__device__ __forceinline__ int lane_id_opq() { int l; asm volatile("v_mbcnt_lo_u32_b32 %0, -1, 0\n\tv_mbcnt_hi_u32_b32 %0, -1, %0" : "=v"(l)); return l; }
__device__ __forceinline__ float shx(float v, int mask, int lane) { return __int_as_float(__builtin_amdgcn_ds_bpermute((lane ^ mask) << 2, __float_as_int(v))); }
typedef f32x4 Acc[2][2][4][2];
#define EPI_ARGS Acc& acc, const Unit& u, int wr, int wc, int fr, int fq, PG8_LAS unsigned char* xl, const float (&pre)[8]

#define PACK8(w, v0, v1) do { w.x = cvt_pk_bf16(v0[0], v0[1]); w.y = cvt_pk_bf16(v0[2], v0[3]); w.z = cvt_pk_bf16(v1[0], v1[1]); w.w = cvt_pk_bf16(v1[2], v1[3]); } while (0)
#define MUL8(v0, v1, g) do { v0[0] *= bf_lo(g.x); v0[1] *= bf_hi(g.x); v0[2] *= bf_lo(g.y); v0[3] *= bf_hi(g.y); v1[0] *= bf_lo(g.z); v1[1] *= bf_hi(g.z); v1[2] *= bf_lo(g.w); v1[3] *= bf_hi(g.w); } while (0)
#define ADD8(v0, v1, g) do { v0[0] += bf_lo(g.x); v0[1] += bf_hi(g.x); v0[2] += bf_lo(g.y); v0[3] += bf_hi(g.y); v1[0] += bf_lo(g.z); v1[1] += bf_hi(g.z); v1[2] += bf_lo(g.w); v1[3] += bf_hi(g.w); } while (0)
#define ROW_RS8(rs, stats, row0) do { f32x4 _a[2][4], _b[2][4]; \
    _Pragma("unroll") for (int ai = 0; ai < 2; ++ai) _Pragma("unroll") for (int m = 0; m < 4; ++m) { const float* _p = (stats) + (size_t)((row0) + ai * HALF + m * 16) * 8; _a[ai][m] = *(const f32x4*)_p; _b[ai][m] = *(const f32x4*)(_p + 4); } \
    _Pragma("unroll") for (int ai = 0; ai < 2; ++ai) _Pragma("unroll") for (int m = 0; m < 4; ++m) \
        rs[ai][m] = 1.0f / sqrtf(((_a[ai][m][0] + _a[ai][m][1]) + (_a[ai][m][2] + _a[ai][m][3]) + (_b[ai][m][0] + _b[ai][m][1]) + (_b[ai][m][2] + _b[ai][m][3])) * (1.0f / 2048.0f) + 1e-6f); } while (0)
__device__ __forceinline__ void gate2(f32x2& a, f32x2& s, float k) { const f32x2 ta = a * k, ts = s * k;
    f32x2 ea, es; ea.x = __builtin_amdgcn_exp2f(ta.x); ea.y = __builtin_amdgcn_exp2f(ta.y); es.x = __builtin_amdgcn_exp2f(ts.x); es.y = __builtin_amdgcn_exp2f(ts.y);
    const f32x2 da = ea + 1.0f, ds = es + 1.0f;
    f32x2 ra, rs; ra.x = __builtin_amdgcn_rcpf(da.x); ra.y = __builtin_amdgcn_rcpf(da.y); rs.x = __builtin_amdgcn_rcpf(ds.x); rs.y = __builtin_amdgcn_rcpf(ds.y);
    a = ds * ra; s = rs; }
#define GATE4(a, s, k) do { f32x2 _al = {a[0], a[1]}, _ah = {a[2], a[3]}, _sl = {s[0], s[1]}, _sh = {s[2], s[3]}; gate2(_al, _sl, k); gate2(_ah, _sh, k); \
    a = (f32x4){_al.x, _al.y, _ah.x, _ah.y}; s = (f32x4){_sl.x, _sl.y, _sh.x, _sh.y}; } while (0)
template <int MODE, bool PRE_ = false> struct EpiBf16 {
    static constexpr bool MID = false, PERM = true, PRE = PRE_;
    bf16_t* C; int ldc; long cS1, cS2; const float* stats;
    float* lnst; int pn0 = 0;
    __device__ __forceinline__ const float* pre_base(const Unit& u) const { return stats + (size_t)u.pm * BM; }
    __device__ __forceinline__ void operator()(EPI_ARGS) const {
        const int pn = u.pn + pn0;
        int act = 0; if (MODE == 1) act = pn < 20 ? 0 : (pn < 28 ? 1 : 2);
        const bool lnrows = (MODE == 1) && pn >= 20 && pn < 28;
        char* ub = (char*)(C + (long)u.z1 * cS1 + (long)u.z2 * cS2 + (long)u.pm * BM * ldc + pn * BM);
        const unsigned lo = (unsigned)((wr * 64 + fr) * ldc + wc * 32 + 8 * fq) * 2u;
        float rs[2][4];
        if (PRE) {
#pragma unroll
            for (int ai = 0; ai < 2; ++ai)
#pragma unroll
                for (int m = 0; m < 4; ++m) rs[ai][m] = pre[ai * 4 + m]; }
        else if (stats) ROW_RS8(rs, stats, u.pm * BM + wr * 64 + fr);
        else {
#pragma unroll
            for (int ai = 0; ai < 2; ++ai)
#pragma unroll
                for (int m = 0; m < 4; ++m) rs[ai][m] = 1.0f; }
        if (MODE == 1 && act == 2) {
            char* g0 = (char*)(C + (long)u.pm * BM * ldc + C_GA + 128 * (pn - 28));
#pragma unroll
            for (int ai = 0; ai < 2; ++ai)
#pragma unroll
                for (int m = 0; m < 4; ++m) { char* rb = g0 + (size_t)(ai * HALF + m * 16) * ldc * 2;
                    f32x4 a0 = acc[ai][0][m][0], a1 = acc[ai][0][m][1], s0 = acc[ai][1][m][0], s1 = acc[ai][1][m][1]; const float kk = rs[ai][m] * (-1.4426950409f);
                    GATE4(a0, s0, kk); GATE4(a1, s1, kk);
                    asm volatile("s_nop 0" : "+v"(s0), "+v"(s1));
                    { u32x4 w; PACK8(w, a0, a1); *(u32x4*)(rb + lo) = w; }
                    { u32x4 w; PACK8(w, s0, s1); *(u32x4*)(rb + lo + (C_GS - C_GA) * 2) = w; } }
            return; }
#pragma unroll
        for (int ai = 0; ai < 2; ++ai)
#pragma unroll
            for (int m = 0; m < 4; ++m) { char* rb = ub + (size_t)(ai * HALF + m * 16) * ldc * 2;
                float s1 = 0.f, s2 = 0.f;
#pragma unroll
                for (int bj = 0; bj < 2; ++bj) { f32x4 v0 = acc[ai][bj][m][0] * rs[ai][m], v1 = acc[ai][bj][m][1] * rs[ai][m];
                    if (act == 1) { ACT4(v0, gelu_t2); ACT4(v1, gelu_t2); }
                    else if (act == 2) { ACT4(v0, sigm2); ACT4(v1, sigm2); }
                    u32x4 w; PACK8(w, v0, v1);
                    *(u32x4*)(rb + lo + bj * 256) = w;
                    if (MODE == 1 && lnrows) { const f32x4 t = v0 + v1, q = v0 * v0 + v1 * v1; s1 += (t[0] + t[1]) + (t[2] + t[3]); s2 += (q[0] + q[1]) + (q[2] + q[3]); } }
                if (MODE == 1 && lnrows) { const int ln = fq * 16 + fr; s1 += shx(s1, 16, ln); s1 += shx(s1, 32, ln); s2 += shx(s2, 16, ln); s2 += shx(s2, 32, ln);
                    if (fq == 0) ((PG8_LAS f32x2*)xl)[(ai * HALF + wr * 64 + m * 16 + fr) * 4 + wc] = (f32x2){s1, s2}; } }
        if (MODE == 1 && lnrows) {
            asm volatile("s_waitcnt lgkmcnt(0)" ::: "memory"); __builtin_amdgcn_s_barrier(); asm volatile("" ::: "memory");
            if (fq == 0) {
#pragma unroll
                for (int ai = 0; ai < 2; ++ai) { const int r = ai * HALF + wr * 64 + wc * 16 + fr; const PG8_LAS f32x2* q = (const PG8_LAS f32x2*)xl + r * 4;
                    const f32x2 a = q[0], b = q[1], c = q[2], d = q[3];
                    *(f32x2*)(lnst + ((size_t)(u.pm * BM + r) * 8 + (pn - 20)) * 2) = (f32x2){(a.x + b.x) + (c.x + d.x), (a.y + b.y) + (c.y + d.y)}; } }
        }
    }
};
struct EpiRes {
    static constexpr bool MID = false, PERM = true, PRE = false;
    bf16_t* XB; int ldc; long cS1; float* stats; int rows_per_z;
    __device__ __forceinline__ void operator()(EPI_ARGS) const {
        char* ub = (char*)(XB + (long)u.z1 * cS1 + (long)u.pm * BM * ldc + u.pn * BM);
        const unsigned lo = (unsigned)((wr * 64 + fr) * ldc + wc * 32 + 8 * fq) * 2u;
        PG8_LAS float* XS = (PG8_LAS float*)xl;
        const int ln = fq * 16 + fr;
        u32x4 xq[2][4][2];
#pragma unroll
        for (int ai = 0; ai < 2; ++ai)
#pragma unroll
            for (int m = 0; m < 4; ++m)
#pragma unroll
                for (int bj = 0; bj < 2; ++bj) xq[ai][m][bj] = *(const u32x4*)(ub + (size_t)(ai * HALF + m * 16) * ldc * 2 + lo + bj * 256);
        asm volatile("" ::: "memory");
#pragma unroll
        for (int ai = 0; ai < 2; ++ai)
#pragma unroll
            for (int m = 0; m < 4; ++m) { float ss = 0.f;
#pragma unroll
                for (int bj = 0; bj < 2; ++bj) { f32x4 v0 = acc[ai][bj][m][0], v1 = acc[ai][bj][m][1];
                    ADD8(v0, v1, xq[ai][m][bj]);
                    u32x4 w; PACK8(w, v0, v1); *(u32x4*)(ub + (size_t)(ai * HALF + m * 16) * ldc * 2 + lo + bj * 256) = w;
                    ss += (v0[0] * v0[0] + v0[1] * v0[1]) + (v0[2] * v0[2] + v0[3] * v0[3]) + (v1[0] * v1[0] + v1[1] * v1[1]) + (v1[2] * v1[2] + v1[3] * v1[3]); }
                ss += shx(ss, 16, ln); ss += shx(ss, 32, ln); if (fq == 0) XS[(ai * HALF + wr * 64 + m * 16 + fr) * 4 + wc] = ss; }
        asm volatile("s_waitcnt lgkmcnt(0)" ::: "memory"); __builtin_amdgcn_s_barrier(); asm volatile("" ::: "memory");
        if (fq == 0) {
#pragma unroll
            for (int ai = 0; ai < 2; ++ai) { const int r = ai * HALF + wr * 64 + wc * 16 + fr; const f32x4 q = *(const PG8_LAS f32x4*)(XS + r * 4);
                stats[((size_t)u.z1 * rows_per_z + u.pm * BM + r) * 8 + u.pn] = (q[0] + q[1]) + (q[2] + q[3]); } }
    }
};
template <bool FIRST> struct EpiMix {
    static constexpr bool MID = false, PERM = true, PRE = false;
    const bf16_t* G; bf16_t* O; int ld;
    __device__ __forceinline__ void operator()(EPI_ARGS) const {
        const long uo = (long)u.pm * BM * ld + u.pn * BM;
        const char* gb = (const char*)(G + uo); char* ob = (char*)(O + uo);
        const unsigned lo = (unsigned)((wr * 64 + fr) * ld + wc * 32 + 8 * fq) * 2u;
#pragma unroll
        for (int ai = 0; ai < 2; ++ai) {
            u32x4 gq[4][2], oq[4][2];
#pragma unroll
            for (int m = 0; m < 4; ++m)
#pragma unroll
                for (int bj = 0; bj < 2; ++bj) { const size_t ro = (size_t)(ai * HALF + m * 16) * ld * 2; gq[m][bj] = *(const u32x4*)(gb + ro + lo + bj * 256); if (!FIRST) oq[m][bj] = *(const u32x4*)(ob + ro + lo + bj * 256); }
            asm volatile("" ::: "memory");
#pragma unroll
            for (int m = 0; m < 4; ++m)
#pragma unroll
                for (int bj = 0; bj < 2; ++bj) { const size_t ro = (size_t)(ai * HALF + m * 16) * ld * 2;
                    f32x4 v0 = acc[ai][bj][m][0], v1 = acc[ai][bj][m][1];
                    MUL8(v0, v1, gq[m][bj]);
                    if (!FIRST) ADD8(v0, v1, oq[m][bj]);
                    u32x4 w; PACK8(w, v0, v1);
                    *(u32x4*)(ob + ro + lo + bj * 256) = w; }
            asm volatile("" ::: "memory"); }
    }
};
struct EpiMixF {
    static constexpr bool MID = true, PERM = true, PRE = false;
    const bf16_t* GA; const bf16_t* GS; bf16_t* O; int ld;
    __device__ __forceinline__ void mid(Acc& acc, const Unit& u, int wr, int wc, int fr, int fq) const {
        const char* ab = (const char*)(GA + ((long)u.pm * BM * ld + u.pn * BM));
        const unsigned lo = (unsigned)((wr * 64 + fr) * ld + wc * 32 + 8 * fq) * 2u;
#pragma unroll
        for (int ai = 0; ai < 2; ++ai) {
            u32x4 aq[4][2];
#pragma unroll
            for (int m = 0; m < 4; ++m)
#pragma unroll
                for (int bj = 0; bj < 2; ++bj) aq[m][bj] = *(const u32x4*)(ab + (size_t)(ai * HALF + m * 16) * ld * 2 + lo + bj * 256);
            asm volatile("" ::: "memory");
#pragma unroll
            for (int m = 0; m < 4; ++m)
#pragma unroll
                for (int bj = 0; bj < 2; ++bj) MUL8(acc[ai][bj][m][0], acc[ai][bj][m][1], aq[m][bj]);
            asm volatile("" ::: "memory"); }
    }
    __device__ __forceinline__ void operator()(EPI_ARGS) const {
        const long uo = (long)u.pm * BM * ld + u.pn * BM;
        const char* gb = (const char*)(GS + uo); char* ob = (char*)(O + uo);
        const unsigned lo = (unsigned)((wr * 64 + fr) * ld + wc * 32 + 8 * fq) * 2u;
#pragma unroll
        for (int ai = 0; ai < 2; ++ai) {
            u32x4 gq[4][2];
#pragma unroll
            for (int m = 0; m < 4; ++m)
#pragma unroll
                for (int bj = 0; bj < 2; ++bj) { const size_t ro = (size_t)(ai * HALF + m * 16) * ld * 2; gq[m][bj] = *(const u32x4*)(gb + ro + lo + bj * 256); }
            asm volatile("" ::: "memory");
#pragma unroll
            for (int m = 0; m < 4; ++m)
#pragma unroll
                for (int bj = 0; bj < 2; ++bj) { const size_t ro = (size_t)(ai * HALF + m * 16) * ld * 2;
                    f32x4 v0 = acc[ai][bj][m][0], v1 = acc[ai][bj][m][1];
                    MUL8(v0, v1, gq[m][bj]);
                    u32x4 w; PACK8(w, v0, v1);
                    *(u32x4*)(ob + ro + lo + bj * 256) = w; }
            asm volatile("" ::: "memory"); }
    }
};
struct EpiSpatial {
    static constexpr bool MID = false, PERM = true, PRE = false;
    bf16_t* U; int ld; const float* bs;
    __device__ __forceinline__ void operator()(EPI_ARGS) const {
        char* ub = (char*)(U + (long)u.z1 * BM * ld + u.z2 * BM);
        const unsigned lo = (unsigned)((wr * 64 + fr) * ld + wc * 32 + 8 * fq) * 2u;
        const float* bp = bs + u.z2 * 128 + wr * 64;
        u32x4 uq[2][4][2]; float bq[4];
#pragma unroll
        for (int m = 0; m < 4; ++m) bq[m] = bp[m * 16 + fr];
#pragma unroll
        for (int ai = 0; ai < 2; ++ai)
#pragma unroll
            for (int m = 0; m < 4; ++m)
#pragma unroll
                for (int bj = 0; bj < 2; ++bj) uq[ai][m][bj] = *(const u32x4*)(ub + (size_t)(ai * HALF + m * 16) * ld * 2 + lo + bj * 256);
        asm volatile("" ::: "memory");
#pragma unroll
        for (int ai = 0; ai < 2; ++ai)
#pragma unroll
            for (int m = 0; m < 4; ++m)
#pragma unroll
                for (int bj = 0; bj < 2; ++bj) {
                    const u32x4 q = uq[ai][m][bj];
                    f32x4 u0 = (f32x4){bf_lo(q.x), bf_hi(q.x), bf_lo(q.y), bf_hi(q.y)}, u1 = (f32x4){bf_lo(q.z), bf_hi(q.z), bf_lo(q.w), bf_hi(q.w)};
                    ACT4(u0, gelu_t2); ACT4(u1, gelu_t2);
                    const f32x4 v0 = (acc[ai][bj][m][0] + bq[m]) * u0, v1 = (acc[ai][bj][m][1] + bq[m]) * u1;
                    u32x4 w; PACK8(w, v0, v1);
                    *(u32x4*)(ub + (size_t)(ai * HALF + m * 16) * ld * 2 + lo + bj * 256) = w; }
    }
};
#define DPP_SHR1 0x111
#define DPP_SHL1 0x101
#define DPP_ROR1 0x121
#define DPP_ROR15 0x12F
#define DPPI(old, src, ctrl) ((unsigned)__builtin_amdgcn_update_dpp((int)(old), (int)(src), ctrl, 0xF, 0xF, false))
struct EpiConv {
    static constexpr bool MID = false, PERM = true, PRE = true;
    __device__ __forceinline__ const float* pre_base(const Unit& u) const { return stats + (size_t)u.pm * BM; }
    const bf16_t* A; bf16_t* O; int ld; const float* stats; const float* cw; const float* cb;
    __device__ __forceinline__ void operator()(EPI_ARGS) const {
        {
#pragma unroll
          for (int ai = 0; ai < 2; ++ai)
#pragma unroll
            for (int m = 0; m < 4; ++m)
#pragma unroll
                for (int bj = 0; bj < 2; ++bj) { acc[ai][bj][m][0] *= pre[ai * 4 + m]; acc[ai][bj][m][1] *= pre[ai * 4 + m]; } }
        const long uo = (long)u.pm * BM * ld + u.pn * BM;
        const char* ab = (const char*)(A + uo); char* ob = (char*)(O + uo);
        const int ld2 = ld * 2;
        const unsigned lo = (unsigned)((wr * 64 + fr) * ld + wc * 32 + 8 * fq) * 2u;
        const unsigned loe = (unsigned)((wr * 64) * ld + wc * 32 + 8 * fq) * 2u;
        const int pm8 = u.pm & 7;
#pragma unroll
        for (int bj = 0; bj < 2; ++bj) {
            const float* pp = cw + u.pn * BM + bj * HALF + wc * 32 + 8 * fq; const float* pb = cb + u.pn * BM + bj * HALF + wc * 32 + 8 * fq;
            const f32x4 w0a = *(const f32x4*)pp, w0b = *(const f32x4*)(pp + 4), w1a = *(const f32x4*)(pp + ld), w1b = *(const f32x4*)(pp + ld + 4),
                        w2a = *(const f32x4*)(pp + 2 * ld), w2b = *(const f32x4*)(pp + 2 * ld + 4), cba = *(const f32x4*)pb, cbb = *(const f32x4*)(pb + 4);
#pragma unroll
            for (int ai = 0; ai < 2; ++ai) {
                const bool tz = (pm8 == 0) && (ai == 0) && (wr == 0), bz = (pm8 == 7) && (ai == 1) && (wr == 1);
                u32x4 qc[4], et, eb;
#pragma unroll
                for (int m = 0; m < 4; ++m) qc[m] = *(const u32x4*)(ab + (size_t)(ai * HALF + m * 16) * ld2 + lo + bj * 256);
                et = *(const u32x4*)(ab + (long)(ai * HALF + (tz ? 0 : -1)) * ld2 + loe + bj * 256);
                eb = *(const u32x4*)(ab + (long)(ai * HALF + (bz ? 63 : 64)) * ld2 + loe + bj * 256);
                asm volatile("" ::: "memory");
                if (tz) et = (u32x4){0u, 0u, 0u, 0u};
                if (bz) eb = (u32x4){0u, 0u, 0u, 0u};
#pragma unroll
                for (int m = 0; m < 4; ++m) {
                    u32x4 zp, zn; const u32x4 zc = qc[m];
#pragma unroll
                    for (int d = 0; d < 4; ++d) {
                        const unsigned X = (m == 0) ? et[d] : DPPI(0, qc[m > 0 ? m - 1 : 0][d], DPP_ROR1);
                        zp[d] = DPPI(X, zc[d], DPP_SHR1);
                        const unsigned Y = (m == 3) ? eb[d] : DPPI(0, qc[m < 3 ? m + 1 : 3][d], DPP_ROR15);
                        zn[d] = DPPI(Y, zc[d], DPP_SHL1); }
#define UNP4(lo4, hi4, QQ) const f32x4 lo4 = (f32x4){bf_lo(QQ.x), bf_hi(QQ.x), bf_lo(QQ.y), bf_hi(QQ.y)}, hi4 = (f32x4){bf_lo(QQ.z), bf_hi(QQ.z), bf_lo(QQ.w), bf_hi(QQ.w)}
                    UNP4(pl, ph, zp); UNP4(cl, ch, zc); UNP4(nl, nh, zn);
#undef UNP4
                    f32x4 c0 = cba + w0a * pl + w1a * cl + w2a * nl, c1 = cbb + w0b * ph + w1b * ch + w2b * nh;
                    ACT4(c0, gelu_t2); ACT4(c1, gelu_t2);
                    const f32x4 v0 = acc[ai][bj][m][0] * c0, v1 = acc[ai][bj][m][1] * c1;
                    u32x4 w; PACK8(w, v0, v1);
                    *(u32x4*)(ob + (size_t)(ai * HALF + m * 16) * ld2 + lo + bj * 256) = w; }
                asm volatile("" ::: "memory"); }
        }
    }
};
struct EpiUp {
    static constexpr bool MID = false, PERM = true, PRE = true;
    bf16_t* O; int ldo; const float* stats; const float* cw; const float* cb; float* EA; float* EB;
    __device__ __forceinline__ const float* pre_base(const Unit& u) const { return stats + (size_t)u.pm * BM; }
    __device__ __forceinline__ void operator()(EPI_ARGS) const {
#pragma unroll
        for (int ai = 0; ai < 2; ++ai)
#pragma unroll
            for (int m = 0; m < 4; ++m)
#pragma unroll
                for (int bj = 0; bj < 2; ++bj) { acc[ai][bj][m][0] *= pre[ai * 4 + m]; acc[ai][bj][m][1] *= pre[ai * 4 + m]; }
        const int ch0 = u.pn * HALF + wc * 32 + 8 * fq;
        const float* pp = cw + ch0; const float* pb = cb + ch0;
        const f32x4 w0a = *(const f32x4*)pp, w0b = *(const f32x4*)(pp + 4), w1a = *(const f32x4*)(pp + ldo), w1b = *(const f32x4*)(pp + ldo + 4),
                    w2a = *(const f32x4*)(pp + 2 * ldo), w2b = *(const f32x4*)(pp + 2 * ldo + 4), cba = *(const f32x4*)pb, cbb = *(const f32x4*)(pb + 4);
        PG8_LAS float* E = (PG8_LAS float*)xl;
        const int cl = wc * 32 + 8 * fq;
#pragma unroll
        for (int ai = 0; ai < 2; ++ai) { const int blk = ai * 2 + wr;
            if (fr == 0)  { *(PG8_LAS f32x4*)(E + (blk * 2 + 0) * HALF + cl) = acc[ai][0][0][0]; *(PG8_LAS f32x4*)(E + (blk * 2 + 0) * HALF + cl + 4) = acc[ai][0][0][1]; }
            if (fr == 15) { *(PG8_LAS f32x4*)(E + (blk * 2 + 1) * HALF + cl) = acc[ai][0][3][0]; *(PG8_LAS f32x4*)(E + (blk * 2 + 1) * HALF + cl + 4) = acc[ai][0][3][1]; } }
        asm volatile("s_waitcnt lgkmcnt(0)" ::: "memory"); __builtin_amdgcn_s_barrier(); asm volatile("" ::: "memory");
        char* ob = (char*)(O + (long)u.pm * BM * ldo + ch0);
        const unsigned lo = (unsigned)((wr * 64 + fr) * ldo) * 2u;
#define DPPF(old, src, ctrl) __uint_as_float((unsigned)__builtin_amdgcn_update_dpp((int)__float_as_uint(old), (int)__float_as_uint(src), ctrl, 0xF, 0xF, false))
#pragma unroll
        for (int ai = 0; ai < 2; ++ai) { const int blk = ai * 2 + wr;
            f32x4 et0 = (f32x4){0.f, 0.f, 0.f, 0.f}, et1 = et0, eb0 = et0, eb1 = et0;
            if (blk > 0) { et0 = *(const PG8_LAS f32x4*)(E + ((blk - 1) * 2 + 1) * HALF + cl); et1 = *(const PG8_LAS f32x4*)(E + ((blk - 1) * 2 + 1) * HALF + cl + 4); }
            if (blk < 3) { eb0 = *(const PG8_LAS f32x4*)(E + ((blk + 1) * 2 + 0) * HALF + cl); eb1 = *(const PG8_LAS f32x4*)(E + ((blk + 1) * 2 + 0) * HALF + cl + 4); }
#pragma unroll
            for (int m = 0; m < 4; ++m) {
                const f32x4 c0 = acc[ai][0][m][0], c1 = acc[ai][0][m][1]; f32x4 p0, p1, n0, n1;
#pragma unroll
                for (int e = 0; e < 4; ++e) {
                    const float X0 = (m == 0) ? et0[e] : DPPF(0.f, acc[ai][0][m > 0 ? m - 1 : 0][0][e], DPP_ROR1), X1 = (m == 0) ? et1[e] : DPPF(0.f, acc[ai][0][m > 0 ? m - 1 : 0][1][e], DPP_ROR1);
                    p0[e] = DPPF(X0, c0[e], DPP_SHR1); p1[e] = DPPF(X1, c1[e], DPP_SHR1);
                    const float Y0 = (m == 3) ? eb0[e] : DPPF(0.f, acc[ai][0][m < 3 ? m + 1 : 3][0][e], DPP_ROR15), Y1 = (m == 3) ? eb1[e] : DPPF(0.f, acc[ai][0][m < 3 ? m + 1 : 3][1][e], DPP_ROR15);
                    n0[e] = DPPF(Y0, c0[e], DPP_SHL1); n1[e] = DPPF(Y1, c1[e], DPP_SHL1); }
                f32x4 g0 = cba + w0a * p0 + w1a * c0 + w2a * n0, g1 = cbb + w0b * p1 + w1b * c1 + w2b * n1;
                ACT4(g0, gelu_t2); ACT4(g1, gelu_t2);
                const f32x4 v0 = acc[ai][1][m][0] * g0, v1 = acc[ai][1][m][1] * g1;
                u32x4 w; PACK8(w, v0, v1);
                *(u32x4*)(ob + (size_t)(ai * HALF + m * 16) * ldo * 2 + lo) = w; } }
#undef DPPF
        if (wr == 0 && fr < 2) { float* ea = EA + ((size_t)u.pm * 4 + fr) * ldo + ch0; *(f32x4*)ea = acc[0][0][0][0]; *(f32x4*)(ea + 4) = acc[0][0][0][1];
            if (fr == 0) { float* eb = EB + ((size_t)u.pm * 2 + 0) * ldo + ch0; *(f32x4*)eb = acc[0][1][0][0]; *(f32x4*)(eb + 4) = acc[0][1][0][1]; } }
        if (wr == 1 && fr >= 14) { float* ea = EA + ((size_t)u.pm * 4 + 2 + (fr - 14)) * ldo + ch0; *(f32x4*)ea = acc[1][0][3][0]; *(f32x4*)(ea + 4) = acc[1][0][3][1];
            if (fr == 15) { float* eb = EB + ((size_t)u.pm * 2 + 1) * ldo + ch0; *(f32x4*)eb = acc[1][1][3][0]; *(f32x4*)(eb + 4) = acc[1][1][3][1]; } }
    }
};
struct EpiSoftmax {
    static constexpr bool MID = false, PERM = true, PRE = false;
    bf16_t* P; int ldc; long cS1; float sc2; const float* stats; int rows_per_z;
    __device__ __forceinline__ void operator()(EPI_ARGS) const {
        PG8_LAS f32x2* X = (PG8_LAS f32x2*)xl;
        float mw[2][4], rsr[2][4]; const int ln = fq * 16 + fr;
        ROW_RS8(rsr, stats, u.z1 * rows_per_z + u.pm * BM + wr * 64 + fr);
#pragma unroll
        for (int ai = 0; ai < 2; ++ai)
#pragma unroll
            for (int m = 0; m < 4; ++m) {
                float mx = -3.0e38f; const float rsc = sc2 * rsr[ai][m];
#pragma unroll
                for (int bj = 0; bj < 2; ++bj)
#pragma unroll
                    for (int n = 0; n < 2; ++n)
#pragma unroll
                        for (int e = 0; e < 4; ++e) { const float v = acc[ai][bj][m][n][e] * rsc; acc[ai][bj][m][n][e] = v; mx = fmaxf(mx, v); }
                mx = fmaxf(mx, shx(mx, 16, ln)); mx = fmaxf(mx, shx(mx, 32, ln));
                float s = 0.f;
#pragma unroll
                for (int bj = 0; bj < 2; ++bj)
#pragma unroll
                    for (int n = 0; n < 2; ++n)
#pragma unroll
                        for (int e = 0; e < 4; ++e) { const float p = __builtin_amdgcn_exp2f(acc[ai][bj][m][n][e] - mx); acc[ai][bj][m][n][e] = p; s += p; }
                s += shx(s, 16, ln); s += shx(s, 32, ln);
                mw[ai][m] = mx;
                if (fq == 0) X[(ai * HALF + wr * 64 + m * 16 + fr) * 4 + wc] = (f32x2){mx, s};
            }
        asm volatile("s_waitcnt lgkmcnt(0)" ::: "memory"); __builtin_amdgcn_s_barrier(); asm volatile("" ::: "memory");
        char* ub = (char*)(P + (long)u.z1 * cS1 + (long)u.pm * BM * ldc + u.pn * BM);
        const unsigned lo = (unsigned)((wr * 64 + fr) * ldc + wc * 32 + 8 * fq) * 2u;
#pragma unroll
        for (int ai = 0; ai < 2; ++ai)
#pragma unroll
            for (int m = 0; m < 4; ++m) { const int r = ai * HALF + wr * 64 + m * 16 + fr;
                const f32x2 a = X[r * 4 + 0], b = X[r * 4 + 1], c = X[r * 4 + 2], d = X[r * 4 + 3];
                const float mt = fmaxf(fmaxf(a.x, b.x), fmaxf(c.x, d.x));
                const float l = a.y * __builtin_amdgcn_exp2f(a.x - mt) + b.y * __builtin_amdgcn_exp2f(b.x - mt) + c.y * __builtin_amdgcn_exp2f(c.x - mt) + d.y * __builtin_amdgcn_exp2f(d.x - mt);
                const float f = __builtin_amdgcn_exp2f(mw[ai][m] - mt) / l;
                char* rb = ub + (size_t)(ai * HALF + m * 16) * ldc * 2;
#pragma unroll
                for (int bj = 0; bj < 2; ++bj) { const f32x4 v0 = acc[ai][bj][m][0] * f, v1 = acc[ai][bj][m][1] * f; u32x4 w; PACK8(w, v0, v1);
                    *(u32x4*)(rb + lo + bj * 256) = w; } }
    }
};

template <class Epi>
__device__ __forceinline__ void gemm_phase(PG8_LAS unsigned char* lds, PG8_LAS unsigned char* xl, const Gemm g, const Sched& S, const Epi& E, const int wid) {
    const int lane = lane_id_opq(), tid = wid * 64 + lane;
    const int wr = wid >> 2, wc = wid & 3, fr = lane & 15, fq = lane >> 4;
    const int K = g.K, nt = K / BK;
    unsigned voffA[2], voffB[2];
#pragma unroll
    for (int i = 0; i < 2; ++i) { int R, C; stage_rc(tid * 16 + i * 8192, R, C); const int Rb = Epi::PERM ? ((R & ~31) + perm32(R & 31)) : R;
        voffA[i] = (unsigned)(R * g.lda + C) * 2u; voffB[i] = (unsigned)(Rb * g.ldb + C) * 2u; }
    const size_t kstep = (size_t)(BK * 2);
    const size_t hstepA = (size_t)HALF * g.lda * 2, hstepB = (size_t)HALF * g.ldb * 2;
    const unsigned ldsw = (unsigned)wid * 1024u;
    const int aoff = lds_byte(wr * 64 + fr, fq * 8), boff = lds_byte(wc * 32 + fr, fq * 8);
#define PG8_SA(b, h) (((b) * 2 + (h)) * HTB)
#define PG8_SB(b, h) ((4 + (b) * 2 + (h)) * HTB)
#define PG8_STAGE(bufoff, gbase, voff) do { _Pragma("unroll") for (int _i = 0; _i < 2; ++_i) \
        __builtin_amdgcn_global_load_lds((const unsigned*)((const char*)(gbase) + (voff)[_i]), (PG8_LAS unsigned*)(lds + (bufoff) + ldsw + _i * 8192), 16, 0, 0); } while (0)
#define PG8_LDA(dst, b, h) do { _Pragma("unroll") for (int m = 0; m < 4; ++m) _Pragma("unroll") for (int k = 0; k < 2; ++k) dst[m][k] = *(const PG8_LAS bf16x8*)(lds + PG8_SA(b, h) + aoff + m * 2048 + k * 1024); } while (0)
#define PG8_LDB(dst, b, h) do { _Pragma("unroll") for (int n = 0; n < 2; ++n) _Pragma("unroll") for (int k = 0; k < 2; ++k) dst[n][k] = *(const PG8_LAS bf16x8*)(lds + PG8_SB(b, h) + boff + n * 2048 + k * 1024); } while (0)
#define PG8_MMA(ai, bj, At, Bt) do { __builtin_amdgcn_s_setprio(1); _Pragma("unroll") for (int m = 0; m < 4; ++m) _Pragma("unroll") for (int n = 0; n < 2; ++n) _Pragma("unroll") for (int k = 0; k < 2; ++k) \
        acc[ai][bj][m][n] = __builtin_amdgcn_mfma_f32_16x16x32_bf16(Bt[n][k], At[m][k], acc[ai][bj][m][n], 0, 0, 0); __builtin_amdgcn_s_setprio(0); } while (0)
#define PG8_WAIT_V(n) asm volatile("s_waitcnt vmcnt(" #n ")" ::: "memory")
#define PG8_WAIT_L(n) asm volatile("s_waitcnt lgkmcnt(" #n ")" ::: "memory")
#define PG8_BAR __builtin_amdgcn_s_barrier()
#define PG8_SCHED __builtin_amdgcn_sched_barrier(0)
    Unit cur, nxt; int ui = 0;
    if (!S.next(0, cur)) return;
    Acc acc;
#pragma unroll
    for (int a = 0; a < 2; ++a)
#pragma unroll
        for (int b = 0; b < 2; ++b)
#pragma unroll
            for (int m = 0; m < 4; ++m)
#pragma unroll
                for (int n = 0; n < 2; ++n) acc[a][b][m][n] = (f32x4){0.f, 0.f, 0.f, 0.f};
    bf16x8 At[4][2], B0[2][2], B1[2][2];
    float prc[8];
#pragma unroll
    for (int k = 0; k < 8; ++k) prc[k] = 1.0f;
    if constexpr (Epi::PRE) { const float* pb = E.pre_base(cur) + wr * 64 + fr;
#pragma unroll
        for (int k = 0; k < 8; ++k) prc[k] = pb[(k >> 2) * HALF + (k & 3) * 16]; }
    const char* cA = a_tile(g, cur); const char* cB = b_tile(g, cur);
    PG8_STAGE(PG8_SB(0, 0), cB, voffB); PG8_STAGE(PG8_SB(0, 1), cB + hstepB, voffB); PG8_STAGE(PG8_SA(0, 0), cA, voffA); PG8_STAGE(PG8_SA(0, 1), cA + hstepA, voffA);
    if (wr == 1) PG8_BAR;
    PG8_WAIT_V(2); PG8_BAR;
    PG8_STAGE(PG8_SB(1, 0), cB + kstep, voffB); PG8_STAGE(PG8_SA(1, 0), cA + kstep, voffA); PG8_STAGE(PG8_SB(1, 1), cB + hstepB + kstep, voffB);
    PG8_WAIT_V(6); PG8_BAR;
    for (;;) {
        const bool has_next = S.next(ui + 1, nxt);
        const char* nA = has_next ? a_tile(g, nxt) : cA; const char* nB = has_next ? b_tile(g, nxt) : cB;
        for (int t = 0; t < nt; t += 2) {
            const bool last = (t == nt - 2);
            long j1 = 0, ja2 = 0, jb2 = 0;
            if constexpr (Epi::MID) {
                if (t == g.tj) { const int lnM = lane_id_opq(); E.mid(acc, cur, wr, wc, lnM & 15, lnM >> 4); }
                if (t >= g.tj) j1 = g.jA;
                if (t + 2 >= g.tj) { ja2 = g.jA; jb2 = g.jB; } }
            const char* a1 = cA + (size_t)(t + 1) * kstep + j1;
            const char* a2 = last ? nA : cA + (size_t)(t + 2) * kstep + ja2; const char* b2 = last ? nB : cB + (size_t)(t + 2) * kstep + jb2;
            const char* a3 = a2 + kstep; const char* b3 = b2 + kstep;
            PG8_LDB(B0, 0, 0); PG8_LDB(B1, 0, 1); PG8_SCHED; PG8_LDA(At, 0, 0); PG8_STAGE(PG8_SA(1, 1), a1 + hstepA, voffA);
            PG8_WAIT_V(8); PG8_WAIT_L(0); PG8_BAR; PG8_MMA(0, 0, At, B0); PG8_MMA(0, 1, At, B1); PG8_BAR; PG8_SCHED;
            PG8_LDA(At, 0, 1); PG8_STAGE(PG8_SB(0, 0), b2, voffB); PG8_STAGE(PG8_SB(0, 1), b2 + hstepB, voffB); PG8_STAGE(PG8_SA(0, 0), a2, voffA);
            PG8_WAIT_V(8); PG8_WAIT_L(0); PG8_BAR; PG8_MMA(1, 0, At, B0); PG8_MMA(1, 1, At, B1); PG8_BAR; PG8_SCHED;
            PG8_LDB(B0, 1, 0); PG8_LDB(B1, 1, 1); PG8_SCHED; PG8_LDA(At, 1, 0); PG8_STAGE(PG8_SA(0, 1), a2 + hstepA, voffA);
            PG8_WAIT_V(8); PG8_WAIT_L(0); PG8_BAR; PG8_MMA(0, 0, At, B0); PG8_MMA(0, 1, At, B1); PG8_BAR; PG8_SCHED;
            PG8_LDA(At, 1, 1); PG8_STAGE(PG8_SB(1, 0), b3, voffB); PG8_STAGE(PG8_SB(1, 1), b3 + hstepB, voffB); PG8_STAGE(PG8_SA(1, 0), a3, voffA);
            PG8_WAIT_V(8); PG8_WAIT_L(0); PG8_BAR; PG8_MMA(1, 0, At, B0); PG8_MMA(1, 1, At, B1); PG8_BAR; PG8_SCHED;
        }
        if (wr == 0) PG8_BAR;
        { const int lnE = lane_id_opq(); const int frE = lnE & 15, fqE = lnE >> 4;
          float prn[8];
#pragma unroll
          for (int k = 0; k < 8; ++k) prn[k] = 1.0f;
          if constexpr (Epi::PRE) { if (has_next) { const float* pb = E.pre_base(nxt) + wr * 64 + frE;
#pragma unroll
              for (int k = 0; k < 8; ++k) prn[k] = pb[(k >> 2) * HALF + (k & 3) * 16]; } }
          E(acc, cur, wr, wc, frE, fqE, xl, prc);
          if constexpr (Epi::PRE) {
#pragma unroll
              for (int k = 0; k < 8; ++k) prc[k] = prn[k]; } }
        if (!has_next) break;
#pragma unroll
        for (int a = 0; a < 2; ++a)
#pragma unroll
            for (int b = 0; b < 2; ++b)
#pragma unroll
                for (int m = 0; m < 4; ++m)
#pragma unroll
                    for (int n = 0; n < 2; ++n) acc[a][b][m][n] = (f32x4){0.f, 0.f, 0.f, 0.f};
        cur = nxt; cA = nA; cB = nB; ++ui;
        if (wr == 1) PG8_BAR;
    }
    PG8_WAIT_V(0);
    PG8_BAR;
#undef PG8_SA
#undef PG8_SB
#undef PG8_STAGE
#undef PG8_LDA
#undef PG8_LDB
#undef PG8_MMA
#undef PG8_WAIT_V
#undef PG8_WAIT_L
#undef PG8_BAR
#undef PG8_SCHED
}
}

namespace attn {
using bf16x8 = __attribute__((ext_vector_type(8))) short;
using s16x4  = __attribute__((ext_vector_type(4))) short;
using f32x16 = __attribute__((ext_vector_type(16))) float;
using u32x4  = __attribute__((ext_vector_type(4))) unsigned;
typedef unsigned short bf16_t;
constexpr int D = 128, NW = 8, QBLK = 32, KVBLK = 64;
constexpr float SCALE = 0.088388347648318440f;
constexpr float THR = 8.f;
constexpr int LD = NIN;
constexpr int NBUF = 3;
constexpr size_t SHM_V = KVBLK * D * 2, SHM_K = KVBLK * D * 2, SHM_WS = NBUF * (SHM_V + SHM_K), SHM_OST = 0;
constexpr int OST_STRIDE = 272, OST_WAVE = 32 * OST_STRIDE;
constexpr size_t SHM_ATTN = SHM_WS + NW * 64 * 4;
static_assert(NW * OST_WAVE <= SHM_WS, "O staging fits inside the ring");
#define KSWZ(row, colB) ((row) * 256 + ((colB) ^ (((row) & 7) << 4)))
#define SBAR() __builtin_amdgcn_sched_barrier(0)
__device__ __forceinline__ int crow(int r, int hi) { return (r & 3) + 8 * (r >> 2) + 4 * hi; }
__device__ __forceinline__ unsigned cvtpk(float lo, float hi) { unsigned r; asm volatile("v_cvt_pk_bf16_f32 %0, %1, %2" : "=v"(r) : "v"(lo), "v"(hi)); return r; }
__device__ __forceinline__ bf16x8 ld8(const bf16_t* p) { return *reinterpret_cast<const bf16x8*>(p); }

__device__ __forceinline__ float fadd_s(float a, float b) { float r; asm("v_add_f32 %0, %1, %2" : "=v"(r) : "v"(a), "v"(b)); return r; }
__device__ __forceinline__ void expHalf(f32x16& p0) {
#pragma unroll
  for (int r = 0; r < 16; ++r) p0[r] = __builtin_amdgcn_exp2f(p0[r]);
}
__device__ __forceinline__ void finishSM(f32x16& p0, f32x16& p1, float& l_reg, bf16x8& pa0, bf16x8& pa1, bf16x8& pa2, bf16x8& pa3) {
#pragma unroll
  for (int r = 0; r < 16; ++r) p1[r] = __builtin_amdgcn_exp2f(p1[r]);
  asm volatile("s_nop 0" : "+v"(p1));
  float s0 = fadd_s(p0[0], p0[1]), s1 = fadd_s(p0[2], p0[3]), s2 = fadd_s(p0[4], p0[5]), s3 = fadd_s(p0[6], p0[7]);
#pragma unroll
  for (int r = 8; r < 16; r += 4) { s0 = fadd_s(s0, p0[r]); s1 = fadd_s(s1, p0[r + 1]); s2 = fadd_s(s2, p0[r + 2]); s3 = fadd_s(s3, p0[r + 3]); }
#pragma unroll
  for (int r = 0; r < 16; r += 4) { s0 = fadd_s(s0, p1[r]); s1 = fadd_s(s1, p1[r + 1]); s2 = fadd_s(s2, p1[r + 2]); s3 = fadd_s(s3, p1[r + 3]); }
  l_reg = fadd_s(l_reg, fadd_s(fadd_s(s0, s1), fadd_s(s2, s3)));
#define PK4(P, BASE, OUT) do { unsigned a0 = cvtpk(P[BASE + 0], P[BASE + 1]), a1 = cvtpk(P[BASE + 2], P[BASE + 3]);   \
    unsigned b0 = cvtpk(P[BASE + 4], P[BASE + 5]), b1 = cvtpk(P[BASE + 6], P[BASE + 7]);                              \
    asm volatile("s_nop 1" : "+v"(a0), "+v"(a1), "+v"(b0), "+v"(b1));     \
    auto r0 = __builtin_amdgcn_permlane32_swap(a0, b0, false, false); auto r1 = __builtin_amdgcn_permlane32_swap(a1, b1, false, false); \
    u32x4 w = {r0[0], r1[0], r0[1], r1[1]}; OUT = *reinterpret_cast<bf16x8*>(&w); } while (0)
  PK4(p0, 0, pa0); PK4(p0, 8, pa1); PK4(p1, 0, pa2); PK4(p1, 8, pa3);
#undef PK4
}
__device__ __forceinline__ void qkt(f32x16& p0, f32x16& p1, const bf16_t* Ks, const bf16x8* qr, int r32, int hi) {
  p0 = f32x16{}; p1 = f32x16{};
#pragma unroll
  for (int d0 = 0; d0 < 8; ++d0) { int cb = (d0 * 16 + hi * 8) * 2;
    bf16x8 b0 = *reinterpret_cast<const bf16x8*>((const char*)Ks + KSWZ(r32, cb));
    bf16x8 b1 = *reinterpret_cast<const bf16x8*>((const char*)Ks + KSWZ(32 + r32, cb));
    p0 = __builtin_amdgcn_mfma_f32_32x32x16_bf16(b0, qr[d0], p0, 0, 0, 0);
    p1 = __builtin_amdgcn_mfma_f32_32x32x16_bf16(b1, qr[d0], p1, 0, 0, 0); }
}
__device__ __forceinline__ int v_st(int k, int c) { const int kk = (k & ~0xC) | ((k & 4) << 1) | ((k & 8) >> 1); return ((kk >> 3) * 4 + (c >> 5)) * 512 + ((kk & 7) * 32 + (c & 31)) * 2; }
__device__ __forceinline__ int v_rd_base(int lane) { return ((lane & 3) << 3) | (((lane >> 2) & 3) << 6) | (((lane >> 4) & 1) << 5) | (((lane >> 5) & 1) << 8); }
constexpr int v_rd_off(int d0, int ks, int half) { return d0 * 512 + ks * 4096 + half * 2048; }
template <int OFF> __device__ __forceinline__ s16x4 tr_read(int vb) {
  s16x4 r; asm volatile("ds_read_b64_tr_b16 %0, %1 offset:%2" : "=&v"(r) : "v"(vb), "i"(OFF) : "memory"); return r;
}
template <int D0> __device__ __forceinline__ void pv_one(f32x16& od, int vb, bf16x8 pa0, bf16x8 pa1, bf16x8 pa2, bf16x8 pa3) {
  const s16x4 l0 = tr_read<v_rd_off(D0, 0, 0)>(vb), h0 = tr_read<v_rd_off(D0, 0, 1)>(vb), l1 = tr_read<v_rd_off(D0, 1, 0)>(vb), h1 = tr_read<v_rd_off(D0, 1, 1)>(vb);
  const s16x4 l2 = tr_read<v_rd_off(D0, 2, 0)>(vb), h2 = tr_read<v_rd_off(D0, 2, 1)>(vb), l3 = tr_read<v_rd_off(D0, 3, 0)>(vb), h3 = tr_read<v_rd_off(D0, 3, 1)>(vb);
  asm volatile("s_waitcnt lgkmcnt(0)" ::: "memory"); SBAR();
#define PK(L, H) (bf16x8){L[0], L[1], L[2], L[3], H[0], H[1], H[2], H[3]}
  od = __builtin_amdgcn_mfma_f32_32x32x16_bf16(pa0, PK(l0, h0), od, 0, 0, 0);
  od = __builtin_amdgcn_mfma_f32_32x32x16_bf16(pa1, PK(l1, h1), od, 0, 0, 0);
  od = __builtin_amdgcn_mfma_f32_32x32x16_bf16(pa2, PK(l2, h2), od, 0, 0, 0);
  od = __builtin_amdgcn_mfma_f32_32x32x16_bf16(pa3, PK(l3, h3), od, 0, 0, 0);
#undef PK
}
__device__ __forceinline__ void pv_d0(f32x16* o, int vb, bf16x8 pa0, bf16x8 pa1, bf16x8 pa2, bf16x8 pa3) {
  pv_one<0>(o[0], vb, pa0, pa1, pa2, pa3); pv_one<1>(o[1], vb, pa0, pa1, pa2, pa3); pv_one<2>(o[2], vb, pa0, pa1, pa2, pa3); pv_one<3>(o[3], vb, pa0, pa1, pa2, pa3);
}
__device__ __forceinline__ void attn_dense_body(const bf16_t* Qb, const bf16_t* __restrict__ Kh, const bf16_t* __restrict__ Vh, bf16_t* Ob, int seq, char* lds, const int wid,
                                                const float* __restrict__ qg, const float* __restrict__ rope, int t0) {
  const int lane = pg8::lane_id_opq(), tid = wid * 64 + lane;
  const int r32 = lane & 31, hi = lane >> 5;
  bf16_t* V_lds = (bf16_t*)lds; bf16_t* K_lds = (bf16_t*)(lds + NBUF * SHM_V);
  float* ws = (float*)(lds + SHM_WS) + wid * 64; float* li_l = ws;
  float l_reg = 0; f32x16 o[4] = {}; bf16x8 qr[8];
  const bf16_t* Qw = Qb + (long)(wid * QBLK + r32) * LD + hi * 8;
#pragma unroll
  for (int d0 = 0; d0 < 8; ++d0) qr[d0] = ld8(Qw + d0 * 16);
  {
    float y[8][8]; float ss = 0.f;
#pragma unroll
    for (int d0 = 0; d0 < 8; ++d0) { const u32x4 w = __builtin_bit_cast(u32x4, qr[d0]);
      y[d0][0] = __uint_as_float(w.x << 16); y[d0][1] = __uint_as_float(w.x & 0xffff0000u); y[d0][2] = __uint_as_float(w.y << 16); y[d0][3] = __uint_as_float(w.y & 0xffff0000u);
      y[d0][4] = __uint_as_float(w.z << 16); y[d0][5] = __uint_as_float(w.z & 0xffff0000u); y[d0][6] = __uint_as_float(w.w << 16); y[d0][7] = __uint_as_float(w.w & 0xffff0000u);
#pragma unroll
      for (int e = 0; e < 8; ++e) ss += y[d0][e] * y[d0][e]; }
    { auto rr = __builtin_amdgcn_permlane32_swap(__float_as_uint(ss), __float_as_uint(ss), false, false); ss = __uint_as_float(rr[0]) + __uint_as_float(rr[1]); }
    const float rs = (SCALE * 1.4426950408889634f) / sqrtf(ss * (1.f / 128.f) + 1e-6f);
#pragma unroll
    for (int d0 = 0; d0 < 8; ++d0) { const float* gp = qg + d0 * 16 + hi * 8;
#pragma unroll
      for (int e = 0; e < 8; ++e) y[d0][e] *= rs * gp[e]; }
    const int t = t0 + wid * QBLK + r32;
#pragma unroll
    for (int a = 0; a < 2; ++a) {
      const float* cp = rope + (size_t)((a ? (t & 63) : (t >> 6)) * 32 + hi * 8) * 2;
#pragma unroll
      for (int h1 = 0; h1 < 2; ++h1) {
        float c[8], sn[8];
#pragma unroll
        for (int e = 0; e < 8; ++e) { c[e] = cp[(h1 * 16 + e) * 2]; sn[e] = cp[(h1 * 16 + e) * 2 + 1]; }
        const int dA = a * 4 + h1, dB = dA + 2;
#pragma unroll
        for (int e = 0; e < 8; ++e) { const float xa = y[dA][e], xb = y[dB][e]; y[dA][e] = xa * c[e] - xb * sn[e]; y[dB][e] = xb * c[e] + xa * sn[e]; }
      } }
#pragma unroll
    for (int d0 = 0; d0 < 8; ++d0) { u32x4 w = {cvtpk(y[d0][0], y[d0][1]), cvtpk(y[d0][2], y[d0][3]), cvtpk(y[d0][4], y[d0][5]), cvtpk(y[d0][6], y[d0][7])}; qr[d0] = __builtin_bit_cast(bf16x8, w); }
  }
  const int sr = tid >> 4, sc = (tid & 15) * 8, vst0 = v_st(sr, sc), vst1 = v_st(32 + sr, sc);
  const int vb0 = (int)(uintptr_t)V_lds + v_rd_base(lane);
  struct { bf16x8 vs0, vs1, ks0, ks1; } sr_[1];
#define SLOAD(i, k0) do { sr_[i].vs0 = ld8(&Vh[(long)((k0) + sr) * LD + sc]); sr_[i].vs1 = ld8(&Vh[(long)((k0) + 32 + sr) * LD + sc]); \
    sr_[i].ks0 = ld8(&Kh[(long)((k0) + sr) * LD + sc]); sr_[i].ks1 = ld8(&Kh[(long)((k0) + 32 + sr) * LD + sc]); } while (0)
#define SWRITE(off, i) do { *(bf16x8*)((char*)V_lds + (off) + vst0) = sr_[i].vs0;          \
    *(bf16x8*)((char*)V_lds + (off) + vst1) = sr_[i].vs1; int kc = sc * 2;               \
    *(bf16x8*)((char*)K_lds + (off) + KSWZ(sr, kc)) = sr_[i].ks0;                       \
    *(bf16x8*)((char*)K_lds + (off) + KSWZ(32 + sr, kc)) = sr_[i].ks1; } while (0)
#define SWAIT() asm volatile("s_waitcnt vmcnt(0)" ::: "memory")
  f32x16 pA0, pA1, pB0, pB1; bf16x8 pa0, pa1, pa2, pa3; const int NT = seq / KVBLK;
  if (wid >= 4) __builtin_amdgcn_s_setprio(1);
  SLOAD(0, 0); SWAIT(); SWRITE(0, 0);
  SLOAD(0, KVBLK); SWAIT(); SWRITE((int)SHM_V, 0); __syncthreads();
  qkt(pA0, pA1, K_lds, qr, r32, hi); expHalf(pA0);
  int o0 = 0, o1 = (int)SHM_V, o2 = 2 * (int)SHM_V;
#define STEP(PC0, PC1, PN0, PN1, jj, DO_QKT, DO_LOAD) do { \
    SBAR(); if (DO_QKT) qkt(PN0, PN1, (bf16_t*)((char*)K_lds + o1), qr, r32, hi); \
    finishSM(PC0, PC1, l_reg, pa0, pa1, pa2, pa3); SBAR(); \
    if (DO_LOAD) SLOAD(0, ((jj) + 2) * KVBLK); SBAR(); \
    pv_d0(o, vb0 + o0, pa0, pa1, pa2, pa3); if (DO_QKT) expHalf(PN0); \
    if (DO_LOAD) { SWAIT(); SWRITE(o2, 0); } \
    __syncthreads(); \
    { const int t_ = o0; o0 = o1; o1 = o2; o2 = t_; } } while (0)
  int j = 0;
  for (; j + 3 < NT; j += 2) { STEP(pA0, pA1, pB0, pB1, j, true, true); STEP(pB0, pB1, pA0, pA1, j + 1, true, true); }
  STEP(pA0, pA1, pB0, pB1, j, true, false);
  STEP(pB0, pB1, pA0, pA1, j + 1, false, false);
#undef STEP
  __builtin_amdgcn_s_setprio(0);
  { auto rr = __builtin_amdgcn_permlane32_swap(__float_as_uint(l_reg), __float_as_uint(l_reg), false, false); l_reg = __uint_as_float(rr[0]) + __uint_as_float(rr[1]); }
  if (hi == 0) li_l[r32] = l_reg; asm volatile("s_waitcnt lgkmcnt(0)" ::: "memory");
  float rli[16];
#pragma unroll
  for (int r = 0; r < 16; ++r) rli[r] = __builtin_amdgcn_rcpf(li_l[crow(r, hi)]);
  char* stg = lds + SHM_OST + wid * OST_WAVE;
#pragma unroll
  for (int r = 0; r < 16; ++r) { const int orow = crow(r, hi);
#pragma unroll
    for (int d0 = 0; d0 < 4; ++d0) { const float v = o[d0][r] * rli[r]; const unsigned w = cvtpk(v, v); *(bf16_t*)(stg + orow * OST_STRIDE + (d0 * 32 + r32) * 2) = (bf16_t)(w & 0xffffu); } }
  asm volatile("s_waitcnt lgkmcnt(0)" ::: "memory");
  bf16_t* Ow = Ob + (long)(wid * QBLK) * LD;
#pragma unroll
  for (int i = 0; i < 8; ++i) { const int c = i * 64 + lane, row = c >> 4, ch = c & 15; const u32x4 v = *(const u32x4*)(stg + row * OST_STRIDE + ch * 16); *(u32x4*)(Ow + (long)row * LD + ch * 8) = v; }
  asm volatile("s_waitcnt lgkmcnt(0)" ::: "memory");
  __syncthreads();
#undef SLOAD
#undef SWRITE
#undef SWAIT
}
#undef KSWZ
#undef SBAR
}

constexpr size_t MiB = 1u << 20;
constexpr size_t WS_CTL = 0, CTL_ZERO_BYTES = 1 * MiB;
constexpr size_t WS_ROPE = 1 * MiB;
constexpr size_t WS_STATS = 2 * MiB;
constexpr size_t WS_W = 4 * MiB;
constexpr size_t W_IN_T = WS_W;
constexpr size_t W_AO_T = W_IN_T + (size_t)NIN * DM * 2;
constexpr size_t W_SO_T = W_AO_T + (size_t)DM * DM * 2;
constexpr size_t W_OUT_T = W_SO_T + (size_t)DM * DM * 2;
constexpr size_t W_XQ_B = W_OUT_T + (size_t)DM * DM * 2;
constexpr size_t W_XKV_T = W_XQ_B + (size_t)DM * DM * 2;
constexpr size_t W_XO_T = W_XKV_T + (size_t)2 * DM * DM * 2;
constexpr size_t W_UP_T = W_XO_T + (size_t)DM * DM * 2;
constexpr size_t W_DN_T = W_UP_T + (size_t)2 * DFF * DM * 2;
constexpr size_t W_SBLK = W_DN_T + (size_t)DM * DFF * 2;
constexpr size_t WS_WEND = W_SBLK + (size_t)8 * 256 * 256 * 2;
constexpr size_t WS_H = 172 * MiB;
constexpr size_t WS_MEMN = WS_H + (size_t)T * DM * 2;
constexpr size_t WS_KV = WS_MEMN + (size_t)MEMROWS * DM * 2;
constexpr size_t WS_QKT = WS_KV + (size_t)MEMROWS * 2 * DM * 2;
constexpr size_t WS_VWT = WS_QKT + (size_t)NB * 1024 * DM * 2;
constexpr size_t WS_P = WS_VWT + (size_t)NB * 1024 * DM * 2;
constexpr size_t WS_BIG = WS_P + (size_t)T * 1024 * 2;
constexpr size_t WS_END = WS_BIG + (size_t)T * NIN * 2;
static_assert(WS_WEND <= WS_H, "weights fit below H");
constexpr int CW_BAR = 4096;

constexpr int RING_OFF = 0, RING_BYTES = 131072;
constexpr int XCH_OFF = 131072;
constexpr int MISC_OFF = 139264;
constexpr int LDS_BYTES = 147456;
static_assert(attn::SHM_ATTN <= MISC_OFF, "attention LDS fits");

#define GAS __attribute__((address_space(1)))
#define LAS __attribute__((address_space(3)))
typedef unsigned short bf16;
typedef unsigned v4u __attribute__((ext_vector_type(4)));
typedef float f32x4 __attribute__((ext_vector_type(4)));
typedef float f32x2 __attribute__((ext_vector_type(2)));
typedef GAS unsigned gu32;
#define RLX_AGENT __ATOMIC_RELAXED, __HIP_MEMORY_SCOPE_AGENT
#define LDS_WAIT() asm volatile("s_waitcnt lgkmcnt(0)" ::: "memory")
#define VM_WAIT() asm volatile("s_waitcnt vmcnt(0)" ::: "memory")
__device__ __forceinline__ unsigned f2bf(float f) { unsigned u = __builtin_bit_cast(unsigned, f); return (u + 0x7fffu + ((u >> 16) & 1u)) >> 16; }
__device__ __forceinline__ unsigned pk2(float lo, float hi) { return f2bf(lo) | (f2bf(hi) << 16); }
__device__ __forceinline__ float blo(unsigned w) { return __uint_as_float(w << 16); }
__device__ __forceinline__ float bhi(unsigned w) { return __uint_as_float(w & 0xffff0000u); }

#define XB_TMO      128
#define XB_XCNT(j)  (256  + 64 * (j))
#define XB_XSUB(j)  (1280 + 64 * (j))
#define XB_XGEN(j)  (2304 + 64 * (j))
#define XB_TOP      3328
#define XB_TOPGEN   3392
#define XCD_BAR_WORDS 3456
#define XB_SPIN_CAP (1u << 18)
__device__ __forceinline__ unsigned xb_ld(unsigned* p)              { return __hip_atomic_load(p, __ATOMIC_RELAXED, __HIP_MEMORY_SCOPE_AGENT); }
__device__ __forceinline__ unsigned xb_add(unsigned* p, unsigned v) { return __hip_atomic_fetch_add(p, v, __ATOMIC_RELAXED, __HIP_MEMORY_SCOPE_AGENT); }
__device__ __forceinline__ unsigned xb_xcc_id() { return (unsigned)__builtin_amdgcn_s_getreg((3 << 11) | 20) & 0xFu; }
#define XB_SPIN(cond, bar) do { unsigned _sp = 0; while (cond) { __builtin_amdgcn_s_sleep(1); \
    if ((++_sp & 255u) == 0u) { if (xb_ld(&(bar)[XB_TMO])) break; if (_sp > XB_SPIN_CAP) { atomicAdd(&(bar)[XB_TMO], 1u); break; } } } } while (0)
struct XcdBarrier { unsigned* bar; unsigned x; volatile LAS unsigned* st; };
__device__ __forceinline__ XcdBarrier xcd_barrier_post(unsigned* bar, volatile LAS unsigned* st) {
    XcdBarrier b; b.bar = bar; b.x = xb_xcc_id(); b.st = st;
    if (threadIdx.x == 0) (void)xb_add(&bar[XB_XCNT(b.x)], 1u);
    return b;
}
__device__ __forceinline__ void xcd_barrier_complete(unsigned* bar, unsigned x, unsigned& nloc, unsigned& nx) {
    const unsigned G = gridDim.x * gridDim.y * gridDim.z;
    unsigned sum, cnt, mine, sp = 0u;
    for (;;) {
        sum = 0u; cnt = 0u; mine = 0u;
#pragma unroll
        for (unsigned j = 0; j < 16; ++j) { const unsigned c = xb_ld(&bar[XB_XCNT(j)]); sum += c; cnt += (c > 0u) ? 1u : 0u; mine = (j == x) ? c : mine; }
        if (sum == G) break;
        __builtin_amdgcn_s_sleep(1);
        if ((++sp & 255u) == 0u) { if (xb_ld(&bar[XB_TMO])) break; if (sp > XB_SPIN_CAP) { atomicAdd(&bar[XB_TMO], 1u); break; } }
    }
    nloc = mine > 0u ? mine : 1u; nx = cnt > 0u ? cnt : 1u;
}
__device__ __forceinline__ void xcd_barrier(const XcdBarrier& b, const int wave) {
    asm volatile("s_waitcnt vmcnt(0)" ::: "memory");
    __syncthreads();
    if (wave == 0 && pg8::lane_id_opq() == 0) {
        unsigned* bar = b.bar;
        __builtin_amdgcn_s_waitcnt(0);
        unsigned nloc = b.st[0], nx = b.st[1];
        if (nloc == 0u) { xcd_barrier_complete(bar, b.x, nloc, nx); b.st[0] = nloc; b.st[1] = nx; }
        const unsigned old = xb_add(&bar[XB_XSUB(b.x)], 1u);
        const unsigned gen = old / nloc;
        if (old + 1u == (gen + 1u) * nloc) {
            __builtin_amdgcn_fence(__ATOMIC_RELEASE, "agent");
            asm volatile("s_waitcnt vmcnt(0)" ::: "memory");
            const unsigned og = xb_add(&bar[XB_TOP], 1u);
            const unsigned tg = og / nx;
            if (og + 1u == (tg + 1u) * nx) xb_add(&bar[XB_TOPGEN], 1u);
            else XB_SPIN(xb_ld(&bar[XB_TOPGEN]) == tg, bar);
            __builtin_amdgcn_fence(__ATOMIC_ACQUIRE, "agent");
            xb_add(&bar[XB_XGEN(b.x)], 1u);
            asm volatile("s_waitcnt vmcnt(0)" ::: "memory");
        } else {
            XB_SPIN(xb_ld(&bar[XB_XGEN(b.x)]) == gen, bar);
            __builtin_amdgcn_fence(__ATOMIC_ACQUIRE, "agent");
            asm volatile("s_waitcnt vmcnt(0)" ::: "memory");
        }
    }
    __syncthreads();
}

__device__ __forceinline__ int opq(int v) { asm volatile("" : "+v"(v)); return v; }
__device__ __forceinline__ float wave_sum(float v, int lane) {
#pragma unroll
    for (int o = 1; o < 64; o <<= 1) v += pg8::shx(v, o, lane);
    return v;
}
__device__ __forceinline__ void transpose_item(const float* W, int N, bf16* WT, int ldt, int k0, int n0, long drow0, LAS float* scr, int lane, const float* gain = nullptr) {
    float wv[32];
#pragma unroll
    for (int i = 0; i < 32; ++i) { const int kk = 2 * i + (lane >> 5); wv[i] = __builtin_nontemporal_load(&W[(size_t)(k0 + kk) * N + n0 + (lane & 31)]); }
#pragma unroll
    for (int i = 0; i < 32; ++i) { const int kk = 2 * i + (lane >> 5); float w = wv[i]; if (gain) w *= gain[k0 + kk]; scr[kk * 33 + (lane & 31)] = w; }
    LDS_WAIT(); asm volatile("" ::: "memory");
    const int c = lane & 7;
#pragma unroll
    for (int j = 0; j < 4; ++j) { const int n = (lane >> 3) + 8 * j; const LAS float* s = scr + (8 * c) * 33 + n;
        v4u o; o.x = pk2(s[0 * 33], s[1 * 33]); o.y = pk2(s[2 * 33], s[3 * 33]); o.z = pk2(s[4 * 33], s[5 * 33]); o.w = pk2(s[6 * 33], s[7 * 33]);
        *(GAS v4u*)(WT + (size_t)(drow0 + n) * ldt + k0 + 8 * c) = o; }
    LDS_WAIT(); asm volatile("" ::: "memory");
}
__device__ __forceinline__ void rms_row_to_bf16(const float* xrow, const float* gain, bf16* orow, float* xcopy, int lane) {
    const GAS f32x4* xr = (const GAS f32x4*)xrow + lane;
    f32x4 v[8]; float s = 0.f;
#pragma unroll
    for (int j = 0; j < 8; ++j) { v[j] = xr[64 * j]; s += (v[j].x * v[j].x + v[j].y * v[j].y) + (v[j].z * v[j].z + v[j].w * v[j].w); }
    if (xcopy) { GAS f32x4* xc = (GAS f32x4*)xcopy + lane;
#pragma unroll
        for (int j = 0; j < 8; ++j) xc[64 * j] = v[j]; }
    const float rs = 1.0f / sqrtf(wave_sum(s, lane) * (1.f / DM) + EPS);
    const GAS f32x4* gr = (const GAS f32x4*)gain + lane;
    GAS unsigned long long* o8 = (GAS unsigned long long*)orow + lane;
#pragma unroll
    for (int j = 0; j < 8; ++j) { const f32x4 g = gr[64 * j];
        o8[64 * j] = (unsigned long long)pk2(v[j].x * rs * g.x, v[j].y * rs * g.y) | ((unsigned long long)pk2(v[j].z * rs * g.z, v[j].w * rs * g.w) << 32); }
}

__device__ __forceinline__ void x_row_init2(const float* xrow, bf16* orow, float* st, float* rsf, int lane) {
    f32x4 v[2][8];
#pragma unroll
    for (int r = 0; r < 2; ++r)
#pragma unroll
        for (int j = 0; j < 8; ++j) v[r][j] = ((const GAS f32x4*)(xrow + (size_t)r * DM) + lane)[64 * j];
#pragma unroll
    for (int r = 0; r < 2; ++r) {
        GAS unsigned long long* o8 = (GAS unsigned long long*)(orow + (size_t)r * DM) + lane;
        float s = 0.f;
#pragma unroll
        for (int j = 0; j < 8; ++j) { const f32x4 w = v[r][j]; s += (w.x * w.x + w.y * w.y) + (w.z * w.z + w.w * w.w);
            o8[64 * j] = (unsigned long long)pk2(w.x, w.y) | ((unsigned long long)pk2(w.z, w.w) << 32); }
        s = wave_sum(s, lane);
        if (lane < 8) st[r * 8 + lane] = lane == 0 ? s : 0.f;
        if (lane == 0) rsf[r] = 1.0f / sqrtf(s * (1.f / DM) + EPS);
    }
}

struct Args { const float* in[26]; float* out; unsigned char* ws; };
static_assert(sizeof(Args) == 28 * 8, "no padding in Args");

__global__ void __launch_bounds__(512, 2) fwd_kernel(Args args) {
    extern __shared__ __attribute__((aligned(16))) unsigned char lds[];
    LAS unsigned char* L = (LAS unsigned char*)lds;
    volatile LAS unsigned* MISC = (volatile LAS unsigned*)(L + MISC_OFF);
    const int tid = threadIdx.x, wave = __builtin_amdgcn_readfirstlane(tid >> 6);
#define lane0 (pg8::lane_id_opq())
    const int G = gridDim.x, bx = blockIdx.x;
    const int vcu = (G % 8 == 0) ? (bx % 8) * (G / 8) + bx / 8 : bx;
    const int gw = vcu * 8 + wave, NGW = G * 8;
    for (int u = tid; u < 64; u += 512) ((LAS unsigned*)(L + MISC_OFF))[u] = 0u;
    __syncthreads();
    XcdBarrier bar = xcd_barrier_post((unsigned*)(args.ws + WS_CTL) + CW_BAR, MISC + 8);
#define GRID_BAR() xcd_barrier(bar, wave)
    LAS unsigned char* const RING = L + RING_OFF;
    LAS unsigned char* const XCH = L + XCH_OFF;
typedef const Args __attribute__((address_space(4))) CArgs;
constexpr int I_IN = (DM / 64) * (NIN / 32), I_SQ = (DM / 64) * (DM / 32), I_KV = (DM / 64) * (2 * DM / 32), I_UP = (DM / 64) * (2 * DFF / 32), I_DN = (DFF / 64) * (DM / 32);
constexpr int NITEMS = I_IN + 4 * I_SQ + I_KV + I_UP + I_DN, I_EARLY7 = I_IN, I_EARLYU = I_IN + 4 * I_SQ + I_KV;
#define CONV_ITEMS(LL, IT_LO, IT_HI, W0, NW) do { \
    const float* w_in = ka->in[5] + (size_t)(LL) * DM * NIN; const float* w_ao = ka->in[8] + (size_t)(LL) * DM * DM; const float* w_so = ka->in[13] + (size_t)(LL) * DM * DM; \
    const float* w_out = ka->in[14] + (size_t)(LL) * DM * DM; const float* w_xkv = ka->in[18] + (size_t)(LL) * DM * 2 * DM; const float* w_xo = ka->in[19] + (size_t)(LL) * DM * DM; \
    const float* w_up = ka->in[21] + (size_t)(LL) * DM * 2 * DFF; const float* w_dn = ka->in[24] + (size_t)(LL) * DFF * DM; const float* gmix = ka->in[4] + (size_t)(LL) * DM; const float* gffn = ka->in[20] + (size_t)(LL) * DM; \
    for (int it = (IT_LO) + (W0); it < (IT_HI); it += (NW)) { \
                int r = it; \
                if (r < I_IN) { const int nb = NIN / 32; const int n0 = 32 * (r % nb); long d0 = n0; \
                    if (n0 >= C_GA) { const int iss = n0 >= C_GS, ch = n0 - (iss ? C_GS : C_GA); d0 = C_GA + (long)(ch / 128) * 256 + iss * 128 + (ch % 128); } \
                    transpose_item(w_in, NIN, (bf16*)(ws + W_IN_T), DM, 64 * (r / nb), n0, d0, scr, lane, gmix); continue; } r -= I_IN; \
                if (r < I_SQ) { const int nb = DM / 32; transpose_item(w_ao, DM, (bf16*)(ws + W_AO_T), DM, 64 * (r / nb), 32 * (r % nb), 32 * (r % nb), scr, lane); continue; } r -= I_SQ; \
                if (r < I_SQ) { const int nb = DM / 32; transpose_item(w_so, DM, (bf16*)(ws + W_SO_T), DM, 64 * (r / nb), 32 * (r % nb), 32 * (r % nb), scr, lane); continue; } r -= I_SQ; \
                if (r < I_SQ) { const int nb = DM / 32; transpose_item(w_out, DM, (bf16*)(ws + W_OUT_T), DM, 64 * (r / nb), 32 * (r % nb), 32 * (r % nb), scr, lane); continue; } r -= I_SQ; \
                if (r < I_SQ) { const int nb = DM / 32; transpose_item(w_xo, DM, (bf16*)(ws + W_XO_T), DM, 64 * (r / nb), 32 * (r % nb), 32 * (r % nb), scr, lane); continue; } r -= I_SQ; \
                if (r < I_KV) { const int nb = 2 * DM / 32; transpose_item(w_xkv, 2 * DM, (bf16*)(ws + W_XKV_T), DM, 64 * (r / nb), 32 * (r % nb), 32 * (r % nb), scr, lane); continue; } r -= I_KV; \
                if (r < I_UP) { const int nb = 2 * DFF / 32; const int n0 = 32 * (r % nb); const int isb = n0 >= DFF, ch = n0 - isb * DFF; \
                    transpose_item(w_up, 2 * DFF, (bf16*)(ws + W_UP_T), DM, 64 * (r / nb), n0, (long)(ch / 128) * 256 + isb * 128 + (ch % 128), scr, lane, gffn); continue; } r -= I_UP; \
                { const int nb = DM / 32; transpose_item(w_dn, DM, (bf16*)(ws + W_DN_T), DFF, 64 * (r / nb), 32 * (r % nb), 32 * (r % nb), scr, lane); } \
            } \
    } while (0)
#define PHASE_ENV \
    CArgs* ka = (CArgs*)__builtin_amdgcn_kernarg_segment_ptr(); asm volatile("" : "+s"(ka)); \
    int G_o = (int)gridDim.x; asm volatile("" : "+s"(G_o)); const int G = G_o, NGW = G_o * 8; (void)G; (void)NGW; \
    unsigned char* const ws = ka->ws; float* const X = ka->out; \
    bf16* const Hb = (bf16*)(ws + WS_H); bf16* const MEMN = (bf16*)(ws + WS_MEMN); bf16* const KV = (bf16*)(ws + WS_KV); bf16* const QKT = (bf16*)(ws + WS_QKT); \
    bf16* const VWT = (bf16*)(ws + WS_VWT); bf16* const Pb = (bf16*)(ws + WS_P); bf16* const BIG = (bf16*)(ws + WS_BIG); f32x2* const ROPE = (f32x2*)(ws + WS_ROPE); \
    float* const STATS = (float*)(ws + WS_STATS); float* const RSF0 = (float*)(ws + WS_STATS + 3 * MiB / 2); float* const RSF2 = RSF0 + T; bf16* const VLT = (bf16*)ka->out; float* const LNST = (float*)((char*)ka->out + (size_t)200 * MiB);   \
    (void)X; (void)Hb; (void)MEMN; (void)KV; (void)QKT; (void)VWT; (void)Pb; (void)BIG; (void)ROPE; (void)STATS; (void)RSF0; (void)RSF2; (void)VLT; (void)LNST

    for (int l = 0; l < DEPTH; ++l) {
#if PH(0)
        { PHASE_ENV;
        {
            const int lane = opq(lane0);
            LAS float* scr = (LAS float*)(RING + wave * 16384);
            const float* w_in = ka->in[5] + (size_t)l * DM * NIN;
            const float* w_ao = ka->in[8] + (size_t)l * DM * DM;
            const float* w_so = ka->in[13] + (size_t)l * DM * DM;
            const float* w_out = ka->in[14] + (size_t)l * DM * DM;
            const float* w_xq = ka->in[17] + (size_t)l * DM * DM;
            const float* w_xkv = ka->in[18] + (size_t)l * DM * 2 * DM;
            const float* w_xo = ka->in[19] + (size_t)l * DM * DM;
            const float* w_up = ka->in[21] + (size_t)l * DM * 2 * DFF;
            const float* w_dn = ka->in[24] + (size_t)l * DFF * DM;
            const float* gmix = ka->in[4] + (size_t)l * DM; const float* gffn = ka->in[20] + (size_t)l * DM; const float* gxn = ka->in[15] + (size_t)l * DM;
            { const int b7 = (NB * 8 * 4) % G, bu = ((T / 256) * (2 * DFF / 256)) % G;
              const int lo = l == 0 ? 0 : (bu > 0 ? I_EARLYU : (b7 > 0 ? I_EARLY7 : 0));
              CONV_ITEMS(l, lo, NITEMS, gw, NGW); }
            { const size_t n8 = (size_t)DM * DM / 8; bf16* dst = (bf16*)(ws + W_XQ_B);
              for (size_t i = (size_t)gw * 64 + lane; i < n8; i += (size_t)NGW * 64) { const float gd = gxn[i >> 8]; const f32x4 a = *(const f32x4*)(w_xq + i * 8) * gd, b = *(const f32x4*)(w_xq + i * 8 + 4) * gd;
                  v4u o; o.x = pk2(a.x, a.y); o.y = pk2(a.z, a.w); o.z = pk2(b.x, b.y); o.w = pk2(b.z, b.w); *(v4u*)(dst + i * 8) = o; } }
            { const float* wsp = ka->in[11] + (size_t)l * 8 * 128 * 128; bf16* dst = (bf16*)(ws + W_SBLK); const size_t n8 = (size_t)8 * 256 * 256 / 8;
              for (size_t i = (size_t)gw * 64 + lane; i < n8; i += (size_t)NGW * 64) { const int e = (int)(i * 8), g = e >> 16, pp = (e >> 8) & 255, qq = e & 255;
                  v4u o = (v4u){0u, 0u, 0u, 0u};
                  if ((pp >> 7) == (qq >> 7)) { const float* s = wsp + ((size_t)g * 128 + (pp & 127)) * 128 + (qq & 127); const f32x4 a = *(const f32x4*)s, b = *(const f32x4*)(s + 4);
                      o.x = pk2(a.x, a.y); o.y = pk2(a.z, a.w); o.z = pk2(b.x, b.y); o.w = pk2(b.z, b.w); }
                  *(v4u*)(dst + i * 8) = o; } }
            if (l == 0) for (int m = gw * 2; m < T; m += NGW * 2) {
                const float* src = m < 4 * SEQ ? ka->in[0] + (size_t)m * DM : ka->in[1] + (size_t)(m - 4 * SEQ) * DM;
                x_row_init2(src, Hb + (size_t)m * DM, STATS + (size_t)m * 8, RSF0 + m, lane);
            }
            else for (int i = gw * 64 + lane; i < T; i += NGW * 64) {
                const f32x4 a = *(const f32x4*)(STATS + (size_t)i * 8), b = *(const f32x4*)(STATS + (size_t)i * 8 + 4);
                RSF0[i] = 1.0f / sqrtf(((a[0] + a[1]) + (a[2] + a[3]) + (b[0] + b[1]) + (b[2] + b[3])) * (1.f / DM) + EPS); }
            const float* gmem = ka->in[16] + (size_t)l * DM;
            for (int m = gw; m < MEMROWS; m += NGW) {
                const float* src = m < 4 * NMEM ? ka->in[2] + (size_t)m * DM : ka->in[3] + (size_t)(m - 4 * NMEM) * DM;
                rms_row_to_bf16(src, gmem, MEMN + (size_t)m * DM, nullptr, lane);
            }
            if (l == 0 && bx == 0 && wave == 0 && lane < 32) {
                double inv = 1.0; for (int j = 0; j < lane; ++j) inv *= 0.74989420933245582;
                const double t2 = inv * inv; double c1 = 1.0, s1 = inv, tc = 1.0, tsn = inv;
                for (int k = 1; k < 14; ++k) { tc *= -t2 / (double)((2 * k - 1) * (2 * k)); c1 += tc; tsn *= -t2 / (double)((2 * k) * (2 * k + 1)); s1 += tsn; }
                double c = 1.0, s = 0.0;
                for (int pos = 0; pos < 64; ++pos) { ROPE[pos * 32 + lane] = (f32x2){(float)c, (float)s}; const double cn = c * c1 - s * s1, sn = s * c1 + c * s1; c = cn; s = sn; }
            }
        }
        }
#endif
        GRID_BAR();
#if PH(1)
        { PHASE_ENV;
        {
            pg8::Gemm g{MEMN, (const bf16*)(ws + W_XKV_T), DM, DM, DM, 0, 0, 0, 0}; pg8::Sched S; S.init(1, 1, MEMROWS / 256, 2 * DM / 256, G, G - 1 - bx);
            pg8::EpiBf16<0> E{KV, 2 * DM, 0, 0, nullptr, nullptr};
            pg8::gemm_phase(RING, XCH, g, S, E, wave);
        }
        {
            pg8::Gemm g{Hb, (const bf16*)(ws + W_IN_T), DM, DM, DM, 0, 0, 0, 0}; pg8::Sched S; S.init(1, 1, T / 256, 28, G, bx, 1);
            pg8::EpiBf16<1, true> E{BIG, NIN, 0, 0, RSF0, LNST};
            pg8::gemm_phase(RING, XCH, g, S, E, wave);
        }
        }
#endif
        GRID_BAR();
#if PH(2)
        { PHASE_ENV;
        {
            const int lane = opq(lane0);
            const float* qg = ka->in[6] + (size_t)l * 128; const float* kg = ka->in[7] + (size_t)l * 128;
            const int hh = lane >> 4, li = lane & 15;
            const int a_ = li >> 3, p_ = (li >> 2) & 1, j0 = (li & 3) * 8;
            for (int row0 = gw * 4; row0 < T; row0 += NGW * 4) {
                bf16* p0 = BIG + (size_t)row0 * NIN + C_K + hh * 128 + li * 8;
                v4u wq[4];
#pragma unroll
                for (int rr = 0; rr < 4; ++rr) wq[rr] = *(const v4u*)(p0 + (size_t)rr * NIN);
#pragma unroll
                for (int rr = 0; rr < 4; ++rr) {
                    const int t = (row0 + rr) & (SEQ - 1), pos = a_ ? (t & 63) : (t >> 6);
                    const v4u w = wq[rr];
                    float y[8] = {blo(w.x), bhi(w.x), blo(w.y), bhi(w.y), blo(w.z), bhi(w.z), blo(w.w), bhi(w.w)};
                    float s = 0.f;
#pragma unroll
                    for (int e = 0; e < 8; ++e) s += y[e] * y[e];
                    s += pg8::shx(s, 1, lane); s += pg8::shx(s, 2, lane); s += pg8::shx(s, 4, lane); s += pg8::shx(s, 8, lane);
                    const float rs = 1.0f / sqrtf(s * (1.f / 128.f) + EPS);
                    const float* gv = kg + li * 8;
                    float o[8];
#pragma unroll
                    for (int e = 0; e < 8; ++e) y[e] = y[e] * rs * gv[e];
#pragma unroll
                    for (int e = 0; e < 8; ++e) { const float yp = pg8::shx(y[e], 4, lane); const f32x2 cs = ROPE[pos * 32 + j0 + e]; o[e] = y[e] * cs.x + (p_ ? yp : -yp) * cs.y; }
                    v4u ow; ow.x = pk2(o[0], o[1]); ow.y = pk2(o[2], o[3]); ow.z = pk2(o[4], o[5]); ow.w = pk2(o[6], o[7]);
                    *(v4u*)(p0 + (size_t)rr * NIN) = ow;
                }
            }
            const float* lng = ka->in[9] + (size_t)l * DM; const float* lnb = ka->in[10] + (size_t)l * DM;
            for (int it = vcu; it < (T / 64) * 2; it += G) {
                const int blk = it >> 1, half = it & 1, t0 = blk * 64 + wave * 8;
                float my_mu = 0.f, my_rs = 0.f;
                {
                    const int r = lane & 7;
                    const float* q = LNST + (size_t)(t0 + r) * 16;
                    const f32x4 a = *(const f32x4*)q, b = *(const f32x4*)(q + 4), c = *(const f32x4*)(q + 8), d = *(const f32x4*)(q + 12);
                    const float s = ((a[0] + a[2]) + (b[0] + b[2])) + ((c[0] + c[2]) + (d[0] + d[2])), s2 = ((a[1] + a[3]) + (b[1] + b[3])) + ((c[1] + c[3]) + (d[1] + d[3]));
                    const float mu = s * (1.f / DM); float var = s2 * (1.f / DM) - mu * mu; var = var < 0.f ? 0.f : var;
                    my_mu = mu; my_rs = 1.0f / sqrtf(var + EPS);
                }
                const int z1 = t0 >> 8, tt = t0 & 255;
#pragma unroll
                for (int q = 0; q < 2; ++q) {
                    const int c0 = half * 1024 + q * 512 + lane * 8;
                    float gch[8], bch[8];
#pragma unroll
                    for (int e = 0; e < 8; ++e) { gch[e] = lng[c0 + e]; bch[e] = lnb[c0 + e]; }
                    unsigned ow[8][4];
                    v4u wr8[8];
#pragma unroll
                    for (int r = 0; r < 8; ++r) wr8[r] = *(const v4u*)(BIG + (size_t)(t0 + r) * NIN + C_VS + c0);
#pragma unroll
                    for (int rp2 = 0; rp2 < 4; ++rp2) {
                        const v4u wa = wr8[2 * rp2], wb = wr8[2 * rp2 + 1];
                        const float mua = __int_as_float(__builtin_amdgcn_readlane(__float_as_int(my_mu), 2 * rp2)), rsa = __int_as_float(__builtin_amdgcn_readlane(__float_as_int(my_rs), 2 * rp2)), mub = __int_as_float(__builtin_amdgcn_readlane(__float_as_int(my_mu), 2 * rp2 + 1)), rsb = __int_as_float(__builtin_amdgcn_readlane(__float_as_int(my_rs), 2 * rp2 + 1));
                        const float fa[8] = {blo(wa.x), bhi(wa.x), blo(wa.y), bhi(wa.y), blo(wa.z), bhi(wa.z), blo(wa.w), bhi(wa.w)};
                        const float fb[8] = {blo(wb.x), bhi(wb.x), blo(wb.y), bhi(wb.y), blo(wb.z), bhi(wb.z), blo(wb.w), bhi(wb.w)};
#pragma unroll
                        for (int e = 0; e < 8; ++e) ow[e][rp2] = pg8::cvt_pk_bf16((fa[e] - mua) * rsa * gch[e] + bch[e], (fb[e] - mub) * rsb * gch[e] + bch[e]);
                    }
#pragma unroll
                    for (int e = 0; e < 8; ++e) { v4u o; o.x = ow[e][0]; o.y = ow[e][1]; o.z = ow[e][2]; o.w = ow[e][3];
                        *(LAS v4u*)(RING + (q * 512 + lane * 8 + e) * 128 + ((wave ^ (lane & 7)) << 4)) = o; }
                }
                __syncthreads();
                {
                    const int p8 = lane & 7, chl = lane >> 3;
                    bf16* dst = VLT + ((size_t)(blk >> 2) * DM + half * 1024 + wave * 128 + chl) * 256 + (blk & 3) * 64 + p8 * 8;
                    v4u rr[16];
#pragma unroll
                    for (int i = 0; i < 16; ++i) { const int ch = wave * 128 + i * 8 + chl; rr[i] = *(const LAS v4u*)(RING + ch * 128 + ((p8 ^ ((ch >> 3) & 7)) << 4)); }
#pragma unroll
                    for (int i = 0; i < 16; ++i) *(v4u*)(dst + (size_t)i * 8 * 256) = rr[i];
                }
                __syncthreads();
            }
        }
        {
            pg8::Gemm g{KV, (const bf16*)(ws + W_XQ_B), 2 * DM, DM, 512, (long)NMEM * 2 * DM, 512, 0, 512}; pg8::Sched S; S.init(NB * 4, 4, 1, 8, G, bx);
            pg8::EpiBf16<0> E{QKT, DM, (long)1024 * DM, (long)256 * DM, nullptr, nullptr};
            pg8::gemm_phase(RING, XCH, g, S, E, wave);
        }
        {
            pg8::Gemm g{(const bf16*)(ws + W_XO_T), KV + DM, DM, 2 * DM, 512, 0, 512, (long)NMEM * 2 * DM, 512}; pg8::Sched S; S.init(NB * 4, 4, 8, 1, G, G - 1 - bx);
            pg8::EpiBf16<0> E{VWT, 1024, (long)DM * 1024, 256, nullptr, nullptr};
            pg8::gemm_phase(RING, XCH, g, S, E, wave);
        }
        }
#endif
        GRID_BAR();
#if PH(3)
        { PHASE_ENV;
        {
            for (int i = 0; ; ++i) {
                const int U = i * G + vcu; if (U >= NB * 128) break;
                const int qb = U & 7, hq = ((U >> 5) & 3) * 4 + ((U >> 3) & 3), kvh = (U >> 5) & 3, b = U >> 7;
                const bf16* Qb = BIG + (size_t)(b * SEQ + qb * 256) * NIN + C_Q + hq * 128;
                const bf16* Kh = BIG + (size_t)(b * SEQ) * NIN + C_K + kvh * 128;
                const bf16* Vh = BIG + (size_t)(b * SEQ) * NIN + C_V + kvh * 128;
                attn::attn_dense_body(Qb, Kh, Vh, (bf16*)Qb, SEQ, (char*)lds, wave, ka->in[6] + (size_t)l * 128, (const float*)ROPE, qb * 256);
            }
        }
        {
            pg8::Gemm g{(const bf16*)(ws + W_SBLK), VLT, 256, 256, 256, 0, (long)256 * 256, (long)DM * 256, (long)256 * 256}; pg8::Sched S; S.init(T / 256 * 8, 8, 1, 1, G, bx);
            pg8::EpiSpatial E{BIG + C_U, NIN, ka->in[12] + (size_t)l * 8 * 128};
            pg8::gemm_phase(RING, XCH, g, S, E, wave);
        }
        {
            pg8::Gemm g{Hb, (const bf16*)(ws + W_IN_T) + (size_t)28 * 256 * DM, DM, DM, DM, 0, 0, 0, 0}; pg8::Sched S; S.init(1, 1, T / 256, 16, G, bx);
            pg8::EpiBf16<1, true> E{BIG, NIN, 0, 0, RSF0, LNST, 28};
            pg8::gemm_phase(RING, XCH, g, S, E, wave);
        }
        }
#endif
        GRID_BAR();
#if PH(4)
        { PHASE_ENV;
        {
            pg8::Gemm g{BIG + C_Q, (const bf16*)(ws + W_AO_T), NIN, DM, 2 * DM, 0, 0, 0, 0, (long)(C_U - C_Q - DM) * 2, (long)W_SO_T - (long)W_AO_T - (long)DM * 2, DM / 64};
            pg8::Sched S; S.init(1, 1, T / 256, DM / 256, G, bx, 1);
            pg8::EpiMixF E{BIG + C_GA, BIG + C_GS, BIG + C_VS, NIN};
            pg8::gemm_phase(RING, XCH, g, S, E, wave);
        }
        }
#endif
        GRID_BAR();
#if PH(5)
        { PHASE_ENV;
        {
            pg8::Gemm g{BIG + C_VS, (const bf16*)(ws + W_OUT_T), NIN, DM, DM, 0, 0, 0, 0}; pg8::Sched S; S.init(1, 1, T / 256, DM / 256, G, bx);
            pg8::EpiRes E{Hb, DM, 0, STATS, 0};
            pg8::gemm_phase(RING, XCH, g, S, E, wave);
        }
        }
#endif
        GRID_BAR();
#if PH(7)
        { PHASE_ENV;
        {
            pg8::Gemm g{Hb, QKT, DM, DM, DM, (long)SEQ * DM, 0, (long)1024 * DM, 0}; pg8::Sched S; S.init(NB, 1, 8, 4, G, bx, 1);
            pg8::EpiSoftmax E{Pb, 1024, (long)SEQ * 1024, 0.044194173824159216f * 1.4426950408889634f, STATS, SEQ};
            pg8::gemm_phase(RING, XCH, g, S, E, wave);
        }
        { const int b7 = (NB * 8 * 4) % G;
          if (l + 1 < DEPTH && b7 > 0 && bx >= b7) { const int lane = opq(lane0); LAS float* scr = (LAS float*)(RING + wave * 16384);
              CONV_ITEMS(l + 1, 0, I_EARLY7, (bx - b7) * 8 + wave, (G - b7) * 8); } }
        }
#endif
        GRID_BAR();
#if PH(8)
        { PHASE_ENV;
        {
            pg8::Gemm g{Pb, VWT, 1024, 1024, 1024, (long)SEQ * 1024, 0, (long)DM * 1024, 0}; pg8::Sched S; S.init(NB, 1, 8, 8, G, bx);
            pg8::EpiRes E{Hb, DM, (long)SEQ * DM, STATS, SEQ};
            pg8::gemm_phase(RING, XCH, g, S, E, wave);
        }
        }
#endif
        GRID_BAR();
#if PH(10)
        { PHASE_ENV; const int lane = opq(lane0);
          for (int i = gw * 64 + lane; i < T; i += NGW * 64) { const f32x4 a = *(const f32x4*)(STATS + (size_t)i * 8), b = *(const f32x4*)(STATS + (size_t)i * 8 + 4);
              RSF2[i] = 1.0f / sqrtf(((a[0] + a[1]) + (a[2] + a[3]) + (b[0] + b[1]) + (b[2] + b[3])) * (1.f / DM) + EPS); } }
        GRID_BAR();
#define FFN_ENV PHASE_ENV; bf16* const ACT = BIG + (size_t)T * DFF;   float* const EA = (float*)BIG;   float* const EB = EA + (size_t)(T / 256) * 4 * DFF;   (void)ACT; (void)EA; (void)EB
        { FFN_ENV;
            pg8::Gemm g{Hb, (const bf16*)(ws + W_UP_T), DM, DM, DM, 0, 0, 0, 0}; pg8::Sched S; S.init(1, 1, T / 256, 2 * DFF / 256, G, bx, 1);
            pg8::EpiUp E{ACT, DFF, RSF2, ka->in[22] + (size_t)l * 3 * DFF, ka->in[23] + (size_t)l * DFF, EA, EB};
            pg8::gemm_phase(RING, XCH, g, S, E, wave);
            { const int bu = ((T / 256) * (2 * DFF / 256)) % G, b7 = (NB * 8 * 4) % G;
              if (l + 1 < DEPTH && bu > 0 && bx >= bu) { const int lane = opq(lane0); LAS float* scr = (LAS float*)(RING + wave * 16384);
                  CONV_ITEMS(l + 1, b7 > 0 ? I_EARLY7 : 0, I_EARLYU, (bx - bu) * 8 + wave, (G - bu) * 8); } }
        }
        GRID_BAR();
        { FFN_ENV; const int lane = opq(lane0);
            const float* cw = ka->in[22] + (size_t)l * 3 * DFF; const float* cb = ka->in[23] + (size_t)l * DFF;
            constexpr int NC8 = DFF / 8, NIT = (T / 256) * 2 * NC8;
            for (int it = gw * 64 + lane; it < NIT; it += NGW * 64) {
                const int c8 = it % NC8, tw = it / NC8, pm = tw >> 1, bot = tw & 1, c0 = c8 * 8;
                const float* ac = EA + ((size_t)pm * 4 + (bot ? 3 : 0)) * DFF + c0;
                const float* ap = bot ? EA + ((size_t)pm * 4 + 2) * DFF + c0 : EA + ((size_t)(pm - 1) * 4 + 3) * DFF + c0;
                const float* an = bot ? EA + ((size_t)(pm + 1) * 4 + 0) * DFF + c0 : EA + ((size_t)pm * 4 + 1) * DFF + c0;
                const bool pz = !bot && (pm & 7) == 0, nz = bot && (pm & 7) == 7;
                const float* bp = EB + ((size_t)pm * 2 + bot) * DFF + c0;
                float o[8];
#pragma unroll
                for (int h = 0; h < 2; ++h) {
                    const f32x4 z = (f32x4){0.f, 0.f, 0.f, 0.f};
                    const f32x4 vc = *(const f32x4*)(ac + 4 * h), vp = pz ? z : *(const f32x4*)((pz ? ac : ap) + 4 * h), vn = nz ? z : *(const f32x4*)((nz ? ac : an) + 4 * h), vb = *(const f32x4*)(bp + 4 * h);
                    const f32x4 w0 = *(const f32x4*)(cw + c0 + 4 * h), w1 = *(const f32x4*)(cw + DFF + c0 + 4 * h), w2 = *(const f32x4*)(cw + 2 * DFF + c0 + 4 * h), bb = *(const f32x4*)(cb + c0 + 4 * h);
#pragma unroll
                    for (int e = 0; e < 4; ++e) o[4 * h + e] = pg8::gelu_t(bb[e] + w0[e] * vp[e] + w1[e] * vc[e] + w2[e] * vn[e]) * vb[e]; }
                v4u ow; ow.x = pk2(o[0], o[1]); ow.y = pk2(o[2], o[3]); ow.z = pk2(o[4], o[5]); ow.w = pk2(o[6], o[7]);
                *(v4u*)(ACT + (size_t)(pm * 256 + (bot ? 255 : 0)) * DFF + c0) = ow;
            }
        }
        GRID_BAR();
        { FFN_ENV;
            pg8::Gemm g{ACT, (const bf16*)(ws + W_DN_T), DFF, DFF, DFF, 0, 0, 0, 0}; pg8::Sched S; S.init(1, 1, T / 256, DM / 256, G, bx);
            pg8::EpiRes E{Hb, DM, 0, STATS, 0};
            pg8::gemm_phase(RING, XCH, g, S, E, wave);
        }
        GRID_BAR();
#endif
    }
    { PHASE_ENV;
        const int lane = opq(lane0);
        const float* gfin = ka->in[25];
        for (int m0 = T - 4 - gw * 4; m0 >= 0; m0 -= NGW * 4) {
            v4u wq[4][4];
#pragma unroll
            for (int r = 0; r < 4; ++r)
#pragma unroll
                for (int j = 0; j < 4; ++j) wq[r][j] = ((const v4u*)(Hb + (size_t)(m0 + r) * DM) + lane)[64 * j];
#pragma unroll
            for (int r = 0; r < 4; ++r) {
                float v[4][8]; float s = 0.f;
#pragma unroll
                for (int j = 0; j < 4; ++j) { const v4u w = wq[r][j]; v[j][0] = blo(w.x); v[j][1] = bhi(w.x); v[j][2] = blo(w.y); v[j][3] = bhi(w.y); v[j][4] = blo(w.z); v[j][5] = bhi(w.z); v[j][6] = blo(w.w); v[j][7] = bhi(w.w);
#pragma unroll
                    for (int e = 0; e < 8; ++e) s += v[j][e] * v[j][e]; }
                const float rs = 1.0f / sqrtf(wave_sum(s, lane) * (1.f / DM) + EPS);
#pragma unroll
                for (int j = 0; j < 4; ++j) { const float* gp = gfin + j * 512 + lane * 8; float* op = X + (size_t)(m0 + r) * DM + j * 512 + lane * 8;
                    const f32x4 g0 = *(const f32x4*)gp, g1 = *(const f32x4*)(gp + 4);
                    *(f32x4*)op = (f32x4){v[j][0] * rs * g0.x, v[j][1] * rs * g0.y, v[j][2] * rs * g0.z, v[j][3] * rs * g0.w};
                    *(f32x4*)(op + 4) = (f32x4){v[j][4] * rs * g1.x, v[j][5] * rs * g1.y, v[j][6] * rs * g1.z, v[j][7] * rs * g1.w}; }
            }
        }
    }
}

extern "C" void kernel_launch(void* const* d_in, const int* in_sizes, int n_in, void* d_out, int out_size, void* d_ws, size_t ws_size, hipStream_t stream) {
    static int grid = 0;
    if (grid == 0) {
        if (n_in != 26 || out_size != T * DM || ws_size < WS_END) { fprintf(stderr, "kernel_launch: shape/workspace mismatch: n_in %d out %d ws %zu (need %zu)\n", n_in, out_size, ws_size, (size_t)WS_END); grid = -1; return; }
        int dev = 0, cus = 0, per_cu = 0;
        if (hipGetDevice(&dev) != hipSuccess || hipDeviceGetAttribute(&cus, hipDeviceAttributeMultiprocessorCount, dev) != hipSuccess) { grid = -1; return; }
        if (hipFuncSetAttribute((const void*)fwd_kernel, hipFuncAttributeMaxDynamicSharedMemorySize, LDS_BYTES) != hipSuccess) { fprintf(stderr, "kernel_launch: hipFuncSetAttribute failed\n"); grid = -1; return; }
        if (hipOccupancyMaxActiveBlocksPerMultiprocessor(&per_cu, (const void*)fwd_kernel, 512, LDS_BYTES) != hipSuccess || per_cu < 1) { fprintf(stderr, "kernel_launch: occupancy query says %d\n", per_cu); }
        (void)hipGetLastError();
        grid = cus;
    }
    if (grid < 0) return;
    (void)hipMemsetAsync((char*)d_ws + WS_CTL, 0, CTL_ZERO_BYTES, stream);
    Args a{};
    for (int i = 0; i < 26; ++i) a.in[i] = (const float*)d_in[i];
    a.out = (float*)d_out; a.ws = (unsigned char*)d_ws;
    hipLaunchKernelGGL(fwd_kernel, dim3(grid), dim3(512), LDS_BYTES, stream, a);
    const hipError_t le = hipPeekAtLastError();
    if (le != hipSuccess) fprintf(stderr, "kernel_launch: launch failed: %s\n", hipGetErrorName(le));
}
```

```cpp
#include <hip/hip_runtime.h>
#include <hip/hip_bf16.h>
#include <cstdio>
#include <cstdint>

#ifndef ONLY
#define ONLY -1
#endif
#define PH(n) (ONLY < 0 || ONLY == (n))
constexpr int DM = 2048, NB = 20, SEQ = 2048, T = NB * SEQ, DEPTH = 4;
constexpr int NIN = 11264, DFF = 5632, HFF = DFF / 2  , NMEM = 256, MEMROWS = NB * NMEM;
constexpr int C_Q = 0, C_K = 2048, C_V = 2560, C_U = 3072, C_VS = 5120, C_GA = 7168, C_GS = 9216;
constexpr float EPS = 1e-6f;

namespace pg8 {
#define PG8_LAS __attribute__((address_space(3)))
typedef unsigned short bf16_t;
typedef short bf16x8 __attribute__((ext_vector_type(8)));
typedef float f32x4 __attribute__((ext_vector_type(4)));
typedef float f32x2 __attribute__((ext_vector_type(2)));
typedef unsigned u32x4 __attribute__((ext_vector_type(4)));
constexpr int BM = 256, BK = 64, HALF = 128, HTB = HALF * BK * 2, STAGE_BYTES = 8 * HTB, NXCD = 8, WGM = 4;

__host__ __device__ __forceinline__ int lds_byte(int r, int c) { const int st = (r >> 4) * 2 + (c >> 5), rr = r & 15, cc = c & 31, ob = rr * 64 + cc * 2; return st * 1024 + (ob ^ (((ob >> 9) & 1) << 5)); }
__host__ __device__ __forceinline__ void stage_rc(int b, int& R, int& C) { const int st = b / 1024, sb = b % 1024, swz = sb ^ (((sb >> 9) & 1) << 5); R = (st >> 1) * 16 + swz / 64; C = (st & 1) * 32 + (swz % 64) / 2; }
__host__ __device__ __forceinline__ int perm32(int rho) { const int n = rho >> 4, i = rho & 15; return 8 * (i >> 2) + 4 * n + (i & 3); }

struct Unit { int z1, z2, pm, pn; };
struct Gemm { const bf16_t* A; const bf16_t* Bt; int lda, ldb, K; long aS1, aS2, bS1, bS2; long jA = 0, jB = 0; int tj = 0; };
struct Sched {
    int Z2, nM, nN, nwg, G, c, rev;
    __device__ __forceinline__ void init(int Z, int Z2_, int nM_, int nN_, int G_, int c_, int rev_ = 0) { Z2 = Z2_; nM = nM_; nN = nN_; nwg = Z * nM_ * nN_; G = G_; c = c_; rev = rev_; }
    __device__ __forceinline__ bool next(int i, Unit& u) const {
        int nM = this->nM, nN = this->nN, Z2 = this->Z2; asm volatile("" : "+s"(nM), "+s"(nN), "+s"(Z2));
        const long L = (long)i * G + c; if (L >= nwg) return false;
        int wgid = (int)L; { const int q = nwg / NXCD, r = nwg % NXCD, xcd = wgid % NXCD, off = wgid / NXCD; wgid = (xcd < r ? xcd * (q + 1) : r * (q + 1) + (xcd - r) * q) + off; }
        if (rev) wgid = nwg - 1 - wgid;
        const int per = nM * nN, z = wgid / per, rem = wgid - z * per;
        const int nig = WGM * nN, gid = rem / nig, fm = gid * WGM, gsz = (nM - fm) < WGM ? (nM - fm) : WGM, ri = rem - gid * nig;
        u.pm = fm + (ri % gsz); u.pn = ri / gsz; u.z1 = z / Z2; u.z2 = z - u.z1 * Z2; return true;
    }
};
__device__ __forceinline__ const char* a_tile(const Gemm& g, const Unit& u) { return (const char*)(g.A + ((long)u.z1 * g.aS1 + (long)u.z2 * g.aS2 + (long)u.pm * BM * g.lda)); }
__device__ __forceinline__ const char* b_tile(const Gemm& g, const Unit& u) { return (const char*)(g.Bt + ((long)u.z1 * g.bS1 + (long)u.z2 * g.bS2 + (long)u.pn * BM * g.ldb)); }

__device__ __forceinline__ unsigned cvt_pk_bf16(float lo, float hi) { unsigned r; asm volatile("v_cvt_pk_bf16_f32 %0, %1, %2" : "=v"(r) : "v"(lo), "v"(hi)); return r; }
__device__ __forceinline__ float bf_lo(unsigned w) { return __uint_as_float(w << 16); }
__device__ __forceinline__ float bf_hi(unsigned w) { return __uint_as_float(w & 0xffff0000u); }
__device__ __forceinline__ float gelu_t(float x) { const float e = __builtin_amdgcn_exp2f(x * (-2.302208198f - 0.1029432397f * x * x)); return x * __builtin_amdgcn_rcpf(1.0f + e); }
__device__ __forceinline__ float sigm(float x) { return __builtin_amdgcn_rcpf(1.0f + __builtin_amdgcn_exp2f(-1.4426950409f * x)); }
__device__ __forceinline__ f32x2 gelu_t2(f32x2 x) { const f32x2 t = x * x, u = t * (-0.1029432397f) + (-2.302208198f), a = x * u;
    f32x2 e; e.x = __builtin_amdgcn_exp2f(a.x); e.y = __builtin_amdgcn_exp2f(a.y); const f32x2 d = e + 1.0f;
    f32x2 r; r.x = __builtin_amdgcn_rcpf(d.x); r.y = __builtin_amdgcn_rcpf(d.y); return x * r; }
__device__ __forceinline__ f32x2 sigm2(f32x2 x) { const f32x2 a = x * (-1.4426950409f);
    f32x2 e; e.x = __builtin_amdgcn_exp2f(a.x); e.y = __builtin_amdgcn_exp2f(a.y); const f32x2 d = e + 1.0f;
    f32x2 r; r.x = __builtin_amdgcn_rcpf(d.x); r.y = __builtin_amdgcn_rcpf(d.y); return r; }
#define ACT4(v, F) do { const f32x2 _lo = F((f32x2){v[0], v[1]}), _hi = F((f32x2){v[2], v[3]}); v = (f32x4){_lo.x, _lo.y, _hi.x, _hi.y}; } while (0)

__device__ __forceinline__ int lane_id_opq() { int l; asm volatile("v_mbcnt_lo_u32_b32 %0, -1, 0\n\tv_mbcnt_hi_u32_b32 %0, -1, %0" : "=v"(l)); return l; }
__device__ __forceinline__ float shx(float v, int mask, int lane) { return __int_as_float(__builtin_amdgcn_ds_bpermute((lane ^ mask) << 2, __float_as_int(v))); }
typedef f32x4 Acc[2][2][4][2];
#define EPI_ARGS Acc& acc, const Unit& u, int wr, int wc, int fr, int fq, PG8_LAS unsigned char* xl, const float (&pre)[8]

#define PACK8(w, v0, v1) do { w.x = cvt_pk_bf16(v0[0], v0[1]); w.y = cvt_pk_bf16(v0[2], v0[3]); w.z = cvt_pk_bf16(v1[0], v1[1]); w.w = cvt_pk_bf16(v1[2], v1[3]); } while (0)
#define MUL8(v0, v1, g) do { v0[0] *= bf_lo(g.x); v0[1] *= bf_hi(g.x); v0[2] *= bf_lo(g.y); v0[3] *= bf_hi(g.y); v1[0] *= bf_lo(g.z); v1[1] *= bf_hi(g.z); v1[2] *= bf_lo(g.w); v1[3] *= bf_hi(g.w); } while (0)
#define ADD8(v0, v1, g) do { v0[0] += bf_lo(g.x); v0[1] += bf_hi(g.x); v0[2] += bf_lo(g.y); v0[3] += bf_hi(g.y); v1[0] += bf_lo(g.z); v1[1] += bf_hi(g.z); v1[2] += bf_lo(g.w); v1[3] += bf_hi(g.w); } while (0)
#define ROW_RS8(rs, stats, row0) do { f32x4 _a[2][4], _b[2][4]; \
    _Pragma("unroll") for (int ai = 0; ai < 2; ++ai) _Pragma("unroll") for (int m = 0; m < 4; ++m) { const float* _p = (stats) + (size_t)((row0) + ai * HALF + m) * 8; _a[ai][m] = *(const f32x4*)_p; _b[ai][m] = *(const f32x4*)(_p + 4); } \
    _Pragma("unroll") for (int ai = 0; ai < 2; ++ai) _Pragma("unroll") for (int m = 0; m < 4; ++m) \
        rs[ai][m] = 1.0f / sqrtf(((_a[ai][m][0] + _a[ai][m][1]) + (_a[ai][m][2] + _a[ai][m][3]) + (_b[ai][m][0] + _b[ai][m][1]) + (_b[ai][m][2] + _b[ai][m][3])) * (1.0f / 2048.0f) + 1e-6f); } while (0)
__device__ __forceinline__ void gate2(f32x2& a, f32x2& s, float k) { const f32x2 ta = a * k, ts = s * k;
    f32x2 ea, es; ea.x = __builtin_amdgcn_exp2f(ta.x); ea.y = __builtin_amdgcn_exp2f(ta.y); es.x = __builtin_amdgcn_exp2f(ts.x); es.y = __builtin_amdgcn_exp2f(ts.y);
    const f32x2 da = ea + 1.0f, ds = es + 1.0f;
    f32x2 ra, rs; ra.x = __builtin_amdgcn_rcpf(da.x); ra.y = __builtin_amdgcn_rcpf(da.y); rs.x = __builtin_amdgcn_rcpf(ds.x); rs.y = __builtin_amdgcn_rcpf(ds.y);
    a = ds * ra; s = rs; }
#define GATE4(a, s, k) do { f32x2 _al = {a[0], a[1]}, _ah = {a[2], a[3]}, _sl = {s[0], s[1]}, _sh = {s[2], s[3]}; gate2(_al, _sl, k); gate2(_ah, _sh, k); \
    a = (f32x4){_al.x, _al.y, _ah.x, _ah.y}; s = (f32x4){_sl.x, _sl.y, _sh.x, _sh.y}; } while (0)
template <int MODE, bool PRE_ = false> struct EpiBf16 {
    static constexpr bool MID = false, PERM = true, PRE = PRE_;
    bf16_t* C; int ldc; long cS1, cS2; const float* stats;
    float* lnst; int pn0 = 0;
    __device__ __forceinline__ const float* pre_base(const Unit& u) const { return stats + (size_t)u.pm * BM; }
    __device__ __forceinline__ void operator()(EPI_ARGS) const {
        const int pn = u.pn + pn0;
        int act = 0; if (MODE == 1) act = pn < 20 ? 0 : (pn < 28 ? 1 : 2);
        const bool lnrows = (MODE == 1) && pn >= 20 && pn < 28;
        char* ub = (char*)(C + (long)u.z1 * cS1 + (long)u.z2 * cS2 + (long)u.pm * BM * ldc + pn * BM);
        const unsigned lo = (unsigned)((wr * 64 + 4 * fr) * ldc + wc * 32 + 8 * fq) * 2u;
        float rs[2][4];
        if (PRE) {
#pragma unroll
            for (int ai = 0; ai < 2; ++ai)
#pragma unroll
                for (int m = 0; m < 4; ++m) rs[ai][m] = pre[ai * 4 + m]; }
        else if (stats) ROW_RS8(rs, stats, u.pm * BM + wr * 64 + 4 * fr);
        else {
#pragma unroll
            for (int ai = 0; ai < 2; ++ai)
#pragma unroll
                for (int m = 0; m < 4; ++m) rs[ai][m] = 1.0f; }
        if (MODE == 1 && act == 2) {
            char* g0 = (char*)(C + (long)u.pm * BM * ldc + C_GA + 128 * (pn - 28));
#pragma unroll
            for (int ai = 0; ai < 2; ++ai)
#pragma unroll
                for (int m = 0; m < 4; ++m) { char* rb = g0 + (size_t)(ai * HALF + m) * ldc * 2;
                    f32x4 a0 = acc[ai][0][m][0], a1 = acc[ai][0][m][1], s0 = acc[ai][1][m][0], s1 = acc[ai][1][m][1]; const float kk = rs[ai][m] * (-1.4426950409f);
                    GATE4(a0, s0, kk); GATE4(a1, s1, kk);
                    asm volatile("s_nop 0" : "+v"(s0), "+v"(s1));
                    { u32x4 w; PACK8(w, a0, a1); *(u32x4*)(rb + lo) = w; }
                    { u32x4 w; PACK8(w, s0, s1); *(u32x4*)(rb + lo + (C_GS - C_GA) * 2) = w; } }
            return; }
#pragma unroll
        for (int ai = 0; ai < 2; ++ai)
#pragma unroll
            for (int m = 0; m < 4; ++m) { char* rb = ub + (size_t)(ai * HALF + m) * ldc * 2;
                float s1 = 0.f, s2 = 0.f;
#pragma unroll
                for (int bj = 0; bj < 2; ++bj) { f32x4 v0 = acc[ai][bj][m][0] * rs[ai][m], v1 = acc[ai][bj][m][1] * rs[ai][m];
                    if (act == 1) { ACT4(v0, gelu_t2); ACT4(v1, gelu_t2); }
                    else if (act == 2) { ACT4(v0, sigm2); ACT4(v1, sigm2); }
                    u32x4 w; PACK8(w, v0, v1);
                    *(u32x4*)(rb + lo + bj * 256) = w;
                    if (MODE == 1 && lnrows) { const f32x4 t = v0 + v1, q = v0 * v0 + v1 * v1; s1 += (t[0] + t[1]) + (t[2] + t[3]); s2 += (q[0] + q[1]) + (q[2] + q[3]); } }
                if (MODE == 1 && lnrows) { const int ln = fq * 16 + fr; s1 += shx(s1, 16, ln); s1 += shx(s1, 32, ln); s2 += shx(s2, 16, ln); s2 += shx(s2, 32, ln);
                    if (fq == 0) ((PG8_LAS f32x2*)xl)[(ai * HALF + wr * 64 + 4 * fr + m) * 4 + wc] = (f32x2){s1, s2}; } }
        if (MODE == 1 && lnrows) {
            asm volatile("s_waitcnt lgkmcnt(0)" ::: "memory"); __builtin_amdgcn_s_barrier(); asm volatile("" ::: "memory");
            if (fq == 0) {
#pragma unroll
                for (int ai = 0; ai < 2; ++ai) { const int r = ai * HALF + wr * 64 + wc * 16 + fr; const PG8_LAS f32x2* q = (const PG8_LAS f32x2*)xl + r * 4;
                    const f32x2 a = q[0], b = q[1], c = q[2], d = q[3];
                    *(f32x2*)(lnst + ((size_t)(u.pm * BM + r) * 8 + (pn - 20)) * 2) = (f32x2){(a.x + b.x) + (c.x + d.x), (a.y + b.y) + (c.y + d.y)}; } }
        }
    }
};
struct EpiRes {
    static constexpr bool MID = false, PERM = true, PRE = false;
    bf16_t* XB; int ldc; long cS1; float* stats; int rows_per_z;
    __device__ __forceinline__ void operator()(EPI_ARGS) const {
        char* ub = (char*)(XB + (long)u.z1 * cS1 + (long)u.pm * BM * ldc + u.pn * BM);
        const unsigned lo = (unsigned)((wr * 64 + 4 * fr) * ldc + wc * 32 + 8 * fq) * 2u;
        PG8_LAS float* XS = (PG8_LAS float*)xl;
        const int ln = fq * 16 + fr;
        u32x4 xq[2][4][2];
#pragma unroll
        for (int ai = 0; ai < 2; ++ai)
#pragma unroll
            for (int m = 0; m < 4; ++m)
#pragma unroll
                for (int bj = 0; bj < 2; ++bj) xq[ai][m][bj] = *(const u32x4*)(ub + (size_t)(ai * HALF + m) * ldc * 2 + lo + bj * 256);
        asm volatile("" ::: "memory");
#pragma unroll
        for (int ai = 0; ai < 2; ++ai)
#pragma unroll
            for (int m = 0; m < 4; ++m) { float ss = 0.f;
#pragma unroll
                for (int bj = 0; bj < 2; ++bj) { f32x4 v0 = acc[ai][bj][m][0], v1 = acc[ai][bj][m][1];
                    ADD8(v0, v1, xq[ai][m][bj]);
                    u32x4 w; PACK8(w, v0, v1); *(u32x4*)(ub + (size_t)(ai * HALF + m) * ldc * 2 + lo + bj * 256) = w;
                    ss += (v0[0] * v0[0] + v0[1] * v0[1]) + (v0[2] * v0[2] + v0[3] * v0[3]) + (v1[0] * v1[0] + v1[1] * v1[1]) + (v1[2] * v1[2] + v1[3] * v1[3]); }
                ss += shx(ss, 16, ln); ss += shx(ss, 32, ln); if (fq == 0) XS[(ai * HALF + wr * 64 + 4 * fr + m) * 4 + wc] = ss; }
        asm volatile("s_waitcnt lgkmcnt(0)" ::: "memory"); __builtin_amdgcn_s_barrier(); asm volatile("" ::: "memory");
        if (fq == 0) {
#pragma unroll
            for (int ai = 0; ai < 2; ++ai) { const int r = ai * HALF + wr * 64 + wc * 16 + fr; const f32x4 q = *(const PG8_LAS f32x4*)(XS + r * 4);
                stats[((size_t)u.z1 * rows_per_z + u.pm * BM + r) * 8 + u.pn] = (q[0] + q[1]) + (q[2] + q[3]); } }
    }
};
template <bool FIRST> struct EpiMix {
    static constexpr bool MID = false, PERM = true, PRE = false;
    const bf16_t* G; bf16_t* O; int ld;
    __device__ __forceinline__ void operator()(EPI_ARGS) const {
        const long uo = (long)u.pm * BM * ld + u.pn * BM;
        const char* gb = (const char*)(G + uo); char* ob = (char*)(O + uo);
        const unsigned lo = (unsigned)((wr * 64 + 4 * fr) * ld + wc * 32 + 8 * fq) * 2u;
#pragma unroll
        for (int ai = 0; ai < 2; ++ai) {
            u32x4 gq[4][2], oq[4][2];
#pragma unroll
            for (int m = 0; m < 4; ++m)
#pragma unroll
                for (int bj = 0; bj < 2; ++bj) { const size_t ro = (size_t)(ai * HALF + m) * ld * 2; gq[m][bj] = *(const u32x4*)(gb + ro + lo + bj * 256); if (!FIRST) oq[m][bj] = *(const u32x4*)(ob + ro + lo + bj * 256); }
            asm volatile("" ::: "memory");
#pragma unroll
            for (int m = 0; m < 4; ++m)
#pragma unroll
                for (int bj = 0; bj < 2; ++bj) { const size_t ro = (size_t)(ai * HALF + m) * ld * 2;
                    f32x4 v0 = acc[ai][bj][m][0], v1 = acc[ai][bj][m][1];
                    MUL8(v0, v1, gq[m][bj]);
                    if (!FIRST) ADD8(v0, v1, oq[m][bj]);
                    u32x4 w; PACK8(w, v0, v1);
                    *(u32x4*)(ob + ro + lo + bj * 256) = w; }
            asm volatile("" ::: "memory"); }
    }
};
struct EpiMixF {
    static constexpr bool MID = true, PERM = true, PRE = false;
    const bf16_t* GA; const bf16_t* GS; bf16_t* O; int ld;
    __device__ __forceinline__ void mid(Acc& acc, const Unit& u, int wr, int wc, int fr, int fq) const {
        const char* ab = (const char*)(GA + ((long)u.pm * BM * ld + u.pn * BM));
        const unsigned lo = (unsigned)((wr * 64 + 4 * fr) * ld + wc * 32 + 8 * fq) * 2u;
#pragma unroll
        for (int ai = 0; ai < 2; ++ai) {
            u32x4 aq[4][2];
#pragma unroll
            for (int m = 0; m < 4; ++m)
#pragma unroll
                for (int bj = 0; bj < 2; ++bj) aq[m][bj] = *(const u32x4*)(ab + (size_t)(ai * HALF + m) * ld * 2 + lo + bj * 256);
            asm volatile("" ::: "memory");
#pragma unroll
            for (int m = 0; m < 4; ++m)
#pragma unroll
                for (int bj = 0; bj < 2; ++bj) MUL8(acc[ai][bj][m][0], acc[ai][bj][m][1], aq[m][bj]);
            asm volatile("" ::: "memory"); }
    }
    __device__ __forceinline__ void operator()(EPI_ARGS) const {
        const long uo = (long)u.pm * BM * ld + u.pn * BM;
        const char* gb = (const char*)(GS + uo); char* ob = (char*)(O + uo);
        const unsigned lo = (unsigned)((wr * 64 + 4 * fr) * ld + wc * 32 + 8 * fq) * 2u;
#pragma unroll
        for (int ai = 0; ai < 2; ++ai) {
            u32x4 gq[4][2];
#pragma unroll
            for (int m = 0; m < 4; ++m)
#pragma unroll
                for (int bj = 0; bj < 2; ++bj) { const size_t ro = (size_t)(ai * HALF + m) * ld * 2; gq[m][bj] = *(const u32x4*)(gb + ro + lo + bj * 256); }
            asm volatile("" ::: "memory");
#pragma unroll
            for (int m = 0; m < 4; ++m)
#pragma unroll
                for (int bj = 0; bj < 2; ++bj) { const size_t ro = (size_t)(ai * HALF + m) * ld * 2;
                    f32x4 v0 = acc[ai][bj][m][0], v1 = acc[ai][bj][m][1];
                    MUL8(v0, v1, gq[m][bj]);
                    u32x4 w; PACK8(w, v0, v1);
                    *(u32x4*)(ob + ro + lo + bj * 256) = w; }
            asm volatile("" ::: "memory"); }
    }
};
struct EpiSpatial {
    static constexpr bool MID = false, PERM = true, PRE = false;
    bf16_t* U; int ld; const float* bs;
    __device__ __forceinline__ void operator()(EPI_ARGS) const {
        char* ub = (char*)(U + (long)u.z1 * BM * ld + u.z2 * BM);
        const unsigned lo = (unsigned)((wr * 64 + 4 * fr) * ld + wc * 32 + 8 * fq) * 2u;
        const float* bp = bs + u.z2 * 128 + wr * 64;
        u32x4 uq[2][4][2]; float bq[4];
#pragma unroll
        for (int m = 0; m < 4; ++m) bq[m] = bp[4 * fr + m];
#pragma unroll
        for (int ai = 0; ai < 2; ++ai)
#pragma unroll
            for (int m = 0; m < 4; ++m)
#pragma unroll
                for (int bj = 0; bj < 2; ++bj) uq[ai][m][bj] = *(const u32x4*)(ub + (size_t)(ai * HALF + m) * ld * 2 + lo + bj * 256);
        asm volatile("" ::: "memory");
#pragma unroll
        for (int ai = 0; ai < 2; ++ai)
#pragma unroll
            for (int m = 0; m < 4; ++m)
#pragma unroll
                for (int bj = 0; bj < 2; ++bj) {
                    const u32x4 q = uq[ai][m][bj];
                    f32x4 u0 = (f32x4){bf_lo(q.x), bf_hi(q.x), bf_lo(q.y), bf_hi(q.y)}, u1 = (f32x4){bf_lo(q.z), bf_hi(q.z), bf_lo(q.w), bf_hi(q.w)};
                    ACT4(u0, gelu_t2); ACT4(u1, gelu_t2);
                    const f32x4 v0 = (acc[ai][bj][m][0] + bq[m]) * u0, v1 = (acc[ai][bj][m][1] + bq[m]) * u1;
                    u32x4 w; PACK8(w, v0, v1);
                    *(u32x4*)(ub + (size_t)(ai * HALF + m) * ld * 2 + lo + bj * 256) = w; }
    }
};
#define DPP_SHR1 0x111
#define DPP_SHL1 0x101
#define DPP_ROR1 0x121
#define DPP_ROR15 0x12F
#define DPPI(old, src, ctrl) ((unsigned)__builtin_amdgcn_update_dpp((int)(old), (int)(src), ctrl, 0xF, 0xF, false))
struct EpiConv {
    static constexpr bool MID = false, PERM = true, PRE = true;
    __device__ __forceinline__ const float* pre_base(const Unit& u) const { return stats + (size_t)u.pm * BM; }
    const bf16_t* A; bf16_t* O; int ld; const float* stats; const float* cw; const float* cb;
    __device__ __forceinline__ void operator()(EPI_ARGS) const {
        {
#pragma unroll
          for (int ai = 0; ai < 2; ++ai)
#pragma unroll
            for (int m = 0; m < 4; ++m)
#pragma unroll
                for (int bj = 0; bj < 2; ++bj) { acc[ai][bj][m][0] *= pre[ai * 4 + m]; acc[ai][bj][m][1] *= pre[ai * 4 + m]; } }
        const long uo = (long)u.pm * BM * ld + u.pn * BM;
        const char* ab = (const char*)(A + uo); char* ob = (char*)(O + uo);
        const int ld2 = ld * 2;
        const unsigned lo = (unsigned)((wr * 64 + 4 * fr) * ld + wc * 32 + 8 * fq) * 2u;
        const unsigned loe = (unsigned)((wr * 64) * ld + wc * 32 + 8 * fq) * 2u;
        const int pm8 = u.pm & 7;
#pragma unroll
        for (int bj = 0; bj < 2; ++bj) {
            const float* pp = cw + u.pn * BM + bj * HALF + wc * 32 + 8 * fq; const float* pb = cb + u.pn * BM + bj * HALF + wc * 32 + 8 * fq;
            const f32x4 w0a = *(const f32x4*)pp, w0b = *(const f32x4*)(pp + 4), w1a = *(const f32x4*)(pp + ld), w1b = *(const f32x4*)(pp + ld + 4),
                        w2a = *(const f32x4*)(pp + 2 * ld), w2b = *(const f32x4*)(pp + 2 * ld + 4), cba = *(const f32x4*)pb, cbb = *(const f32x4*)(pb + 4);
#pragma unroll
            for (int ai = 0; ai < 2; ++ai) {
                const bool tz = (pm8 == 0) && (ai == 0) && (wr == 0), bz = (pm8 == 7) && (ai == 1) && (wr == 1);
                u32x4 qc[4], et, eb;
#pragma unroll
                for (int m = 0; m < 4; ++m) qc[m] = *(const u32x4*)(ab + (size_t)(ai * HALF + m) * ld2 + lo + bj * 256);
                et = *(const u32x4*)(ab + (long)(ai * HALF + (tz ? 0 : -1)) * ld2 + loe + bj * 256);
                eb = *(const u32x4*)(ab + (long)(ai * HALF + (bz ? 63 : 64)) * ld2 + loe + bj * 256);
                asm volatile("" ::: "memory");
                if (tz) et = (u32x4){0u, 0u, 0u, 0u};
                if (bz) eb = (u32x4){0u, 0u, 0u, 0u};
#pragma unroll
                for (int m = 0; m < 4; ++m) {
                    u32x4 zp, zn; const u32x4 zc = qc[m];
#pragma unroll
                    for (int d = 0; d < 4; ++d) {
                        const unsigned X = (m == 0) ? et[d] : DPPI(0, qc[m > 0 ? m - 1 : 0][d], DPP_ROR1);
                        zp[d] = DPPI(X, zc[d], DPP_SHR1);
                        const unsigned Y = (m == 3) ? eb[d] : DPPI(0, qc[m < 3 ? m + 1 : 3][d], DPP_ROR15);
                        zn[d] = DPPI(Y, zc[d], DPP_SHL1); }
#define UNP4(lo4, hi4, QQ) const f32x4 lo4 = (f32x4){bf_lo(QQ.x), bf_hi(QQ.x), bf_lo(QQ.y), bf_hi(QQ.y)}, hi4 = (f32x4){bf_lo(QQ.z), bf_hi(QQ.z), bf_lo(QQ.w), bf_hi(QQ.w)}
                    UNP4(pl, ph, zp); UNP4(cl, ch, zc); UNP4(nl, nh, zn);
#undef UNP4
                    f32x4 c0 = cba + w0a * pl + w1a * cl + w2a * nl, c1 = cbb + w0b * ph + w1b * ch + w2b * nh;
                    ACT4(c0, gelu_t2); ACT4(c1, gelu_t2);
                    const f32x4 v0 = acc[ai][bj][m][0] * c0, v1 = acc[ai][bj][m][1] * c1;
                    u32x4 w; PACK8(w, v0, v1);
                    *(u32x4*)(ob + (size_t)(ai * HALF + m) * ld2 + lo + bj * 256) = w; }
                asm volatile("" ::: "memory"); }
        }
    }
};
struct EpiUp {
    static constexpr bool MID = false, PERM = true, PRE = true;
    bf16_t* O; int ldo; const float* stats; const float* cw; const float* cb; float* EA; float* EB;
    __device__ __forceinline__ const float* pre_base(const Unit& u) const { return stats + (size_t)u.pm * BM; }
    __device__ __forceinline__ void operator()(EPI_ARGS) const {
#pragma unroll
        for (int ai = 0; ai < 2; ++ai)
#pragma unroll
            for (int m = 0; m < 4; ++m)
#pragma unroll
                for (int bj = 0; bj < 2; ++bj) { acc[ai][bj][m][0] *= pre[ai * 4 + m]; acc[ai][bj][m][1] *= pre[ai * 4 + m]; }
        const int ch0 = u.pn * HALF + wc * 32 + 8 * fq;
        const float* pp = cw + ch0; const float* pb = cb + ch0;
        const f32x4 w0a = *(const f32x4*)pp, w0b = *(const f32x4*)(pp + 4), w1a = *(const f32x4*)(pp + ldo), w1b = *(const f32x4*)(pp + ldo + 4),
                    w2a = *(const f32x4*)(pp + 2 * ldo), w2b = *(const f32x4*)(pp + 2 * ldo + 4), cba = *(const f32x4*)pb, cbb = *(const f32x4*)(pb + 4);
        PG8_LAS float* E = (PG8_LAS float*)xl;
        const int cl = wc * 32 + 8 * fq;
#pragma unroll
        for (int ai = 0; ai < 2; ++ai) { const int blk = ai * 2 + wr;
            if (fr == 0)  { *(PG8_LAS f32x4*)(E + (blk * 2 + 0) * HALF + cl) = acc[ai][0][0][0]; *(PG8_LAS f32x4*)(E + (blk * 2 + 0) * HALF + cl + 4) = acc[ai][0][0][1]; }
            if (fr == 15) { *(PG8_LAS f32x4*)(E + (blk * 2 + 1) * HALF + cl) = acc[ai][0][3][0]; *(PG8_LAS f32x4*)(E + (blk * 2 + 1) * HALF + cl + 4) = acc[ai][0][3][1]; } }
        asm volatile("s_waitcnt lgkmcnt(0)" ::: "memory"); __builtin_amdgcn_s_barrier(); asm volatile("" ::: "memory");
        char* ob = (char*)(O + (long)u.pm * BM * ldo + ch0);
        const unsigned lo = (unsigned)((wr * 64 + 4 * fr) * ldo) * 2u;
#define DPPF(old, src, ctrl) __uint_as_float((unsigned)__builtin_amdgcn_update_dpp((int)__float_as_uint(old), (int)__float_as_uint(src), ctrl, 0xF, 0xF, false))
#pragma unroll
        for (int ai = 0; ai < 2; ++ai) { const int blk = ai * 2 + wr;
            f32x4 et0 = (f32x4){0.f, 0.f, 0.f, 0.f}, et1 = et0, eb0 = et0, eb1 = et0;
            if (blk > 0) { et0 = *(const PG8_LAS f32x4*)(E + ((blk - 1) * 2 + 1) * HALF + cl); et1 = *(const PG8_LAS f32x4*)(E + ((blk - 1) * 2 + 1) * HALF + cl + 4); }
            if (blk < 3) { eb0 = *(const PG8_LAS f32x4*)(E + ((blk + 1) * 2 + 0) * HALF + cl); eb1 = *(const PG8_LAS f32x4*)(E + ((blk + 1) * 2 + 0) * HALF + cl + 4); }
            f32x4 pe0, pe1, ne0, ne1;
#pragma unroll
            for (int e = 0; e < 4; ++e) { pe0[e] = DPPF(et0[e], acc[ai][0][3][0][e], DPP_SHR1); pe1[e] = DPPF(et1[e], acc[ai][0][3][1][e], DPP_SHR1);
                                          ne0[e] = DPPF(eb0[e], acc[ai][0][0][0][e], DPP_SHL1); ne1[e] = DPPF(eb1[e], acc[ai][0][0][1][e], DPP_SHL1); }
#pragma unroll
            for (int m = 0; m < 4; ++m) {
                const f32x4 c0 = acc[ai][0][m][0], c1 = acc[ai][0][m][1];
                const f32x4 p0 = (m == 0) ? pe0 : acc[ai][0][m > 0 ? m - 1 : 0][0], p1 = (m == 0) ? pe1 : acc[ai][0][m > 0 ? m - 1 : 0][1];
                const f32x4 n0 = (m == 3) ? ne0 : acc[ai][0][m < 3 ? m + 1 : 3][0], n1 = (m == 3) ? ne1 : acc[ai][0][m < 3 ? m + 1 : 3][1];
                f32x4 g0 = cba + w0a * p0 + w1a * c0 + w2a * n0, g1 = cbb + w0b * p1 + w1b * c1 + w2b * n1;
                ACT4(g0, gelu_t2); ACT4(g1, gelu_t2);
                const f32x4 v0 = acc[ai][1][m][0] * g0, v1 = acc[ai][1][m][1] * g1;
                u32x4 w; PACK8(w, v0, v1);
                *(u32x4*)(ob + (size_t)(ai * HALF + m) * ldo * 2 + lo) = w; } }
#undef DPPF
        if (wr == 0 && fr == 0) { float* ea = EA + ((size_t)u.pm * 4 + 0) * ldo + ch0; *(f32x4*)ea = acc[0][0][0][0]; *(f32x4*)(ea + 4) = acc[0][0][0][1];
            *(f32x4*)(ea + ldo) = acc[0][0][1][0]; *(f32x4*)(ea + ldo + 4) = acc[0][0][1][1];
            float* eb = EB + ((size_t)u.pm * 2 + 0) * ldo + ch0; *(f32x4*)eb = acc[0][1][0][0]; *(f32x4*)(eb + 4) = acc[0][1][0][1]; }
        if (wr == 1 && fr == 15) { float* ea = EA + ((size_t)u.pm * 4 + 2) * ldo + ch0; *(f32x4*)ea = acc[1][0][2][0]; *(f32x4*)(ea + 4) = acc[1][0][2][1];
            *(f32x4*)(ea + ldo) = acc[1][0][3][0]; *(f32x4*)(ea + ldo + 4) = acc[1][0][3][1];
            float* eb = EB + ((size_t)u.pm * 2 + 1) * ldo + ch0; *(f32x4*)eb = acc[1][1][3][0]; *(f32x4*)(eb + 4) = acc[1][1][3][1]; }
    }
};
struct EpiSoftmax {
    static constexpr bool MID = false, PERM = true, PRE = false;
    bf16_t* P; int ldc; long cS1; float sc2; const float* stats; int rows_per_z;
    __device__ __forceinline__ void operator()(EPI_ARGS) const {
        PG8_LAS f32x2* X = (PG8_LAS f32x2*)xl;
        float mw[2][4], rsr[2][4]; const int ln = fq * 16 + fr;
        ROW_RS8(rsr, stats, u.z1 * rows_per_z + u.pm * BM + wr * 64 + 4 * fr);
#pragma unroll
        for (int ai = 0; ai < 2; ++ai)
#pragma unroll
            for (int m = 0; m < 4; ++m) {
                float mx = -3.0e38f; const float rsc = sc2 * rsr[ai][m];
#pragma unroll
                for (int bj = 0; bj < 2; ++bj)
#pragma unroll
                    for (int n = 0; n < 2; ++n)
#pragma unroll
                        for (int e = 0; e < 4; ++e) { const float v = acc[ai][bj][m][n][e] * rsc; acc[ai][bj][m][n][e] = v; mx = fmaxf(mx, v); }
                mx = fmaxf(mx, shx(mx, 16, ln)); mx = fmaxf(mx, shx(mx, 32, ln));
                float s = 0.f;
#pragma unroll
                for (int bj = 0; bj < 2; ++bj)
#pragma unroll
                    for (int n = 0; n < 2; ++n)
#pragma unroll
                        for (int e = 0; e < 4; ++e) { const float p = __builtin_amdgcn_exp2f(acc[ai][bj][m][n][e] - mx); acc[ai][bj][m][n][e] = p; s += p; }
                s += shx(s, 16, ln); s += shx(s, 32, ln);
                mw[ai][m] = mx;
                if (fq == 0) X[(ai * HALF + wr * 64 + 4 * fr + m) * 4 + wc] = (f32x2){mx, s};
            }
        asm volatile("s_waitcnt lgkmcnt(0)" ::: "memory"); __builtin_amdgcn_s_barrier(); asm volatile("" ::: "memory");
        char* ub = (char*)(P + (long)u.z1 * cS1 + (long)u.pm * BM * ldc + u.pn * BM);
        const unsigned lo = (unsigned)((wr * 64 + 4 * fr) * ldc + wc * 32 + 8 * fq) * 2u;
#pragma unroll
        for (int ai = 0; ai < 2; ++ai)
#pragma unroll
            for (int m = 0; m < 4; ++m) { const int r = ai * HALF + wr * 64 + 4 * fr + m;
                const f32x2 a = X[r * 4 + 0], b = X[r * 4 + 1], c = X[r * 4 + 2], d = X[r * 4 + 3];
                const float mt = fmaxf(fmaxf(a.x, b.x), fmaxf(c.x, d.x));
                const float l = a.y * __builtin_amdgcn_exp2f(a.x - mt) + b.y * __builtin_amdgcn_exp2f(b.x - mt) + c.y * __builtin_amdgcn_exp2f(c.x - mt) + d.y * __builtin_amdgcn_exp2f(d.x - mt);
                const float f = __builtin_amdgcn_exp2f(mw[ai][m] - mt) / l;
                char* rb = ub + (size_t)(ai * HALF + m) * ldc * 2;
#pragma unroll
                for (int bj = 0; bj < 2; ++bj) { const f32x4 v0 = acc[ai][bj][m][0] * f, v1 = acc[ai][bj][m][1] * f; u32x4 w; PACK8(w, v0, v1);
                    *(u32x4*)(rb + lo + bj * 256) = w; } }
    }
};

template <class Epi>
__device__ __forceinline__ void gemm_phase(PG8_LAS unsigned char* lds, PG8_LAS unsigned char* xl, const Gemm g, const Sched& S, const Epi& E, const int wid) {
    const int lane = lane_id_opq(), tid = wid * 64 + lane;
    const int wr = wid >> 2, wc = wid & 3, fr = lane & 15, fq = lane >> 4;
    const int K = g.K, nt = K / BK;
    unsigned voffA[2], voffB[2];
#pragma unroll
    for (int i = 0; i < 2; ++i) { int R, C; stage_rc(tid * 16 + i * 8192, R, C); const int Rb = Epi::PERM ? ((R & ~31) + perm32(R & 31)) : R;
        const int Ra = Epi::PERM ? ((R & ~63) + 4 * (R & 15) + ((R >> 4) & 3)) : R;
        voffA[i] = (unsigned)(Ra * g.lda + C) * 2u; voffB[i] = (unsigned)(Rb * g.ldb + C) * 2u; }
    const size_t kstep = (size_t)(BK * 2);
    const size_t hstepA = (size_t)HALF * g.lda * 2, hstepB = (size_t)HALF * g.ldb * 2;
    const unsigned ldsw = (unsigned)wid * 1024u;
    const int aoff = lds_byte(wr * 64 + fr, fq * 8), boff = lds_byte(wc * 32 + fr, fq * 8);
#define PG8_SA(b, h) (((b) * 2 + (h)) * HTB)
#define PG8_SB(b, h) ((4 + (b) * 2 + (h)) * HTB)
#define PG8_STAGE(bufoff, gbase, voff) do { _Pragma("unroll") for (int _i = 0; _i < 2; ++_i) \
        __builtin_amdgcn_global_load_lds((const unsigned*)((const char*)(gbase) + (voff)[_i]), (PG8_LAS unsigned*)(lds + (bufoff) + ldsw + _i * 8192), 16, 0, 0); } while (0)
#define PG8_LDA(dst, b, h) do { _Pragma("unroll") for (int m = 0; m < 4; ++m) _Pragma("unroll") for (int k = 0; k < 2; ++k) dst[m][k] = *(const PG8_LAS bf16x8*)(lds + PG8_SA(b, h) + aoff + m * 2048 + k * 1024); } while (0)
#define PG8_LDB(dst, b, h) do { _Pragma("unroll") for (int n = 0; n < 2; ++n) _Pragma("unroll") for (int k = 0; k < 2; ++k) dst[n][k] = *(const PG8_LAS bf16x8*)(lds + PG8_SB(b, h) + boff + n * 2048 + k * 1024); } while (0)
#define PG8_MMA(ai, bj, At, Bt) do { __builtin_amdgcn_s_setprio(1); _Pragma("unroll") for (int m = 0; m < 4; ++m) _Pragma("unroll") for (int n = 0; n < 2; ++n) _Pragma("unroll") for (int k = 0; k < 2; ++k) \
        acc[ai][bj][m][n] = __builtin_amdgcn_mfma_f32_16x16x32_bf16(Bt[n][k], At[m][k], acc[ai][bj][m][n], 0, 0, 0); __builtin_amdgcn_s_setprio(0); } while (0)
#define PG8_WAIT_V(n) asm volatile("s_waitcnt vmcnt(" #n ")" ::: "memory")
#define PG8_WAIT_L(n) asm volatile("s_waitcnt lgkmcnt(" #n ")" ::: "memory")
#define PG8_BAR __builtin_amdgcn_s_barrier()
#define PG8_SCHED __builtin_amdgcn_sched_barrier(0)
    Unit cur, nxt; int ui = 0;
    if (!S.next(0, cur)) return;
    Acc acc;
#pragma unroll
    for (int a = 0; a < 2; ++a)
#pragma unroll
        for (int b = 0; b < 2; ++b)
#pragma unroll
            for (int m = 0; m < 4; ++m)
#pragma unroll
                for (int n = 0; n < 2; ++n) acc[a][b][m][n] = (f32x4){0.f, 0.f, 0.f, 0.f};
    bf16x8 At[4][2], B0[2][2], B1[2][2];
    float prc[8];
#pragma unroll
    for (int k = 0; k < 8; ++k) prc[k] = 1.0f;
    if constexpr (Epi::PRE) { const float* pb = E.pre_base(cur) + wr * 64 + 4 * fr;
#pragma unroll
        for (int k = 0; k < 8; ++k) prc[k] = pb[(k >> 2) * HALF + (k & 3)]; }
    const char* cA = a_tile(g, cur); const char* cB = b_tile(g, cur);
    PG8_STAGE(PG8_SB(0, 0), cB, voffB); PG8_STAGE(PG8_SB(0, 1), cB + hstepB, voffB); PG8_STAGE(PG8_SA(0, 0), cA, voffA); PG8_STAGE(PG8_SA(0, 1), cA + hstepA, voffA);
    if (wr == 1) PG8_BAR;
    PG8_WAIT_V(2); PG8_BAR;
    PG8_STAGE(PG8_SB(1, 0), cB + kstep, voffB); PG8_STAGE(PG8_SA(1, 0), cA + kstep, voffA); PG8_STAGE(PG8_SB(1, 1), cB + hstepB + kstep, voffB);
    PG8_WAIT_V(6); PG8_BAR;
    for (;;) {
        const bool has_next = S.next(ui + 1, nxt);
        const char* nA = has_next ? a_tile(g, nxt) : cA; const char* nB = has_next ? b_tile(g, nxt) : cB;
        for (int t = 0; t < nt; t += 2) {
            const bool last = (t == nt - 2);
            long j1 = 0, ja2 = 0, jb2 = 0;
            if constexpr (Epi::MID) {
                if (t == g.tj) { const int lnM = lane_id_opq(); E.mid(acc, cur, wr, wc, lnM & 15, lnM >> 4); }
                if (t >= g.tj) j1 = g.jA;
                if (t + 2 >= g.tj) { ja2 = g.jA; jb2 = g.jB; } }
            const char* a1 = cA + (size_t)(t + 1) * kstep + j1;
            const char* a2 = last ? nA : cA + (size_t)(t + 2) * kstep + ja2; const char* b2 = last ? nB : cB + (size_t)(t + 2) * kstep + jb2;
            const char* a3 = a2 + kstep; const char* b3 = b2 + kstep;
            PG8_LDB(B0, 0, 0); PG8_LDB(B1, 0, 1); PG8_SCHED; PG8_LDA(At, 0, 0); PG8_STAGE(PG8_SA(1, 1), a1 + hstepA, voffA);
            PG8_WAIT_V(8); PG8_WAIT_L(0); PG8_BAR; PG8_MMA(0, 0, At, B0); PG8_MMA(0, 1, At, B1); PG8_BAR; PG8_SCHED;
            PG8_LDA(At, 0, 1); PG8_STAGE(PG8_SB(0, 0), b2, voffB); PG8_STAGE(PG8_SB(0, 1), b2 + hstepB, voffB); PG8_STAGE(PG8_SA(0, 0), a2, voffA);
            PG8_WAIT_V(8); PG8_WAIT_L(0); PG8_BAR; PG8_MMA(1, 0, At, B0); PG8_MMA(1, 1, At, B1); PG8_BAR; PG8_SCHED;
            PG8_LDB(B0, 1, 0); PG8_LDB(B1, 1, 1); PG8_SCHED; PG8_LDA(At, 1, 0); PG8_STAGE(PG8_SA(0, 1), a2 + hstepA, voffA);
            PG8_WAIT_V(8); PG8_WAIT_L(0); PG8_BAR; PG8_MMA(0, 0, At, B0); PG8_MMA(0, 1, At, B1); PG8_BAR; PG8_SCHED;
            PG8_LDA(At, 1, 1); PG8_STAGE(PG8_SB(1, 0), b3, voffB); PG8_STAGE(PG8_SB(1, 1), b3 + hstepB, voffB); PG8_STAGE(PG8_SA(1, 0), a3, voffA);
            PG8_WAIT_V(8); PG8_WAIT_L(0); PG8_BAR; PG8_MMA(1, 0, At, B0); PG8_MMA(1, 1, At, B1); PG8_BAR; PG8_SCHED;
        }
        if (wr == 0) PG8_BAR;
        { const int lnE = lane_id_opq(); const int frE = lnE & 15, fqE = lnE >> 4;
          float prn[8];
#pragma unroll
          for (int k = 0; k < 8; ++k) prn[k] = 1.0f;
          if constexpr (Epi::PRE) { if (has_next) { const float* pb = E.pre_base(nxt) + wr * 64 + 4 * frE;
#pragma unroll
              for (int k = 0; k < 8; ++k) prn[k] = pb[(k >> 2) * HALF + (k & 3)]; } }
          E(acc, cur, wr, wc, frE, fqE, xl, prc);
          if constexpr (Epi::PRE) {
#pragma unroll
              for (int k = 0; k < 8; ++k) prc[k] = prn[k]; } }
        if (!has_next) break;
#pragma unroll
        for (int a = 0; a < 2; ++a)
#pragma unroll
            for (int b = 0; b < 2; ++b)
#pragma unroll
                for (int m = 0; m < 4; ++m)
#pragma unroll
                    for (int n = 0; n < 2; ++n) acc[a][b][m][n] = (f32x4){0.f, 0.f, 0.f, 0.f};
        cur = nxt; cA = nA; cB = nB; ++ui;
        if (wr == 1) PG8_BAR;
    }
    PG8_WAIT_V(0);
    PG8_BAR;
#undef PG8_SA
#undef PG8_SB
#undef PG8_STAGE
#undef PG8_LDA
#undef PG8_LDB
#undef PG8_MMA
#undef PG8_WAIT_V
#undef PG8_WAIT_L
#undef PG8_BAR
#undef PG8_SCHED
}
}

namespace attn {
using bf16x8 = __attribute__((ext_vector_type(8))) short;
using s16x4  = __attribute__((ext_vector_type(4))) short;
using f32x16 = __attribute__((ext_vector_type(16))) float;
using u32x4  = __attribute__((ext_vector_type(4))) unsigned;
typedef unsigned short bf16_t;
constexpr int D = 128, NW = 8, QBLK = 32, KVBLK = 64;
constexpr float SCALE = 0.088388347648318440f;
constexpr float THR = 8.f;
constexpr int LD = NIN;
constexpr int NBUF = 3;
constexpr size_t SHM_V = KVBLK * D * 2, SHM_K = KVBLK * D * 2, SHM_WS = NBUF * (SHM_V + SHM_K), SHM_OST = 0;
constexpr int OST_STRIDE = 272, OST_WAVE = 32 * OST_STRIDE;
constexpr size_t SHM_ATTN = SHM_WS + NW * 64 * 4;
static_assert(NW * OST_WAVE <= SHM_WS, "O staging fits inside the ring");
#define KSWZ(row, colB) ((row) * 256 + ((colB) ^ (((row) & 7) << 4)))
#define SBAR() __builtin_amdgcn_sched_barrier(0)
__device__ __forceinline__ int crow(int r, int hi) { return (r & 3) + 8 * (r >> 2) + 4 * hi; }
__device__ __forceinline__ unsigned cvtpk(float lo, float hi) { unsigned r; asm volatile("v_cvt_pk_bf16_f32 %0, %1, %2" : "=v"(r) : "v"(lo), "v"(hi)); return r; }
__device__ __forceinline__ bf16x8 ld8(const bf16_t* p) { return *reinterpret_cast<const bf16x8*>(p); }

__device__ __forceinline__ float fadd_s(float a, float b) { float r; asm("v_add_f32 %0, %1, %2" : "=v"(r) : "v"(a), "v"(b)); return r; }
__device__ __forceinline__ void expHalf(f32x16& p0) {
#pragma unroll
  for (int r = 0; r < 16; ++r) p0[r] = __builtin_amdgcn_exp2f(p0[r]);
}
__device__ __forceinline__ void finishSM(f32x16& p0, f32x16& p1, float& l_reg, bf16x8& pa0, bf16x8& pa1, bf16x8& pa2, bf16x8& pa3) {
#pragma unroll
  for (int r = 0; r < 16; ++r) p1[r] = __builtin_amdgcn_exp2f(p1[r]);
  asm volatile("s_nop 0" : "+v"(p1));
  float s0 = fadd_s(p0[0], p0[1]), s1 = fadd_s(p0[2], p0[3]), s2 = fadd_s(p0[4], p0[5]), s3 = fadd_s(p0[6], p0[7]);
#pragma unroll
  for (int r = 8; r < 16; r += 4) { s0 = fadd_s(s0, p0[r]); s1 = fadd_s(s1, p0[r + 1]); s2 = fadd_s(s2, p0[r + 2]); s3 = fadd_s(s3, p0[r + 3]); }
#pragma unroll
  for (int r = 0; r < 16; r += 4) { s0 = fadd_s(s0, p1[r]); s1 = fadd_s(s1, p1[r + 1]); s2 = fadd_s(s2, p1[r + 2]); s3 = fadd_s(s3, p1[r + 3]); }
  l_reg = fadd_s(l_reg, fadd_s(fadd_s(s0, s1), fadd_s(s2, s3)));
#define PK4(P, BASE, OUT) do { unsigned a0 = cvtpk(P[BASE + 0], P[BASE + 1]), a1 = cvtpk(P[BASE + 2], P[BASE + 3]);   \
    unsigned b0 = cvtpk(P[BASE + 4], P[BASE + 5]), b1 = cvtpk(P[BASE + 6], P[BASE + 7]);                              \
    asm volatile("s_nop 1" : "+v"(a0), "+v"(a1), "+v"(b0), "+v"(b1));     \
    auto r0 = __builtin_amdgcn_permlane32_swap(a0, b0, false, false); auto r1 = __builtin_amdgcn_permlane32_swap(a1, b1, false, false); \
    u32x4 w = {r0[0], r1[0], r0[1], r1[1]}; OUT = *reinterpret_cast<bf16x8*>(&w); } while (0)
  PK4(p0, 0, pa0); PK4(p0, 8, pa1); PK4(p1, 0, pa2); PK4(p1, 8, pa3);
#undef PK4
}
__device__ __forceinline__ void qkt(f32x16& p0, f32x16& p1, const bf16_t* Ks, const bf16x8* qr, int r32, int hi) {
  p0 = f32x16{}; p1 = f32x16{};
#pragma unroll
  for (int d0 = 0; d0 < 8; ++d0) { int cb = (d0 * 16 + hi * 8) * 2;
    bf16x8 b0 = *reinterpret_cast<const bf16x8*>((const char*)Ks + KSWZ(r32, cb));
    bf16x8 b1 = *reinterpret_cast<const bf16x8*>((const char*)Ks + KSWZ(32 + r32, cb));
    p0 = __builtin_amdgcn_mfma_f32_32x32x16_bf16(b0, qr[d0], p0, 0, 0, 0);
    p1 = __builtin_amdgcn_mfma_f32_32x32x16_bf16(b1, qr[d0], p1, 0, 0, 0); }
}
__device__ __forceinline__ int v_st(int k, int c) { const int kk = (k & ~0xC) | ((k & 4) << 1) | ((k & 8) >> 1); return ((kk >> 3) * 4 + (c >> 5)) * 512 + ((kk & 7) * 32 + (c & 31)) * 2; }
__device__ __forceinline__ int v_rd_base(int lane) { return ((lane & 3) << 3) | (((lane >> 2) & 3) << 6) | (((lane >> 4) & 1) << 5) | (((lane >> 5) & 1) << 8); }
constexpr int v_rd_off(int d0, int ks, int half) { return d0 * 512 + ks * 4096 + half * 2048; }
template <int OFF> __device__ __forceinline__ s16x4 tr_read(int vb) {
  s16x4 r; asm volatile("ds_read_b64_tr_b16 %0, %1 offset:%2" : "=&v"(r) : "v"(vb), "i"(OFF) : "memory"); return r;
}
template <int D0> __device__ __forceinline__ void pv_one(f32x16& od, int vb, bf16x8 pa0, bf16x8 pa1, bf16x8 pa2, bf16x8 pa3) {
  const s16x4 l0 = tr_read<v_rd_off(D0, 0, 0)>(vb), h0 = tr_read<v_rd_off(D0, 0, 1)>(vb), l1 = tr_read<v_rd_off(D0, 1, 0)>(vb), h1 = tr_read<v_rd_off(D0, 1, 1)>(vb);
  const s16x4 l2 = tr_read<v_rd_off(D0, 2, 0)>(vb), h2 = tr_read<v_rd_off(D0, 2, 1)>(vb), l3 = tr_read<v_rd_off(D0, 3, 0)>(vb), h3 = tr_read<v_rd_off(D0, 3, 1)>(vb);
  asm volatile("s_waitcnt lgkmcnt(0)" ::: "memory"); SBAR();
#define PK(L, H) (bf16x8){L[0], L[1], L[2], L[3], H[0], H[1], H[2], H[3]}
  od = __builtin_amdgcn_mfma_f32_32x32x16_bf16(pa0, PK(l0, h0), od, 0, 0, 0);
  od = __builtin_amdgcn_mfma_f32_32x32x16_bf16(pa1, PK(l1, h1), od, 0, 0, 0);
  od = __builtin_amdgcn_mfma_f32_32x32x16_bf16(pa2, PK(l2, h2), od, 0, 0, 0);
  od = __builtin_amdgcn_mfma_f32_32x32x16_bf16(pa3, PK(l3, h3), od, 0, 0, 0);
#undef PK
}
__device__ __forceinline__ void pv_d0(f32x16* o, int vb, bf16x8 pa0, bf16x8 pa1, bf16x8 pa2, bf16x8 pa3) {
  pv_one<0>(o[0], vb, pa0, pa1, pa2, pa3); pv_one<1>(o[1], vb, pa0, pa1, pa2, pa3); pv_one<2>(o[2], vb, pa0, pa1, pa2, pa3); pv_one<3>(o[3], vb, pa0, pa1, pa2, pa3);
}
__device__ __forceinline__ void attn_dense_body(const bf16_t* Qb, const bf16_t* __restrict__ Kh, const bf16_t* __restrict__ Vh, bf16_t* Ob, int seq, char* lds, const int wid,
                                                const float* __restrict__ qg, const float* __restrict__ rope, int t0) {
  const int lane = pg8::lane_id_opq(), tid = wid * 64 + lane;
  const int r32 = lane & 31, hi = lane >> 5;
  bf16_t* V_lds = (bf16_t*)lds; bf16_t* K_lds = (bf16_t*)(lds + NBUF * SHM_V);
  float* ws = (float*)(lds + SHM_WS) + wid * 64; float* li_l = ws;
  float l_reg = 0; f32x16 o[4] = {}; bf16x8 qr[8];
  const bf16_t* Qw = Qb + (long)(wid * QBLK + r32) * LD + hi * 8;
#pragma unroll
  for (int d0 = 0; d0 < 8; ++d0) qr[d0] = ld8(Qw + d0 * 16);
  {
    float y[8][8]; float ss = 0.f;
#pragma unroll
    for (int d0 = 0; d0 < 8; ++d0) { const u32x4 w = __builtin_bit_cast(u32x4, qr[d0]);
      y[d0][0] = __uint_as_float(w.x << 16); y[d0][1] = __uint_as_float(w.x & 0xffff0000u); y[d0][2] = __uint_as_float(w.y << 16); y[d0][3] = __uint_as_float(w.y & 0xffff0000u);
      y[d0][4] = __uint_as_float(w.z << 16); y[d0][5] = __uint_as_float(w.z & 0xffff0000u); y[d0][6] = __uint_as_float(w.w << 16); y[d0][7] = __uint_as_float(w.w & 0xffff0000u);
#pragma unroll
      for (int e = 0; e < 8; ++e) ss += y[d0][e] * y[d0][e]; }
    { auto rr = __builtin_amdgcn_permlane32_swap(__float_as_uint(ss), __float_as_uint(ss), false, false); ss = __uint_as_float(rr[0]) + __uint_as_float(rr[1]); }
    const float rs = (SCALE * 1.4426950408889634f) / sqrtf(ss * (1.f / 128.f) + 1e-6f);
#pragma unroll
    for (int d0 = 0; d0 < 8; ++d0) { const float* gp = qg + d0 * 16 + hi * 8;
#pragma unroll
      for (int e = 0; e < 8; ++e) y[d0][e] *= rs * gp[e]; }
    const int t = t0 + wid * QBLK + r32;
#pragma unroll
    for (int a = 0; a < 2; ++a) {
      const float* cp = rope + (size_t)((a ? (t & 63) : (t >> 6)) * 32 + hi * 8) * 2;
#pragma unroll
      for (int h1 = 0; h1 < 2; ++h1) {
        float c[8], sn[8];
#pragma unroll
        for (int e = 0; e < 8; ++e) { c[e] = cp[(h1 * 16 + e) * 2]; sn[e] = cp[(h1 * 16 + e) * 2 + 1]; }
        const int dA = a * 4 + h1, dB = dA + 2;
#pragma unroll
        for (int e = 0; e < 8; ++e) { const float xa = y[dA][e], xb = y[dB][e]; y[dA][e] = xa * c[e] - xb * sn[e]; y[dB][e] = xb * c[e] + xa * sn[e]; }
      } }
#pragma unroll
    for (int d0 = 0; d0 < 8; ++d0) { u32x4 w = {cvtpk(y[d0][0], y[d0][1]), cvtpk(y[d0][2], y[d0][3]), cvtpk(y[d0][4], y[d0][5]), cvtpk(y[d0][6], y[d0][7])}; qr[d0] = __builtin_bit_cast(bf16x8, w); }
  }
  const int sr = tid >> 4, sc = (tid & 15) * 8, vst0 = v_st(sr, sc), vst1 = v_st(32 + sr, sc);
  const int vb0 = (int)(uintptr_t)V_lds + v_rd_base(lane);
  struct { bf16x8 vs0, vs1, ks0, ks1; } sr_[1];
#define SLOAD(i, k0) do { sr_[i].vs0 = ld8(&Vh[(long)((k0) + sr) * LD + sc]); sr_[i].vs1 = ld8(&Vh[(long)((k0) + 32 + sr) * LD + sc]); \
    sr_[i].ks0 = ld8(&Kh[(long)((k0) + sr) * LD + sc]); sr_[i].ks1 = ld8(&Kh[(long)((k0) + 32 + sr) * LD + sc]); } while (0)
#define SWRITE(off, i) do { *(bf16x8*)((char*)V_lds + (off) + vst0) = sr_[i].vs0;          \
    *(bf16x8*)((char*)V_lds + (off) + vst1) = sr_[i].vs1; int kc = sc * 2;               \
    *(bf16x8*)((char*)K_lds + (off) + KSWZ(sr, kc)) = sr_[i].ks0;                       \
    *(bf16x8*)((char*)K_lds + (off) + KSWZ(32 + sr, kc)) = sr_[i].ks1; } while (0)
#define SWAIT() asm volatile("s_waitcnt vmcnt(0)" ::: "memory")
  f32x16 pA0, pA1, pB0, pB1; bf16x8 pa0, pa1, pa2, pa3; const int NT = seq / KVBLK;
  if (wid >= 4) __builtin_amdgcn_s_setprio(1);
  SLOAD(0, 0); SWAIT(); SWRITE(0, 0);
  SLOAD(0, KVBLK); SWAIT(); SWRITE((int)SHM_V, 0); __syncthreads();
  qkt(pA0, pA1, K_lds, qr, r32, hi); expHalf(pA0);
  int o0 = 0, o1 = (int)SHM_V, o2 = 2 * (int)SHM_V;
#define STEP(PC0, PC1, PN0, PN1, jj, DO_QKT, DO_LOAD) do { \
    SBAR(); if (DO_QKT) qkt(PN0, PN1, (bf16_t*)((char*)K_lds + o1), qr, r32, hi); \
    finishSM(PC0, PC1, l_reg, pa0, pa1, pa2, pa3); SBAR(); \
    if (DO_LOAD) SLOAD(0, ((jj) + 2) * KVBLK); SBAR(); \
    pv_d0(o, vb0 + o0, pa0, pa1, pa2, pa3); if (DO_QKT) expHalf(PN0); \
    if (DO_LOAD) { SWAIT(); SWRITE(o2, 0); } \
    __syncthreads(); \
    { const int t_ = o0; o0 = o1; o1 = o2; o2 = t_; } } while (0)
  int j = 0;
  for (; j + 3 < NT; j += 2) { STEP(pA0, pA1, pB0, pB1, j, true, true); STEP(pB0, pB1, pA0, pA1, j + 1, true, true); }
  STEP(pA0, pA1, pB0, pB1, j, true, false);
  STEP(pB0, pB1, pA0, pA1, j + 1, false, false);
#undef STEP
  __builtin_amdgcn_s_setprio(0);
  { auto rr = __builtin_amdgcn_permlane32_swap(__float_as_uint(l_reg), __float_as_uint(l_reg), false, false); l_reg = __uint_as_float(rr[0]) + __uint_as_float(rr[1]); }
  if (hi == 0) li_l[r32] = l_reg; asm volatile("s_waitcnt lgkmcnt(0)" ::: "memory");
  float rli[16];
#pragma unroll
  for (int r = 0; r < 16; ++r) rli[r] = __builtin_amdgcn_rcpf(li_l[crow(r, hi)]);
  char* stg = lds + SHM_OST + wid * OST_WAVE;
#pragma unroll
  for (int r = 0; r < 16; ++r) { const int orow = crow(r, hi);
#pragma unroll
    for (int d0 = 0; d0 < 4; ++d0) { const float v = o[d0][r] * rli[r]; const unsigned w = cvtpk(v, v); *(bf16_t*)(stg + orow * OST_STRIDE + (d0 * 32 + r32) * 2) = (bf16_t)(w & 0xffffu); } }
  asm volatile("s_waitcnt lgkmcnt(0)" ::: "memory");
  bf16_t* Ow = Ob + (long)(wid * QBLK) * LD;
#pragma unroll
  for (int i = 0; i < 8; ++i) { const int c = i * 64 + lane, row = c >> 4, ch = c & 15; const u32x4 v = *(const u32x4*)(stg + row * OST_STRIDE + ch * 16); *(u32x4*)(Ow + (long)row * LD + ch * 8) = v; }
  asm volatile("s_waitcnt lgkmcnt(0)" ::: "memory");
  __syncthreads();
#undef SLOAD
#undef SWRITE
#undef SWAIT
}
#undef KSWZ
#undef SBAR
}

constexpr size_t MiB = 1u << 20;
constexpr size_t WS_CTL = 0, CTL_ZERO_BYTES = 1 * MiB;
constexpr size_t WS_ROPE = 1 * MiB;
constexpr size_t WS_STATS = 2 * MiB;
constexpr size_t WS_W = 4 * MiB;
constexpr size_t W_IN_T = WS_W;
constexpr size_t W_AO_T = W_IN_T + (size_t)NIN * DM * 2;
constexpr size_t W_SO_T = W_AO_T + (size_t)DM * DM * 2;
constexpr size_t W_OUT_T = W_SO_T + (size_t)DM * DM * 2;
constexpr size_t W_XQ_B = W_OUT_T + (size_t)DM * DM * 2;
constexpr size_t W_XKV_T = W_XQ_B + (size_t)DM * DM * 2;
constexpr size_t W_XO_T = W_XKV_T + (size_t)2 * DM * DM * 2;
constexpr size_t W_UP_T = W_XO_T + (size_t)DM * DM * 2;
constexpr size_t W_DN_T = W_UP_T + (size_t)2 * DFF * DM * 2;
constexpr size_t W_SBLK = W_DN_T + (size_t)DM * DFF * 2;
constexpr size_t WS_WEND = W_SBLK + (size_t)8 * 256 * 256 * 2;
constexpr size_t WS_H = 172 * MiB;
constexpr size_t WS_MEMN = WS_H + (size_t)T * DM * 2;
constexpr size_t WS_KV = WS_MEMN + (size_t)MEMROWS * DM * 2;
constexpr size_t WS_QKT = WS_KV + (size_t)MEMROWS * 2 * DM * 2;
constexpr size_t WS_VWT = WS_QKT + (size_t)NB * 1024 * DM * 2;
constexpr size_t WS_P = WS_VWT + (size_t)NB * 1024 * DM * 2;
constexpr size_t WS_BIG = WS_P + (size_t)T * 1024 * 2;
constexpr size_t WS_END = WS_BIG + (size_t)T * NIN * 2;
static_assert(WS_WEND <= WS_H, "weights fit below H");
constexpr int CW_BAR = 4096;

constexpr int RING_OFF = 0, RING_BYTES = 131072;
constexpr int XCH_OFF = 131072;
constexpr int MISC_OFF = 139264;
constexpr int LDS_BYTES = 147456;
static_assert(attn::SHM_ATTN <= MISC_OFF, "attention LDS fits");

#define GAS __attribute__((address_space(1)))
#define LAS __attribute__((address_space(3)))
typedef unsigned short bf16;
typedef unsigned v4u __attribute__((ext_vector_type(4)));
typedef float f32x4 __attribute__((ext_vector_type(4)));
typedef float f32x2 __attribute__((ext_vector_type(2)));
typedef GAS unsigned gu32;
#define RLX_AGENT __ATOMIC_RELAXED, __HIP_MEMORY_SCOPE_AGENT
#define LDS_WAIT() asm volatile("s_waitcnt lgkmcnt(0)" ::: "memory")
#define VM_WAIT() asm volatile("s_waitcnt vmcnt(0)" ::: "memory")
__device__ __forceinline__ unsigned f2bf(float f) { unsigned u = __builtin_bit_cast(unsigned, f); return (u + 0x7fffu + ((u >> 16) & 1u)) >> 16; }
__device__ __forceinline__ unsigned pk2(float lo, float hi) { return f2bf(lo) | (f2bf(hi) << 16); }
__device__ __forceinline__ float blo(unsigned w) { return __uint_as_float(w << 16); }
__device__ __forceinline__ float bhi(unsigned w) { return __uint_as_float(w & 0xffff0000u); }

#define XB_TMO      128
#define XB_XCNT(j)  (256  + 64 * (j))
#define XB_XSUB(j)  (1280 + 64 * (j))
#define XB_XGEN(j)  (2304 + 64 * (j))
#define XB_TOP      3328
#define XB_TOPGEN   3392
#define XCD_BAR_WORDS 3456
#define XB_SPIN_CAP (1u << 18)
__device__ __forceinline__ unsigned xb_ld(unsigned* p)              { return __hip_atomic_load(p, __ATOMIC_RELAXED, __HIP_MEMORY_SCOPE_AGENT); }
__device__ __forceinline__ unsigned xb_add(unsigned* p, unsigned v) { return __hip_atomic_fetch_add(p, v, __ATOMIC_RELAXED, __HIP_MEMORY_SCOPE_AGENT); }
__device__ __forceinline__ unsigned xb_xcc_id() { return (unsigned)__builtin_amdgcn_s_getreg((3 << 11) | 20) & 0xFu; }
#define XB_SPIN(cond, bar) do { unsigned _sp = 0; while (cond) { __builtin_amdgcn_s_sleep(1); \
    if ((++_sp & 255u) == 0u) { if (xb_ld(&(bar)[XB_TMO])) break; if (_sp > XB_SPIN_CAP) { atomicAdd(&(bar)[XB_TMO], 1u); break; } } } } while (0)
struct XcdBarrier { unsigned* bar; unsigned x; volatile LAS unsigned* st; };
__device__ __forceinline__ XcdBarrier xcd_barrier_post(unsigned* bar, volatile LAS unsigned* st) {
    XcdBarrier b; b.bar = bar; b.x = xb_xcc_id(); b.st = st;
    if (threadIdx.x == 0) (void)xb_add(&bar[XB_XCNT(b.x)], 1u);
    return b;
}
__device__ __forceinline__ void xcd_barrier_complete(unsigned* bar, unsigned x, unsigned& nloc, unsigned& nx) {
    const unsigned G = gridDim.x * gridDim.y * gridDim.z;
    unsigned sum, cnt, mine, sp = 0u;
    for (;;) {
        sum = 0u; cnt = 0u; mine = 0u;
#pragma unroll
        for (unsigned j = 0; j < 16; ++j) { const unsigned c = xb_ld(&bar[XB_XCNT(j)]); sum += c; cnt += (c > 0u) ? 1u : 0u; mine = (j == x) ? c : mine; }
        if (sum == G) break;
        __builtin_amdgcn_s_sleep(1);
        if ((++sp & 255u) == 0u) { if (xb_ld(&bar[XB_TMO])) break; if (sp > XB_SPIN_CAP) { atomicAdd(&bar[XB_TMO], 1u); break; } }
    }
    nloc = mine > 0u ? mine : 1u; nx = cnt > 0u ? cnt : 1u;
}
__device__ __forceinline__ void xcd_barrier(const XcdBarrier& b, const int wave) {
    asm volatile("s_waitcnt vmcnt(0)" ::: "memory");
    __syncthreads();
    if (wave == 0 && pg8::lane_id_opq() == 0) {
        unsigned* bar = b.bar;
        __builtin_amdgcn_s_waitcnt(0);
        unsigned nloc = b.st[0], nx = b.st[1];
        if (nloc == 0u) { xcd_barrier_complete(bar, b.x, nloc, nx); b.st[0] = nloc; b.st[1] = nx; }
        const unsigned old = xb_add(&bar[XB_XSUB(b.x)], 1u);
        const unsigned gen = old / nloc;
        if (old + 1u == (gen + 1u) * nloc) {
            __builtin_amdgcn_fence(__ATOMIC_RELEASE, "agent");
            asm volatile("s_waitcnt vmcnt(0)" ::: "memory");
            const unsigned og = xb_add(&bar[XB_TOP], 1u);
            const unsigned tg = og / nx;
            if (og + 1u == (tg + 1u) * nx) xb_add(&bar[XB_TOPGEN], 1u);
            else XB_SPIN(xb_ld(&bar[XB_TOPGEN]) == tg, bar);
            __builtin_amdgcn_fence(__ATOMIC_ACQUIRE, "agent");
            xb_add(&bar[XB_XGEN(b.x)], 1u);
            asm volatile("s_waitcnt vmcnt(0)" ::: "memory");
        } else {
            XB_SPIN(xb_ld(&bar[XB_XGEN(b.x)]) == gen, bar);
            __builtin_amdgcn_fence(__ATOMIC_ACQUIRE, "agent");
            asm volatile("s_waitcnt vmcnt(0)" ::: "memory");
        }
    }
    __syncthreads();
}

__device__ __forceinline__ int opq(int v) { asm volatile("" : "+v"(v)); return v; }
__device__ __forceinline__ float wave_sum(float v, int lane) {
#pragma unroll
    for (int o = 1; o < 64; o <<= 1) v += pg8::shx(v, o, lane);
    return v;
}
__device__ __forceinline__ void transpose_item(const float* W, int N, bf16* WT, int ldt, int k0, int n0, long drow0, LAS float* scr, int lane, const float* gain = nullptr) {
    float wv[32];
#pragma unroll
    for (int i = 0; i < 32; ++i) { const int kk = 2 * i + (lane >> 5); wv[i] = __builtin_nontemporal_load(&W[(size_t)(k0 + kk) * N + n0 + (lane & 31)]); }
#pragma unroll
    for (int i = 0; i < 32; ++i) { const int kk = 2 * i + (lane >> 5); float w = wv[i]; if (gain) w *= gain[k0 + kk]; scr[kk * 33 + (lane & 31)] = w; }
    LDS_WAIT(); asm volatile("" ::: "memory");
    const int c = lane & 7;
#pragma unroll
    for (int j = 0; j < 4; ++j) { const int n = (lane >> 3) + 8 * j; const LAS float* s = scr + (8 * c) * 33 + n;
        v4u o; o.x = pk2(s[0 * 33], s[1 * 33]); o.y = pk2(s[2 * 33], s[3 * 33]); o.z = pk2(s[4 * 33], s[5 * 33]); o.w = pk2(s[6 * 33], s[7 * 33]);
        *(GAS v4u*)(WT + (size_t)(drow0 + n) * ldt + k0 + 8 * c) = o; }
    LDS_WAIT(); asm volatile("" ::: "memory");
}
__device__ __forceinline__ void rms_row_to_bf16(const float* xrow, const float* gain, bf16* orow, float* xcopy, int lane) {
    const GAS f32x4* xr = (const GAS f32x4*)xrow + lane;
    f32x4 v[8]; float s = 0.f;
#pragma unroll
    for (int j = 0; j < 8; ++j) { v[j] = xr[64 * j]; s += (v[j].x * v[j].x + v[j].y * v[j].y) + (v[j].z * v[j].z + v[j].w * v[j].w); }
    if (xcopy) { GAS f32x4* xc = (GAS f32x4*)xcopy + lane;
#pragma unroll
        for (int j = 0; j < 8; ++j) xc[64 * j] = v[j]; }
    const float rs = 1.0f / sqrtf(wave_sum(s, lane) * (1.f / DM) + EPS);
    const GAS f32x4* gr = (const GAS f32x4*)gain + lane;
    GAS unsigned long long* o8 = (GAS unsigned long long*)orow + lane;
#pragma unroll
    for (int j = 0; j < 8; ++j) { const f32x4 g = gr[64 * j];
        o8[64 * j] = (unsigned long long)pk2(v[j].x * rs * g.x, v[j].y * rs * g.y) | ((unsigned long long)pk2(v[j].z * rs * g.z, v[j].w * rs * g.w) << 32); }
}

__device__ __forceinline__ void x_row_init2(const float* xrow, bf16* orow, float* st, float* rsf, int lane) {
    f32x4 v[2][8];
#pragma unroll
    for (int r = 0; r < 2; ++r)
#pragma unroll
        for (int j = 0; j < 8; ++j) v[r][j] = ((const GAS f32x4*)(xrow + (size_t)r * DM) + lane)[64 * j];
#pragma unroll
    for (int r = 0; r < 2; ++r) {
        GAS unsigned long long* o8 = (GAS unsigned long long*)(orow + (size_t)r * DM) + lane;
        float s = 0.f;
#pragma unroll
        for (int j = 0; j < 8; ++j) { const f32x4 w = v[r][j]; s += (w.x * w.x + w.y * w.y) + (w.z * w.z + w.w * w.w);
            o8[64 * j] = (unsigned long long)pk2(w.x, w.y) | ((unsigned long long)pk2(w.z, w.w) << 32); }
        s = wave_sum(s, lane);
        if (lane < 8) st[r * 8 + lane] = lane == 0 ? s : 0.f;
        if (lane == 0) rsf[r] = 1.0f / sqrtf(s * (1.f / DM) + EPS);
    }
}

struct Args { const float* in[26]; float* out; unsigned char* ws; };
static_assert(sizeof(Args) == 28 * 8, "no padding in Args");

__global__ void __launch_bounds__(512, 2) fwd_kernel(Args args) {
    extern __shared__ __attribute__((aligned(16))) unsigned char lds[];
    LAS unsigned char* L = (LAS unsigned char*)lds;
    volatile LAS unsigned* MISC = (volatile LAS unsigned*)(L + MISC_OFF);
    const int tid = threadIdx.x, wave = __builtin_amdgcn_readfirstlane(tid >> 6);
#define lane0 (pg8::lane_id_opq())
    const int G = gridDim.x, bx = blockIdx.x;
    const int vcu = (G % 8 == 0) ? (bx % 8) * (G / 8) + bx / 8 : bx;
    const int gw = vcu * 8 + wave, NGW = G * 8;
    for (int u = tid; u < 64; u += 512) ((LAS unsigned*)(L + MISC_OFF))[u] = 0u;
    __syncthreads();
    XcdBarrier bar = xcd_barrier_post((unsigned*)(args.ws + WS_CTL) + CW_BAR, MISC + 8);
#define GRID_BAR() xcd_barrier(bar, wave)
    LAS unsigned char* const RING = L + RING_OFF;
    LAS unsigned char* const XCH = L + XCH_OFF;
typedef const Args __attribute__((address_space(4))) CArgs;
constexpr int I_IN = (DM / 64) * (NIN / 32), I_SQ = (DM / 64) * (DM / 32), I_KV = (DM / 64) * (2 * DM / 32), I_UP = (DM / 64) * (2 * DFF / 32), I_DN = (DFF / 64) * (DM / 32);
constexpr int NITEMS = I_IN + 4 * I_SQ + I_KV + I_UP + I_DN, I_EARLY7 = I_IN, I_EARLYU = I_IN + 4 * I_SQ + I_KV;
#define CONV_ITEMS(LL, IT_LO, IT_HI, W0, NW) do { \
    const float* w_in = ka->in[5] + (size_t)(LL) * DM * NIN; const float* w_ao = ka->in[8] + (size_t)(LL) * DM * DM; const float* w_so = ka->in[13] + (size_t)(LL) * DM * DM; \
    const float* w_out = ka->in[14] + (size_t)(LL) * DM * DM; const float* w_xkv = ka->in[18] + (size_t)(LL) * DM * 2 * DM; const float* w_xo = ka->in[19] + (size_t)(LL) * DM * DM; \
    const float* w_up = ka->in[21] + (size_t)(LL) * DM * 2 * DFF; const float* w_dn = ka->in[24] + (size_t)(LL) * DFF * DM; const float* gmix = ka->in[4] + (size_t)(LL) * DM; const float* gffn = ka->in[20] + (size_t)(LL) * DM; \
    for (int it = (IT_LO) + (W0); it < (IT_HI); it += (NW)) { \
                int r = it; \
                if (r < I_IN) { const int nb = NIN / 32; const int n0 = 32 * (r % nb); long d0 = n0; \
                    if (n0 >= C_GA) { const int iss = n0 >= C_GS, ch = n0 - (iss ? C_GS : C_GA); d0 = C_GA + (long)(ch / 128) * 256 + iss * 128 + (ch % 128); } \
                    transpose_item(w_in, NIN, (bf16*)(ws + W_IN_T), DM, 64 * (r / nb), n0, d0, scr, lane, gmix); continue; } r -= I_IN; \
                if (r < I_SQ) { const int nb = DM / 32; transpose_item(w_ao, DM, (bf16*)(ws + W_AO_T), DM, 64 * (r / nb), 32 * (r % nb), 32 * (r % nb), scr, lane); continue; } r -= I_SQ; \
                if (r < I_SQ) { const int nb = DM / 32; transpose_item(w_so, DM, (bf16*)(ws + W_SO_T), DM, 64 * (r / nb), 32 * (r % nb), 32 * (r % nb), scr, lane); continue; } r -= I_SQ; \
                if (r < I_SQ) { const int nb = DM / 32; transpose_item(w_out, DM, (bf16*)(ws + W_OUT_T), DM, 64 * (r / nb), 32 * (r % nb), 32 * (r % nb), scr, lane); continue; } r -= I_SQ; \
                if (r < I_SQ) { const int nb = DM / 32; transpose_item(w_xo, DM, (bf16*)(ws + W_XO_T), DM, 64 * (r / nb), 32 * (r % nb), 32 * (r % nb), scr, lane); continue; } r -= I_SQ; \
                if (r < I_KV) { const int nb = 2 * DM / 32; transpose_item(w_xkv, 2 * DM, (bf16*)(ws + W_XKV_T), DM, 64 * (r / nb), 32 * (r % nb), 32 * (r % nb), scr, lane); continue; } r -= I_KV; \
                if (r < I_UP) { const int nb = 2 * DFF / 32; const int n0 = 32 * (r % nb); const int isb = n0 >= DFF, ch = n0 - isb * DFF; \
                    transpose_item(w_up, 2 * DFF, (bf16*)(ws + W_UP_T), DM, 64 * (r / nb), n0, (long)(ch / 128) * 256 + isb * 128 + (ch % 128), scr, lane, gffn); continue; } r -= I_UP; \
                { const int nb = DM / 32; transpose_item(w_dn, DM, (bf16*)(ws + W_DN_T), DFF, 64 * (r / nb), 32 * (r % nb), 32 * (r % nb), scr, lane); } \
            } \
    } while (0)
#define PHASE_ENV \
    CArgs* ka = (CArgs*)__builtin_amdgcn_kernarg_segment_ptr(); asm volatile("" : "+s"(ka)); \
    int G_o = (int)gridDim.x; asm volatile("" : "+s"(G_o)); const int G = G_o, NGW = G_o * 8; (void)G; (void)NGW; \
    unsigned char* const ws = ka->ws; float* const X = ka->out; \
    bf16* const Hb = (bf16*)(ws + WS_H); bf16* const MEMN = (bf16*)(ws + WS_MEMN); bf16* const KV = (bf16*)(ws + WS_KV); bf16* const QKT = (bf16*)(ws + WS_QKT); \
    bf16* const VWT = (bf16*)(ws + WS_VWT); bf16* const Pb = (bf16*)(ws + WS_P); bf16* const BIG = (bf16*)(ws + WS_BIG); f32x2* const ROPE = (f32x2*)(ws + WS_ROPE); \
    float* const STATS = (float*)(ws + WS_STATS); float* const RSF0 = (float*)(ws + WS_STATS + 3 * MiB / 2); float* const RSF2 = RSF0 + T; bf16* const VLT = (bf16*)ka->out; float* const LNST = (float*)((char*)ka->out + (size_t)200 * MiB);   \
    (void)X; (void)Hb; (void)MEMN; (void)KV; (void)QKT; (void)VWT; (void)Pb; (void)BIG; (void)ROPE; (void)STATS; (void)RSF0; (void)RSF2; (void)VLT; (void)LNST

    for (int l = 0; l < DEPTH; ++l) {
#if PH(0)
        { PHASE_ENV;
        {
            const int lane = opq(lane0);
            LAS float* scr = (LAS float*)(RING + wave * 16384);
            const float* w_in = ka->in[5] + (size_t)l * DM * NIN;
            const float* w_ao = ka->in[8] + (size_t)l * DM * DM;
            const float* w_so = ka->in[13] + (size_t)l * DM * DM;
            const float* w_out = ka->in[14] + (size_t)l * DM * DM;
            const float* w_xq = ka->in[17] + (size_t)l * DM * DM;
            const float* w_xkv = ka->in[18] + (size_t)l * DM * 2 * DM;
            const float* w_xo = ka->in[19] + (size_t)l * DM * DM;
            const float* w_up = ka->in[21] + (size_t)l * DM * 2 * DFF;
            const float* w_dn = ka->in[24] + (size_t)l * DFF * DM;
            const float* gmix = ka->in[4] + (size_t)l * DM; const float* gffn = ka->in[20] + (size_t)l * DM; const float* gxn = ka->in[15] + (size_t)l * DM;
            { const int b7 = (NB * 8 * 4) % G, bu = ((T / 256) * (2 * DFF / 256)) % G;
              const int lo = l == 0 ? 0 : (bu > 0 ? I_EARLYU : (b7 > 0 ? I_EARLY7 : 0));
              CONV_ITEMS(l, lo, NITEMS, gw, NGW); }
            { const size_t n8 = (size_t)DM * DM / 8; bf16* dst = (bf16*)(ws + W_XQ_B);
              for (size_t i = (size_t)gw * 64 + lane; i < n8; i += (size_t)NGW * 64) { const float gd = gxn[i >> 8]; const f32x4 a = *(const f32x4*)(w_xq + i * 8) * gd, b = *(const f32x4*)(w_xq + i * 8 + 4) * gd;
                  v4u o; o.x = pk2(a.x, a.y); o.y = pk2(a.z, a.w); o.z = pk2(b.x, b.y); o.w = pk2(b.z, b.w); *(v4u*)(dst + i * 8) = o; } }
            { const float* wsp = ka->in[11] + (size_t)l * 8 * 128 * 128; bf16* dst = (bf16*)(ws + W_SBLK); const size_t n8 = (size_t)8 * 256 * 256 / 8;
              for (size_t i = (size_t)gw * 64 + lane; i < n8; i += (size_t)NGW * 64) { const int e = (int)(i * 8), g = e >> 16, pp = (e >> 8) & 255, qq = e & 255;
                  v4u o = (v4u){0u, 0u, 0u, 0u};
                  if ((pp >> 7) == (qq >> 7)) { const float* s = wsp + ((size_t)g * 128 + (pp & 127)) * 128 + (qq & 127); const f32x4 a = *(const f32x4*)s, b = *(const f32x4*)(s + 4);
                      o.x = pk2(a.x, a.y); o.y = pk2(a.z, a.w); o.z = pk2(b.x, b.y); o.w = pk2(b.z, b.w); }
                  *(v4u*)(dst + i * 8) = o; } }
            if (l == 0) for (int m = gw * 2; m < T; m += NGW * 2) {
                const float* src = m < 4 * SEQ ? ka->in[0] + (size_t)m * DM : ka->in[1] + (size_t)(m - 4 * SEQ) * DM;
                x_row_init2(src, Hb + (size_t)m * DM, STATS + (size_t)m * 8, RSF0 + m, lane);
            }
            else for (int i = gw * 64 + lane; i < T; i += NGW * 64) {
                const f32x4 a = *(const f32x4*)(STATS + (size_t)i * 8), b = *(const f32x4*)(STATS + (size_t)i * 8 + 4);
                RSF0[i] = 1.0f / sqrtf(((a[0] + a[1]) + (a[2] + a[3]) + (b[0] + b[1]) + (b[2] + b[3])) * (1.f / DM) + EPS); }
            const float* gmem = ka->in[16] + (size_t)l * DM;
            for (int m = gw; m < MEMROWS; m += NGW) {
                const float* src = m < 4 * NMEM ? ka->in[2] + (size_t)m * DM : ka->in[3] + (size_t)(m - 4 * NMEM) * DM;
                rms_row_to_bf16(src, gmem, MEMN + (size_t)m * DM, nullptr, lane);
            }
            if (l == 0 && bx == 0 && wave == 0 && lane < 32) {
                double inv = 1.0; for (int j = 0; j < lane; ++j) inv *= 0.74989420933245582;
                const double t2 = inv * inv; double c1 = 1.0, s1 = inv, tc = 1.0, tsn = inv;
                for (int k = 1; k < 14; ++k) { tc *= -t2 / (double)((2 * k - 1) * (2 * k)); c1 += tc; tsn *= -t2 / (double)((2 * k) * (2 * k + 1)); s1 += tsn; }
                double c = 1.0, s = 0.0;
                for (int pos = 0; pos < 64; ++pos) { ROPE[pos * 32 + lane] = (f32x2){(float)c, (float)s}; const double cn = c * c1 - s * s1, sn = s * c1 + c * s1; c = cn; s = sn; }
            }
        }
        }
#endif
        GRID_BAR();
#if PH(1)
        { PHASE_ENV;
        {
            pg8::Gemm g{MEMN, (const bf16*)(ws + W_XKV_T), DM, DM, DM, 0, 0, 0, 0}; pg8::Sched S; S.init(1, 1, MEMROWS / 256, 2 * DM / 256, G, G - 1 - bx);
            pg8::EpiBf16<0> E{KV, 2 * DM, 0, 0, nullptr, nullptr};
            pg8::gemm_phase(RING, XCH, g, S, E, wave);
        }
        {
            pg8::Gemm g{Hb, (const bf16*)(ws + W_IN_T), DM, DM, DM, 0, 0, 0, 0}; pg8::Sched S; S.init(1, 1, T / 256, 28, G, bx, 1);
            pg8::EpiBf16<1, true> E{BIG, NIN, 0, 0, RSF0, LNST};
            pg8::gemm_phase(RING, XCH, g, S, E, wave);
        }
        }
#endif
        GRID_BAR();
#if PH(2)
        { PHASE_ENV;
        {
            const int lane = opq(lane0);
            const float* qg = ka->in[6] + (size_t)l * 128; const float* kg = ka->in[7] + (size_t)l * 128;
            const int hh = lane >> 4, li = lane & 15;
            const int a_ = li >> 3, p_ = (li >> 2) & 1, j0 = (li & 3) * 8;
            for (int row0 = gw * 4; row0 < T; row0 += NGW * 4) {
                bf16* p0 = BIG + (size_t)row0 * NIN + C_K + hh * 128 + li * 8;
                v4u wq[4];
#pragma unroll
                for (int rr = 0; rr < 4; ++rr) wq[rr] = *(const v4u*)(p0 + (size_t)rr * NIN);
#pragma unroll
                for (int rr = 0; rr < 4; ++rr) {
                    const int t = (row0 + rr) & (SEQ - 1), pos = a_ ? (t & 63) : (t >> 6);
                    const v4u w = wq[rr];
                    float y[8] = {blo(w.x), bhi(w.x), blo(w.y), bhi(w.y), blo(w.z), bhi(w.z), blo(w.w), bhi(w.w)};
                    float s = 0.f;
#pragma unroll
                    for (int e = 0; e < 8; ++e) s += y[e] * y[e];
                    s += pg8::shx(s, 1, lane); s += pg8::shx(s, 2, lane); s += pg8::shx(s, 4, lane); s += pg8::shx(s, 8, lane);
                    const float rs = 1.0f / sqrtf(s * (1.f / 128.f) + EPS);
                    const float* gv = kg + li * 8;
                    float o[8];
#pragma unroll
                    for (int e = 0; e < 8; ++e) y[e] = y[e] * rs * gv[e];
#pragma unroll
                    for (int e = 0; e < 8; ++e) { const float yp = pg8::shx(y[e], 4, lane); const f32x2 cs = ROPE[pos * 32 + j0 + e]; o[e] = y[e] * cs.x + (p_ ? yp : -yp) * cs.y; }
                    v4u ow; ow.x = pk2(o[0], o[1]); ow.y = pk2(o[2], o[3]); ow.z = pk2(o[4], o[5]); ow.w = pk2(o[6], o[7]);
                    *(v4u*)(p0 + (size_t)rr * NIN) = ow;
                }
            }
            const float* lng = ka->in[9] + (size_t)l * DM; const float* lnb = ka->in[10] + (size_t)l * DM;
            for (int it = vcu; it < (T / 64) * 2; it += G) {
                const int blk = it >> 1, half = it & 1, t0 = blk * 64 + wave * 8;
                float my_mu = 0.f, my_rs = 0.f;
                {
                    const int r = lane & 7;
                    const float* q = LNST + (size_t)(t0 + r) * 16;
                    const f32x4 a = *(const f32x4*)q, b = *(const f32x4*)(q + 4), c = *(const f32x4*)(q + 8), d = *(const f32x4*)(q + 12);
                    const float s = ((a[0] + a[2]) + (b[0] + b[2])) + ((c[0] + c[2]) + (d[0] + d[2])), s2 = ((a[1] + a[3]) + (b[1] + b[3])) + ((c[1] + c[3]) + (d[1] + d[3]));
                    const float mu = s * (1.f / DM); float var = s2 * (1.f / DM) - mu * mu; var = var < 0.f ? 0.f : var;
                    my_mu = mu; my_rs = 1.0f / sqrtf(var + EPS);
                }
                const int z1 = t0 >> 8, tt = t0 & 255;
#pragma unroll
                for (int q = 0; q < 2; ++q) {
                    const int c0 = half * 1024 + q * 512 + lane * 8;
                    float gch[8], bch[8];
#pragma unroll
                    for (int e = 0; e < 8; ++e) { gch[e] = lng[c0 + e]; bch[e] = lnb[c0 + e]; }
                    unsigned ow[8][4];
                    v4u wr8[8];
#pragma unroll
                    for (int r = 0; r < 8; ++r) wr8[r] = *(const v4u*)(BIG + (size_t)(t0 + r) * NIN + C_VS + c0);
#pragma unroll
                    for (int rp2 = 0; rp2 < 4; ++rp2) {
                        const v4u wa = wr8[2 * rp2], wb = wr8[2 * rp2 + 1];
                        const float mua = __int_as_float(__builtin_amdgcn_readlane(__float_as_int(my_mu), 2 * rp2)), rsa = __int_as_float(__builtin_amdgcn_readlane(__float_as_int(my_rs), 2 * rp2)), mub = __int_as_float(__builtin_amdgcn_readlane(__float_as_int(my_mu), 2 * rp2 + 1)), rsb = __int_as_float(__builtin_amdgcn_readlane(__float_as_int(my_rs), 2 * rp2 + 1));
                        const float fa[8] = {blo(wa.x), bhi(wa.x), blo(wa.y), bhi(wa.y), blo(wa.z), bhi(wa.z), blo(wa.w), bhi(wa.w)};
                        const float fb[8] = {blo(wb.x), bhi(wb.x), blo(wb.y), bhi(wb.y), blo(wb.z), bhi(wb.z), blo(wb.w), bhi(wb.w)};
#pragma unroll
                        for (int e = 0; e < 8; ++e) ow[e][rp2] = pg8::cvt_pk_bf16((fa[e] - mua) * rsa * gch[e] + bch[e], (fb[e] - mub) * rsb * gch[e] + bch[e]);
                    }
#pragma unroll
                    for (int e = 0; e < 8; ++e) { v4u o; o.x = ow[e][0]; o.y = ow[e][1]; o.z = ow[e][2]; o.w = ow[e][3];
                        *(LAS v4u*)(RING + (q * 512 + lane * 8 + e) * 128 + ((wave ^ (lane & 7)) << 4)) = o; }
                }
                __syncthreads();
                {
                    const int p8 = lane & 7, chl = lane >> 3;
                    bf16* dst = VLT + ((size_t)(blk >> 2) * DM + half * 1024 + wave * 128 + chl) * 256 + (blk & 3) * 64 + p8 * 8;
                    v4u rr[16];
#pragma unroll
                    for (int i = 0; i < 16; ++i) { const int ch = wave * 128 + i * 8 + chl; rr[i] = *(const LAS v4u*)(RING + ch * 128 + ((p8 ^ ((ch >> 3) & 7)) << 4)); }
#pragma unroll
                    for (int i = 0; i < 16; ++i) *(v4u*)(dst + (size_t)i * 8 * 256) = rr[i];
                }
                __syncthreads();
            }
        }
        {
            pg8::Gemm g{KV, (const bf16*)(ws + W_XQ_B), 2 * DM, DM, 512, (long)NMEM * 2 * DM, 512, 0, 512}; pg8::Sched S; S.init(NB * 4, 4, 1, 8, G, bx);
            pg8::EpiBf16<0> E{QKT, DM, (long)1024 * DM, (long)256 * DM, nullptr, nullptr};
            pg8::gemm_phase(RING, XCH, g, S, E, wave);
        }
        {
            pg8::Gemm g{(const bf16*)(ws + W_XO_T), KV + DM, DM, 2 * DM, 512, 0, 512, (long)NMEM * 2 * DM, 512}; pg8::Sched S; S.init(NB * 4, 4, 8, 1, G, G - 1 - bx);
            pg8::EpiBf16<0> E{VWT, 1024, (long)DM * 1024, 256, nullptr, nullptr};
            pg8::gemm_phase(RING, XCH, g, S, E, wave);
        }
        }
#endif
        GRID_BAR();
#if PH(3)
        { PHASE_ENV;
        {
            for (int i = 0; ; ++i) {
                const int U = i * G + vcu; if (U >= NB * 128) break;
                const int qb = U & 7, hq = ((U >> 5) & 3) * 4 + ((U >> 3) & 3), kvh = (U >> 5) & 3, b = U >> 7;
                const bf16* Qb = BIG + (size_t)(b * SEQ + qb * 256) * NIN + C_Q + hq * 128;
                const bf16* Kh = BIG + (size_t)(b * SEQ) * NIN + C_K + kvh * 128;
                const bf16* Vh = BIG + (size_t)(b * SEQ) * NIN + C_V + kvh * 128;
                attn::attn_dense_body(Qb, Kh, Vh, (bf16*)Qb, SEQ, (char*)lds, wave, ka->in[6] + (size_t)l * 128, (const float*)ROPE, qb * 256);
            }
        }
        {
            pg8::Gemm g{(const bf16*)(ws + W_SBLK), VLT, 256, 256, 256, 0, (long)256 * 256, (long)DM * 256, (long)256 * 256}; pg8::Sched S; S.init(T / 256 * 8, 8, 1, 1, G, bx);
            pg8::EpiSpatial E{BIG + C_U, NIN, ka->in[12] + (size_t)l * 8 * 128};
            pg8::gemm_phase(RING, XCH, g, S, E, wave);
        }
        {
            pg8::Gemm g{Hb, (const bf16*)(ws + W_IN_T) + (size_t)28 * 256 * DM, DM, DM, DM, 0, 0, 0, 0}; pg8::Sched S; S.init(1, 1, T / 256, 16, G, bx);
            pg8::EpiBf16<1, true> E{BIG, NIN, 0, 0, RSF0, LNST, 28};
            pg8::gemm_phase(RING, XCH, g, S, E, wave);
        }
        }
#endif
        GRID_BAR();
#if PH(4)
        { PHASE_ENV;
        {
            pg8::Gemm g{BIG + C_Q, (const bf16*)(ws + W_AO_T), NIN, DM, 2 * DM, 0, 0, 0, 0, (long)(C_U - C_Q - DM) * 2, (long)W_SO_T - (long)W_AO_T - (long)DM * 2, DM / 64};
            pg8::Sched S; S.init(1, 1, T / 256, DM / 256, G, bx, 1);
            pg8::EpiMixF E{BIG + C_GA, BIG + C_GS, BIG + C_VS, NIN};
            pg8::gemm_phase(RING, XCH, g, S, E, wave);
        }
        }
#endif
        GRID_BAR();
#if PH(5)
        { PHASE_ENV;
        {
            pg8::Gemm g{BIG + C_VS, (const bf16*)(ws + W_OUT_T), NIN, DM, DM, 0, 0, 0, 0}; pg8::Sched S; S.init(1, 1, T / 256, DM / 256, G, bx);
            pg8::EpiRes E{Hb, DM, 0, STATS, 0};
            pg8::gemm_phase(RING, XCH, g, S, E, wave);
        }
        }
#endif
        GRID_BAR();
#if PH(7)
        { PHASE_ENV;
        {
            pg8::Gemm g{Hb, QKT, DM, DM, DM, (long)SEQ * DM, 0, (long)1024 * DM, 0}; pg8::Sched S; S.init(NB, 1, 8, 4, G, bx, 1);
            pg8::EpiSoftmax E{Pb, 1024, (long)SEQ * 1024, 0.044194173824159216f * 1.4426950408889634f, STATS, SEQ};
            pg8::gemm_phase(RING, XCH, g, S, E, wave);
        }
        { const int b7 = (NB * 8 * 4) % G;
          if (l + 1 < DEPTH && b7 > 0 && bx >= b7) { const int lane = opq(lane0); LAS float* scr = (LAS float*)(RING + wave * 16384);
              CONV_ITEMS(l + 1, 0, I_EARLY7, (bx - b7) * 8 + wave, (G - b7) * 8); } }
        }
#endif
        GRID_BAR();
#if PH(8)
        { PHASE_ENV;
        {
            pg8::Gemm g{Pb, VWT, 1024, 1024, 1024, (long)SEQ * 1024, 0, (long)DM * 1024, 0}; pg8::Sched S; S.init(NB, 1, 8, 8, G, bx);
            pg8::EpiRes E{Hb, DM, (long)SEQ * DM, STATS, SEQ};
            pg8::gemm_phase(RING, XCH, g, S, E, wave);
        }
        }
#endif
        GRID_BAR();
#if PH(10)
        { PHASE_ENV; const int lane = opq(lane0);
          for (int i = gw * 64 + lane; i < T; i += NGW * 64) { const f32x4 a = *(const f32x4*)(STATS + (size_t)i * 8), b = *(const f32x4*)(STATS + (size_t)i * 8 + 4);
              RSF2[i] = 1.0f / sqrtf(((a[0] + a[1]) + (a[2] + a[3]) + (b[0] + b[1]) + (b[2] + b[3])) * (1.f / DM) + EPS); } }
        GRID_BAR();
#define FFN_ENV PHASE_ENV; bf16* const ACT = BIG + (size_t)T * DFF;   float* const EA = (float*)BIG;   float* const EB = EA + (size_t)(T / 256) * 4 * DFF;   (void)ACT; (void)EA; (void)EB
        { FFN_ENV;
            pg8::Gemm g{Hb, (const bf16*)(ws + W_UP_T), DM, DM, DM, 0, 0, 0, 0}; pg8::Sched S; S.init(1, 1, T / 256, 2 * DFF / 256, G, bx, 1);
            pg8::EpiUp E{ACT, DFF, RSF2, ka->in[22] + (size_t)l * 3 * DFF, ka->in[23] + (size_t)l * DFF, EA, EB};
            pg8::gemm_phase(RING, XCH, g, S, E, wave);
            { const int bu = ((T / 256) * (2 * DFF / 256)) % G, b7 = (NB * 8 * 4) % G;
              if (l + 1 < DEPTH && bu > 0 && bx >= bu) { const int lane = opq(lane0); LAS float* scr = (LAS float*)(RING + wave * 16384);
                  CONV_ITEMS(l + 1, b7 > 0 ? I_EARLY7 : 0, I_EARLYU, (bx - bu) * 8 + wave, (G - bu) * 8); } }
        }
        GRID_BAR();
        { FFN_ENV; const int lane = opq(lane0);
            const float* cw = ka->in[22] + (size_t)l * 3 * DFF; const float* cb = ka->in[23] + (size_t)l * DFF;
            constexpr int NC8 = DFF / 8, NIT = (T / 256) * 2 * NC8;
            for (int it = gw * 64 + lane; it < NIT; it += NGW * 64) {
                const int c8 = it % NC8, tw = it / NC8, pm = tw >> 1, bot = tw & 1, c0 = c8 * 8;
                const float* ac = EA + ((size_t)pm * 4 + (bot ? 3 : 0)) * DFF + c0;
                const float* ap = bot ? EA + ((size_t)pm * 4 + 2) * DFF + c0 : EA + ((size_t)(pm - 1) * 4 + 3) * DFF + c0;
                const float* an = bot ? EA + ((size_t)(pm + 1) * 4 + 0) * DFF + c0 : EA + ((size_t)pm * 4 + 1) * DFF + c0;
                const bool pz = !bot && (pm & 7) == 0, nz = bot && (pm & 7) == 7;
                const float* bp = EB + ((size_t)pm * 2 + bot) * DFF + c0;
                float o[8];
#pragma unroll
                for (int h = 0; h < 2; ++h) {
                    const f32x4 z = (f32x4){0.f, 0.f, 0.f, 0.f};
                    const f32x4 vc = *(const f32x4*)(ac + 4 * h), vp = pz ? z : *(const f32x4*)((pz ? ac : ap) + 4 * h), vn = nz ? z : *(const f32x4*)((nz ? ac : an) + 4 * h), vb = *(const f32x4*)(bp + 4 * h);
                    const f32x4 w0 = *(const f32x4*)(cw + c0 + 4 * h), w1 = *(const f32x4*)(cw + DFF + c0 + 4 * h), w2 = *(const f32x4*)(cw + 2 * DFF + c0 + 4 * h), bb = *(const f32x4*)(cb + c0 + 4 * h);
#pragma unroll
                    for (int e = 0; e < 4; ++e) o[4 * h + e] = pg8::gelu_t(bb[e] + w0[e] * vp[e] + w1[e] * vc[e] + w2[e] * vn[e]) * vb[e]; }
                v4u ow; ow.x = pk2(o[0], o[1]); ow.y = pk2(o[2], o[3]); ow.z = pk2(o[4], o[5]); ow.w = pk2(o[6], o[7]);
                *(v4u*)(ACT + (size_t)(pm * 256 + (bot ? 255 : 0)) * DFF + c0) = ow;
            }
        }
        GRID_BAR();
        { FFN_ENV;
            pg8::Gemm g{ACT, (const bf16*)(ws + W_DN_T), DFF, DFF, DFF, 0, 0, 0, 0}; pg8::Sched S; S.init(1, 1, T / 256, DM / 256, G, bx);
            pg8::EpiRes E{Hb, DM, 0, STATS, 0};
            pg8::gemm_phase(RING, XCH, g, S, E, wave);
        }
        GRID_BAR();
#endif
    }
    { PHASE_ENV;
        const int lane = opq(lane0);
        const float* gfin = ka->in[25];
        for (int m0 = T - 4 - gw * 4; m0 >= 0; m0 -= NGW * 4) {
            v4u wq[4][4];
#pragma unroll
            for (int r = 0; r < 4; ++r)
#pragma unroll
                for (int j = 0; j < 4; ++j) wq[r][j] = ((const v4u*)(Hb + (size_t)(m0 + r) * DM) + lane)[64 * j];
#pragma unroll
            for (int r = 0; r < 4; ++r) {
                float v[4][8]; float s = 0.f;
#pragma unroll
                for (int j = 0; j < 4; ++j) { const v4u w = wq[r][j]; v[j][0] = blo(w.x); v[j][1] = bhi(w.x); v[j][2] = blo(w.y); v[j][3] = bhi(w.y); v[j][4] = blo(w.z); v[j][5] = bhi(w.z); v[j][6] = blo(w.w); v[j][7] = bhi(w.w);
#pragma unroll
                    for (int e = 0; e < 8; ++e) s += v[j][e] * v[j][e]; }
                const float rs = 1.0f / sqrtf(wave_sum(s, lane) * (1.f / DM) + EPS);
#pragma unroll
                for (int j = 0; j < 4; ++j) { const float* gp = gfin + j * 512 + lane * 8; float* op = X + (size_t)(m0 + r) * DM + j * 512 + lane * 8;
                    const f32x4 g0 = *(const f32x4*)gp, g1 = *(const f32x4*)(gp + 4);
                    *(f32x4*)op = (f32x4){v[j][0] * rs * g0.x, v[j][1] * rs * g0.y, v[j][2] * rs * g0.z, v[j][3] * rs * g0.w};
                    *(f32x4*)(op + 4) = (f32x4){v[j][4] * rs * g1.x, v[j][5] * rs * g1.y, v[j][6] * rs * g1.z, v[j][7] * rs * g1.w}; }
            }
        }
    }
}

extern "C" void kernel_launch(void* const* d_in, const int* in_sizes, int n_in, void* d_out, int out_size, void* d_ws, size_t ws_size, hipStream_t stream) {
    static int grid = 0;
    if (grid == 0) {
        if (n_in != 26 || out_size != T * DM || ws_size < WS_END) { fprintf(stderr, "kernel_launch: shape/workspace mismatch: n_in %d out %d ws %zu (need %zu)\n", n_in, out_size, ws_size, (size_t)WS_END); grid = -1; return; }
        int dev = 0, cus = 0, per_cu = 0;
        if (hipGetDevice(&dev) != hipSuccess || hipDeviceGetAttribute(&cus, hipDeviceAttributeMultiprocessorCount, dev) != hipSuccess) { grid = -1; return; }
        if (hipFuncSetAttribute((const void*)fwd_kernel, hipFuncAttributeMaxDynamicSharedMemorySize, LDS_BYTES) != hipSuccess) { fprintf(stderr, "kernel_launch: hipFuncSetAttribute failed\n"); grid = -1; return; }
        if (hipOccupancyMaxActiveBlocksPerMultiprocessor(&per_cu, (const void*)fwd_kernel, 512, LDS_BYTES) != hipSuccess || per_cu < 1) { fprintf(stderr, "kernel_launch: occupancy query says %d\n", per_cu); }
        (void)hipGetLastError();
        grid = cus;
    }
    if (grid < 0) return;
    (void)hipMemsetAsync((char*)d_ws + WS_CTL, 0, CTL_ZERO_BYTES, stream);
    Args a{};
    for (int i = 0; i < 26; ++i) a.in[i] = (const float*)d_in[i];
    a.out = (float*)d_out; a.ws = (unsigned char*)d_ws;
    hipLaunchKernelGGL(fwd_kernel, dim3(grid), dim3(512), LDS_BYTES, stream, a);
    const hipError_t le = hipPeekAtLastError();
    if (le != hipSuccess) fprintf(stderr, "kernel_launch: launch failed: %s\n", hipGetErrorName(le));
}
```
